# Optimizing an MI355X kernel written in HIP

```python
import math
import jax, jax.numpy as jnp
from jax import lax
import numpy as np

D_MODEL = 1024
BATCH = 8
SEQ = 8192
DEPTH = 4

HEAD_DIM = 64
N_Q_HEADS = 16
N_KV_HEADS = 4
GROUP = N_Q_HEADS // N_KV_HEADS
WINDOW = 128
BLOCK = 128
ROT_DIM = HEAD_DIM // 4
ROPE_THETA = 500000.0
Q_WIDTH = N_Q_HEADS * HEAD_DIM
KV_WIDTH = N_KV_HEADS * HEAD_DIM
D_RNN = 1024
RNN_BLOCKS = 16
RNN_BW = D_RNN // RNN_BLOCKS
CONV_WIDTH = 4
LRU_C = 8.0
POOL_WINDOWS = (2, 4, 8, 16)
N_POOL_GROUPS = len(POOL_WINDOWS)
D_POOL = 1024
POOL_GW = D_POOL // N_POOL_GROUPS
N_BRANCHES = 3
D_FF = 4 * D_MODEL
EPS = 1e-6
NEG_INF = -1e30

D_IN = Q_WIDTH + 2 * KV_WIDTH + 2 * D_RNN + D_POOL + N_BRANCHES * D_MODEL
SPLITS = tuple(np.cumsum([Q_WIDTH, KV_WIDTH, KV_WIDTH, D_RNN, D_RNN, D_POOL]).tolist())

kernel_name = "hybrid_swa_rglru_pool_gated_block"


def rms_norm(x, g):
    xf = x.astype(jnp.float32)
    y = xf * lax.rsqrt(jnp.mean(xf * xf, axis=-1, keepdims=True) + EPS)
    return (y * g.astype(jnp.float32)).astype(x.dtype)


def rope_tables(seq):
    inv_freq = ROPE_THETA ** (-jnp.arange(0, ROT_DIM, 2, dtype=jnp.float32) / ROT_DIM)
    ang = jnp.arange(seq, dtype=jnp.float32)[:, None] * inv_freq[None, :]
    return jnp.cos(ang)[:, None, :], jnp.sin(ang)[:, None, :]


def apply_partial_rope(x, cos, sin):
    half = ROT_DIM // 2
    xf = x.astype(jnp.float32)
    x1, x2, rest = xf[..., :half], xf[..., half:ROT_DIM], xf[..., ROT_DIM:]
    out = jnp.concatenate([x1 * cos - x2 * sin, x2 * cos + x1 * sin, rest], axis=-1)
    return out.astype(x.dtype)


def sliding_window_attention(q, k, v, sinks):
    b, s = q.shape[0], q.shape[1]
    nb = s // BLOCK
    qb = q.reshape(b, nb, BLOCK, N_KV_HEADS, GROUP, HEAD_DIM)
    kb = k.reshape(b, nb, BLOCK, N_KV_HEADS, HEAD_DIM)
    vb = v.reshape(b, nb, BLOCK, N_KV_HEADS, HEAD_DIM)
    pad = ((0, 0), (1, 0), (0, 0), (0, 0), (0, 0))
    kcat = jnp.concatenate([jnp.pad(kb[:, :-1], pad), kb], axis=2)
    vcat = jnp.concatenate([jnp.pad(vb[:, :-1], pad), vb], axis=2)
    scores = jnp.einsum('bnqhgd,bnkhd->bnhgqk', qb, kcat).astype(jnp.float32) * (HEAD_DIM ** -0.5)
    qi = jnp.arange(BLOCK)[:, None]
    ki = jnp.arange(2 * BLOCK)[None, :]
    rel = qi + BLOCK - ki
    band = (rel >= 0) & (rel < WINDOW)
    has_prev = (jnp.arange(nb) > 0)[:, None, None]
    valid = band[None] & (has_prev | (ki >= BLOCK)[None])
    scores = jnp.where(valid[None, :, None, None], scores, NEG_INF)
    sink = sinks.astype(jnp.float32).reshape(N_KV_HEADS, GROUP)[None, None, :, :, None, None]
    m = jnp.maximum(jnp.max(scores, axis=-1, keepdims=True), sink)
    p = jnp.exp(scores - m)
    p = p / (jnp.sum(p, axis=-1, keepdims=True) + jnp.exp(sink - m))
    o = jnp.einsum('bnhgqk,bnkhd->bnqhgd', p.astype(v.dtype), vcat)
    return o.reshape(b, s, Q_WIDTH)


def causal_depthwise_conv(x, w, bias):
    s = x.shape[1]
    xp = jnp.pad(x, ((0, 0), (CONV_WIDTH - 1, 0), (0, 0)))
    y = bias
    for tap in range(CONV_WIDTH):
        y = y + xp[:, tap:tap + s] * w[tap]
    return y


def _lru_combine(e1, e2):
    a1, b1 = e1
    a2, b2 = e2
    return a1 * a2, a2 * b1 + b2


def rg_lru(x, w_a, b_a, w_i, b_i, lam):
    b, s, c = x.shape
    xf = x.astype(jnp.float32)
    xb = xf.reshape(b, s, RNN_BLOCKS, RNN_BW)
    r = jax.nn.sigmoid(jnp.einsum('bshi,hij->bshj', xb, w_a.astype(jnp.float32)).reshape(b, s, c) + b_a)
    i = jax.nn.sigmoid(jnp.einsum('bshi,hij->bshj', xb, w_i.astype(jnp.float32)).reshape(b, s, c) + b_i)
    log_a = LRU_C * r * jax.nn.log_sigmoid(lam.astype(jnp.float32))
    a = jnp.exp(log_a)
    u = jnp.sqrt(-jnp.expm1(2.0 * log_a)) * (i * xf)
    _, h = lax.associative_scan(_lru_combine, (a, u), axis=1)
    return h


def multi_scale_pool(p, w_groups, scale):
    b, s, c = p.shape
    pf = p.astype(jnp.float32)
    cs = jnp.cumsum(pf, axis=1)
    t = jnp.arange(s)
    outs = []
    for g, w in enumerate(POOL_WINDOWS):
        sl = slice(g * POOL_GW, (g + 1) * POOL_GW)
        c_g = cs[..., sl]
        lag = jnp.pad(c_g[:, :s - w], ((0, 0), (w, 0), (0, 0)))
        cnt = jnp.minimum(t + 1, w).astype(jnp.float32)[None, :, None]
        outs.append((c_g - lag) / cnt - pf[..., sl])
    pooled = jnp.stack(outs, axis=2)
    mixed = jnp.einsum('bsgi,gij->bsgj', pooled, w_groups.astype(jnp.float32)).reshape(b, s, c)
    return (mixed * scale.astype(jnp.float32)).astype(p.dtype)


def setup_inputs(seed: int = 0) -> dict:
    key = jax.random.key(seed)
    ks = jax.random.split(key, 24)
    f32 = jnp.float32

    def nrm(k, shape, fan_in):
        return jax.random.normal(k, shape, f32) * (fan_in ** -0.5)

    def gain(k, shape):
        return 1.0 + 0.05 * jax.random.normal(k, shape, f32)

    L = DEPTH
    a0 = jax.random.uniform(ks[11], (L, D_RNN), f32, 0.9, 0.999)
    return {
        "x": jax.random.normal(ks[0], (BATCH, SEQ, D_MODEL), f32),
        "norm_mix_pre": gain(ks[1], (L, D_MODEL)),
        "norm_mix_post": gain(ks[2], (L, D_MODEL)),
        "w_in": nrm(ks[3], (L, D_MODEL, D_IN), D_MODEL),
        "attn_sinks": 0.5 * jax.random.normal(ks[4], (L, N_Q_HEADS), f32),
        "w_attn_br": nrm(ks[5], (L, Q_WIDTH, D_MODEL), Q_WIDTH),
        "conv_w": nrm(ks[6], (L, CONV_WIDTH, D_RNN), CONV_WIDTH),
        "conv_b": 0.01 * jax.random.normal(ks[7], (L, D_RNN), f32),
        "w_rg_a": nrm(ks[8], (L, RNN_BLOCKS, RNN_BW, RNN_BW), RNN_BW),
        "b_rg_a": 0.01 * jax.random.normal(ks[9], (L, D_RNN), f32),
        "w_rg_i": nrm(ks[10], (L, RNN_BLOCKS, RNN_BW, RNN_BW), RNN_BW),
        "b_rg_i": 0.01 * jax.random.normal(ks[12], (L, D_RNN), f32),
        "lru_lambda": jnp.log(a0) - jnp.log1p(-a0),
        "w_rnn_br": nrm(ks[13], (L, D_RNN, D_MODEL), D_RNN),
        "w_pool_groups": nrm(ks[14], (L, N_POOL_GROUPS, POOL_GW, POOL_GW), POOL_GW),
        "pool_scale": gain(ks[15], (L, D_POOL)),
        "w_pool_br": nrm(ks[16], (L, D_POOL, D_MODEL), D_POOL),
        "w_out": nrm(ks[17], (L, D_MODEL, D_MODEL), D_MODEL),
        "norm_mlp_pre": gain(ks[18], (L, D_MODEL)),
        "norm_mlp_post": gain(ks[19], (L, D_MODEL)),
        "w_mlp_up": nrm(ks[20], (L, D_MODEL, D_FF), D_MODEL),
        "w_mlp_down": nrm(ks[21], (L, D_FF, D_MODEL), D_FF),
    }


def reference(x, norm_mix_pre, norm_mix_post, w_in, attn_sinks, w_attn_br, conv_w, conv_b,
              w_rg_a, b_rg_a, w_rg_i, b_rg_i, lru_lambda, w_rnn_br, w_pool_groups, pool_scale,
              w_pool_br, w_out, norm_mlp_pre, norm_mlp_post, w_mlp_up, w_mlp_down):
    b, s, _ = x.shape
    cos, sin = rope_tables(s)
    h = x
    for l in range(DEPTH):
        u = rms_norm(h, norm_mix_pre[l])
        proj = u @ w_in[l]
        q, k, v, xr, yr, pp, gt = jnp.split(proj, SPLITS, axis=-1)
        q = apply_partial_rope(q.reshape(b, s, N_Q_HEADS, HEAD_DIM), cos, sin)
        k = apply_partial_rope(k.reshape(b, s, N_KV_HEADS, HEAD_DIM), cos, sin)
        v = v.reshape(b, s, N_KV_HEADS, HEAD_DIM)
        attn_br = sliding_window_attention(q, k, v, attn_sinks[l]) @ w_attn_br[l]
        xc = causal_depthwise_conv(xr, conv_w[l], conv_b[l])
        hr = rg_lru(xc, w_rg_a[l], b_rg_a[l], w_rg_i[l], b_rg_i[l], lru_lambda[l])
        rnn_br = (hr * jax.nn.gelu(yr.astype(jnp.float32))).astype(h.dtype) @ w_rnn_br[l]
        pool_br = multi_scale_pool(pp, w_pool_groups[l], pool_scale[l]) @ w_pool_br[l]
        g = jax.nn.sigmoid(gt.astype(jnp.float32)).reshape(b, s, N_BRANCHES, D_MODEL)
        merged = (g[:, :, 0] * attn_br + g[:, :, 1] * rnn_br + g[:, :, 2] * pool_br).astype(h.dtype)
        mix = merged @ w_out[l]
        h = h + rms_norm(mix, norm_mix_post[l])
        m = rms_norm(h, norm_mlp_pre[l])
        y = jnp.square(jax.nn.relu(m @ w_mlp_up[l])) @ w_mlp_down[l]
        h = h + rms_norm(y, norm_mlp_post[l])
    return h
```

```cpp
#include <hip/hip_runtime.h>
#include <hip/hip_cooperative_groups.h>
#include <cstdio>
#include <cstdint>
#include <cmath>
namespace cg = cooperative_groups;

#define LAS __attribute__((address_space(3)))
#define DI __device__ __forceinline__
typedef unsigned short bf16_t;
typedef short bf16x8 __attribute__((ext_vector_type(8)));
typedef short s16x4 __attribute__((ext_vector_type(4)));
typedef float f32x2 __attribute__((ext_vector_type(2)));
typedef float f32x4 __attribute__((ext_vector_type(4)));
typedef float f32x16 __attribute__((ext_vector_type(16)));
typedef unsigned u32x2 __attribute__((ext_vector_type(2)));
typedef unsigned u32x4 __attribute__((ext_vector_type(4)));
typedef __bf16 bf16x2_t __attribute__((ext_vector_type(2)));

constexpr int D = 1024, SEQ = 8192, BATCH = 8, DEPTH = 4, DIN = 7680, DFF = 4096;
constexpr int NCHUNK = 4, BPC = BATCH / NCHUNK, MC = BPC * SEQ;
constexpr int PC_Q = 0, PC_Y = 1024, PC_P = 2048, PC_K = 3072, PC_V = 3328, PC_X = 3584, PC_G = 4608;
constexpr size_t WO_IN = 0, WO_BR = WO_IN + (size_t)DIN * D, WO_OUT = WO_BR + 3ull * D * D, WO_PG = WO_OUT + (size_t)D * D, WO_UP = WO_PG + 4ull * 256 * 256,
                 WO_DN = WO_UP + (size_t)DFF * D, WO_RA = WO_DN + (size_t)DFF * D, WO_RI = WO_RA + 16ull * 64 * 64, WO_LAYER = WO_RI + 16ull * 64 * 64;
constexpr size_t MiB = 1ull << 20;
constexpr size_t WS_ROPE = 0, WS_W = 3 * MiB, WS_SUMS = 163 * MiB, WS_HB = 164 * MiB, WS_POOLED = 196 * MiB, WS_MERGED = 228 * MiB, WS_PROJ = 260 * MiB, HALF_STRIDE = 337 * MiB,
                 WS_CTL = 838 * MiB, WS_END = 839 * MiB;
constexpr size_t CTL_ZERO_BYTES = 65536;
static_assert(WO_LAYER * 2 * DEPTH <= 160 * MiB, "weights fit");
static_assert((size_t)MC * DIN * 2 == 240 * MiB && WS_PROJ + 240 * MiB <= WS_SUMS + HALF_STRIDE, "proj size");
constexpr size_t PROJ_MIX_OFF = 128 * MiB;
constexpr int LDS_BYTES = 147456;
constexpr float EPS = 1e-6f;
constexpr float LOG2E = 1.4426950408889634f;

DI unsigned pk2(float lo, float hi) { f32x2 v = {lo, hi}; bf16x2_t b = __builtin_convertvector(v, bf16x2_t); return __builtin_bit_cast(unsigned, b); }
DI float bflo(unsigned u) { return __uint_as_float(u << 16); }
DI float bfhi(unsigned u) { return __uint_as_float(u & 0xffff0000u); }
DI float bf1(bf16_t u) { return __uint_as_float(((unsigned)u) << 16); }
DI float wave_sum(float v) {
#pragma unroll
    for (int o = 1; o < 64; o <<= 1) v += __shfl_xor(v, o);
    return v;
}
DI float sigm(float x) { return __builtin_amdgcn_rcpf(1.0f + __builtin_amdgcn_exp2f(-x * LOG2E)); }
DI float gelu_tanh(float y) { const float z = 0.7978845608028654f * (y + 0.044715f * y * y * y); const float t = 1.0f - 2.0f * __builtin_amdgcn_rcpf(1.0f + __builtin_amdgcn_exp2f(2.0f * LOG2E * z)); return 0.5f * y * (1.0f + t); }
#define MFMA32(a, b, c) __builtin_amdgcn_mfma_f32_32x32x16_bf16((a), (b), (c), 0, 0, 0)

namespace pg8 {
constexpr int BM = 256, BK = 64, HALF = 128, HTB = HALF * BK * 2, STAGE_BYTES = 8 * HTB, NXCD = 8, WGM = 8;
__host__ __device__ __forceinline__ int lds_byte(int r, int c) { const int st = (r >> 4) * 2 + (c >> 5), rr = r & 15, cc = c & 31, ob = rr * 64 + cc * 2; return st * 1024 + (ob ^ (((ob >> 9) & 1) << 5)); }
__host__ __device__ __forceinline__ void stage_rc(int b, int& R, int& C) { const int st = b / 1024, sb = b % 1024, swz = sb ^ (((sb >> 9) & 1) << 5); R = (st >> 1) * 16 + swz / 64; C = (st & 1) * 32 + (swz % 64) / 2; }
__host__ __device__ __forceinline__ int perm32(int rho) { const int n = rho >> 4, i = rho & 15; return 8 * (i >> 2) + 4 * n + (i & 3); }

struct Unit { int pm, pn, z; };
enum { EP_BF16 = 0, EP_RELU2 = 1, EP_SCALE = 2, EP_MERGE = 4 };
struct Cfg { const bf16_t* A; const bf16_t* Bt; int lda, ldb, K, N, lz, zA, zB, pnA; };
DI Cfg gemm_cfg(int ph, unsigned char* ws, unsigned char* wg, int l) {
    const bf16_t* Wl = (const bf16_t*)(wg + WS_W) + (size_t)l * WO_LAYER; const bf16_t* proj = (const bf16_t*)(ws + WS_PROJ);
    Cfg c; c.zA = 0; c.zB = 0; c.pnA = 0; c.lda = D; c.ldb = D; c.K = D; c.N = D; c.lz = 4;
    if (ph == 0) { c.A = (const bf16_t*)(ws + WS_HB); c.Bt = Wl + WO_IN; c.N = DIN; }
    else if (ph == 2) { c.A = (const bf16_t*)(ws + WS_POOLED); c.pnA = 256; c.Bt = Wl + WO_PG; c.K = 256; c.ldb = 256; c.lz = 2; }
    else if (ph == 3) { c.A = proj + PC_Q; c.lda = DIN; c.zA = D; c.Bt = Wl + WO_BR; c.zB = D * D; c.K = 3 * D; }
    else if (ph == 4) { c.A = (const bf16_t*)(ws + WS_MERGED); c.Bt = Wl + WO_OUT; }
    else if (ph == 6) { c.A = (const bf16_t*)(ws + WS_HB); c.Bt = Wl + WO_UP; c.N = DFF; }
    else { c.A = proj; c.lda = DFF; c.Bt = Wl + WO_DN; c.K = DFF; c.ldb = DFF; c.lz = 6; }
    return c;
}
struct Sched {
    int nM, nN, nZ, nwg, G, c, nx;
    DI void init(int M, int N, int nZ_, int G_, int c_, int nx_) { nM = M / BM; nN = N / BM; nZ = nZ_; nwg = nM * nN; G = G_; c = c_; nx = nx_; }
    DI bool next(int i, Unit& u) const {
        const int t = i; u.z = 0;
        const long L = (long)t * G + c; if (L >= nwg) return false;
        int wgid = (int)L; { const int q = nwg / nx, r = nwg % nx, xcd = wgid % nx, off = wgid / nx; wgid = (xcd < r ? xcd * (q + 1) : r * (q + 1) + (xcd - r) * q) + off; }
        const int nig = WGM * nN, gid = wgid / nig, fm = gid * WGM, gsz = (nM - fm) < WGM ? (nM - fm) : WGM;
        u.pm = fm + ((wgid % nig) % gsz); u.pn = (wgid % nig) / gsz; return true;
    }
};

DI unsigned ror8(unsigned x) { return (unsigned)__builtin_amdgcn_mov_dpp((int)x, 0x128, 0xf, 0xf, true); }
DI void store_lines(bf16_t* Ob, size_t row, int ldc, int colw, int fr, int fq, const u32x4& w0, const u32x4& w1) {
    const bool lo = (fr & 8) == 0;
    const u32x4 snd = lo ? w1 : w0;
    u32x4 rcv; rcv.x = ror8(snd.x); rcv.y = ror8(snd.y); rcv.z = ror8(snd.z); rcv.w = ror8(snd.w);
    const u32x4 dA = lo ? w0 : rcv, dB = lo ? rcv : w1;
    const int col = colw + 8 * fq + (lo ? 0 : 32);
    __builtin_nontemporal_store(dA, (u32x4*)(Ob + (lo ? row : row - 8) * ldc + col));
    __builtin_nontemporal_store(dB, (u32x4*)(Ob + (lo ? row + 8 : row) * ldc + col));
}
DI void epilogue(const f32x4 (&acc)[2][2][4][2], int ph, unsigned char* ws, const float* pscale, const Unit& u, int wr, int wc, int fr, int fq) {
    const int row0 = u.pm * BM + wr * 64 + fr, colw = u.pn * BM + wc * 64, col0 = colw + 8 * fq;
    const int mode = (ph == 0 || ph == 4 || ph == 7) ? EP_BF16 : ph == 2 ? EP_SCALE : ph == 3 ? EP_MERGE : EP_RELU2;
    bf16_t* Ob = ph == 3 ? (bf16_t*)(ws + WS_MERGED) : (ph == 4 || ph == 7) ? (bf16_t*)(ws + WS_PROJ + PROJ_MIX_OFF) : (bf16_t*)(ws + WS_PROJ) + (ph == 2 ? PC_P : 0);
    const int ldc = (ph == 0 || ph == 2) ? DIN : (ph == 6 ? DFF : D);
    if (mode == EP_BF16 || mode == EP_RELU2) {
        const bool r2 = mode == EP_RELU2;
#pragma unroll
        for (int ai = 0; ai < 2; ++ai)
#pragma unroll
            for (int m = 0; m < 4; ++m) { u32x4 w[2];
#pragma unroll
                for (int bj = 0; bj < 2; ++bj) { f32x4 v0 = acc[ai][bj][m][0], v1 = acc[ai][bj][m][1];
                    if (r2) {
#pragma unroll
                        for (int j = 0; j < 4; ++j) { const float a = fmaxf(v0[j], 0.f), b = fmaxf(v1[j], 0.f); v0[j] = a * a; v1[j] = b * b; } }
                    w[bj].x = pk2(v0[0], v0[1]); w[bj].y = pk2(v0[2], v0[3]); w[bj].z = pk2(v1[0], v1[1]); w[bj].w = pk2(v1[2], v1[3]); }
                store_lines(Ob, (size_t)(row0 + ai * HALF + m * 16), ldc, colw, fr, fq, w[0], w[1]); }
    } else if (mode == EP_SCALE) {
        f32x4 sc[2][2];
#pragma unroll
        for (int bj = 0; bj < 2; ++bj)
#pragma unroll
            for (int n = 0; n < 2; ++n) sc[bj][n] = *(const f32x4*)(pscale + col0 + bj * 32 + 4 * n);
#pragma unroll
        for (int ai = 0; ai < 2; ++ai)
#pragma unroll
            for (int m = 0; m < 4; ++m) { u32x4 w[2];
#pragma unroll
                for (int bj = 0; bj < 2; ++bj) { const f32x4 v0 = acc[ai][bj][m][0] * sc[bj][0], v1 = acc[ai][bj][m][1] * sc[bj][1];
                    w[bj].x = pk2(v0[0], v0[1]); w[bj].y = pk2(v0[2], v0[3]); w[bj].z = pk2(v1[0], v1[1]); w[bj].w = pk2(v1[2], v1[3]); }
                store_lines(Ob, (size_t)(row0 + ai * HALF + m * 16), ldc, colw, fr, fq, w[0], w[1]); }
    } else {
        const bf16_t* gate = (const bf16_t*)(ws + WS_PROJ) + PC_G + 2 * D;
#pragma unroll
        for (int ai = 0; ai < 2; ++ai)
#pragma unroll
            for (int m = 0; m < 4; ++m) { const size_t row = (size_t)(row0 + ai * HALF + m * 16); u32x4 w[2];
#pragma unroll
                for (int bj = 0; bj < 2; ++bj) { const int col = col0 + bj * 32;
                    const u32x4 gw = *(const u32x4*)(gate + row * DIN + col);
                    const float ga[8] = {bflo(gw.x), bfhi(gw.x), bflo(gw.y), bfhi(gw.y), bflo(gw.z), bfhi(gw.z), bflo(gw.w), bfhi(gw.w)};
                    float f[8];
#pragma unroll
                    for (int j = 0; j < 8; ++j) f[j] = __builtin_amdgcn_rcpf(1.0f + __builtin_amdgcn_exp2f(-fmaxf(ga[j], -30.f) * LOG2E));
                    const f32x4 v0 = acc[ai][bj][m][0] * (f32x4){f[0], f[1], f[2], f[3]}, v1 = acc[ai][bj][m][1] * (f32x4){f[4], f[5], f[6], f[7]};
                    w[bj].x = pk2(v0[0], v0[1]); w[bj].y = pk2(v0[2], v0[3]); w[bj].z = pk2(v1[0], v1[1]); w[bj].w = pk2(v1[2], v1[3]); }
                store_lines(Ob, row, ldc, colw, fr, fq, w[0], w[1]);
                asm volatile("" ::: "memory"); }
    }
}
DI void merge_carry(f32x4 (&acc)[2][2][4][2], unsigned char* ws, const Unit& u, int z, int wr, int wc, int fr, int fq) {
    const int row0 = u.pm * BM + wr * 64 + fr, col0 = u.pn * BM + wc * 64 + 8 * fq;
    const bf16_t* gate = (const bf16_t*)(ws + WS_PROJ) + PC_G + (size_t)z * D;
#pragma unroll
    for (int ai = 0; ai < 2; ++ai)
#pragma unroll
        for (int m = 0; m < 4; ++m) { const size_t row = (size_t)(row0 + ai * HALF + m * 16);
#pragma unroll
            for (int bj = 0; bj < 2; ++bj) { const int col = col0 + bj * 32;
                const u32x4 gw = *(const u32x4*)(gate + row * DIN + col), hw = *(const u32x4*)(gate + row * DIN + D + col);
                const float ga[8] = {bflo(gw.x), bfhi(gw.x), bflo(gw.y), bfhi(gw.y), bflo(gw.z), bfhi(gw.z), bflo(gw.w), bfhi(gw.w)};
                const float gb[8] = {bflo(hw.x), bfhi(hw.x), bflo(hw.y), bfhi(hw.y), bflo(hw.z), bfhi(hw.z), bflo(hw.w), bfhi(hw.w)};
                float f[8];
#pragma unroll
                for (int j = 0; j < 8; ++j) { const float ea = __builtin_amdgcn_exp2f(-fmaxf(ga[j], -30.f) * LOG2E), eb = __builtin_amdgcn_exp2f(-fmaxf(gb[j], -30.f) * LOG2E);
                    f[j] = (1.0f + eb) * __builtin_amdgcn_rcpf(1.0f + ea); }
                acc[ai][bj][m][0] = acc[ai][bj][m][0] * (f32x4){f[0], f[1], f[2], f[3]}; acc[ai][bj][m][1] = acc[ai][bj][m][1] * (f32x4){f[4], f[5], f[6], f[7]};
                asm volatile("" ::: "memory"); } }
}

DI void gemm_phase(LAS unsigned char* lds, int ph, unsigned char* ws, unsigned char* wg, int l, const float* pscale, int G, int cidx, int nx) {
    int tid_ = threadIdx.x; asm volatile("" : "+v"(tid_));
    const int tid = tid_, wid = __builtin_amdgcn_readfirstlane(tid >> 6), lane = tid & 63, wr = wid >> 2, wc = wid & 3, fr = lane & 15, fq = lane >> 4;
    const Cfg g0 = gemm_cfg(ph, ws, wg, l);
    const int nt = g0.K / BK, lda = g0.lda, ldb = g0.ldb, lz = g0.lz, ntzm = (1 << g0.lz) - 1;
    const size_t zAb = (size_t)g0.zA * 2, zBb = (size_t)g0.zB * 2;
    Sched S; S.init(MC, g0.N, 1, G, cidx, nx);
    unsigned voffA[2], voffB[2];
#pragma unroll
    for (int i = 0; i < 2; ++i) { int R, C; stage_rc(tid * 16 + i * 8192, R, C); const int Rb = (R >> 5) * 64 + perm32(R & 31);
        voffA[i] = (unsigned)(R * lda + C) * 2u; voffB[i] = (unsigned)(Rb * ldb + C) * 2u; }
    const size_t kstep = (size_t)(BK * 2);
    const size_t hstepA = (size_t)HALF * lda * 2, hstepB = (size_t)32 * ldb * 2;
    const unsigned ldsw = (unsigned)wid * 1024u;
    const int aoff = lds_byte(wr * 64 + fr, fq * 8), boff = lds_byte(wc * 32 + fr, fq * 8);
#define PG8_SA(b, h) (((b) * 2 + (h)) * HTB)
#define PG8_SB(b, h) ((4 + (b) * 2 + (h)) * HTB)
#define PG8_STAGE(bufoff, gbase, voff) do { _Pragma("unroll") for (int _i = 0; _i < 2; ++_i) \
        __builtin_amdgcn_global_load_lds((const unsigned*)((const char*)(gbase) + (voff)[_i]), (LAS unsigned*)(lds + (bufoff) + ldsw + _i * 8192), 16, 0, 0); } while (0)
#define PG8_LDA(dst, b, h) do { _Pragma("unroll") for (int m = 0; m < 4; ++m) _Pragma("unroll") for (int k = 0; k < 2; ++k) dst[m][k] = *(const LAS bf16x8*)(lds + PG8_SA(b, h) + aoff + m * 2048 + k * 1024); } while (0)
#define PG8_LDB(dst, b, h) do { _Pragma("unroll") for (int n = 0; n < 2; ++n) _Pragma("unroll") for (int k = 0; k < 2; ++k) dst[n][k] = *(const LAS bf16x8*)(lds + PG8_SB(b, h) + boff + n * 2048 + k * 1024); } while (0)
#define PG8_MMA(ai, bj, At, Bt) do { __builtin_amdgcn_s_setprio(1); _Pragma("unroll") for (int m = 0; m < 4; ++m) _Pragma("unroll") for (int n = 0; n < 2; ++n) _Pragma("unroll") for (int k = 0; k < 2; ++k) \
        acc[ai][bj][m][n] = __builtin_amdgcn_mfma_f32_16x16x32_bf16(Bt[n][k], At[m][k], acc[ai][bj][m][n], 0, 0, 0); __builtin_amdgcn_s_setprio(0); } while (0)
#define PG8_WAIT_V(n) asm volatile("s_waitcnt vmcnt(" #n ")" ::: "memory")
#define PG8_WAIT_L(n) asm volatile("s_waitcnt lgkmcnt(" #n ")" ::: "memory")
#define PG8_BAR __builtin_amdgcn_s_barrier()
#define PG8_SCHED __builtin_amdgcn_sched_barrier(0)
#define PG8_ABASE(u) ((const char*)gx.A + (size_t)(u).pm * tstepA + (size_t)(u).pn * gx.pnA * 2)
#define PG8_BBASE(u) ((const char*)gx.Bt + (size_t)(u).pn * tstepB)
#define PG8_KA(t_) (cA + (size_t)((t_) >> lz) * zAb + (size_t)((t_) & ntzm) * kstep)
#define PG8_KB(t_) (cB + (size_t)((t_) >> lz) * zBb + (size_t)((t_) & ntzm) * kstep)
#define PG8_RECFG() int phx = ph; int lx = l; unsigned char* wsx = ws; unsigned char* wgx = wg; asm volatile("" : "+s"(phx), "+s"(lx), "+s"(wsx), "+s"(wgx)); const Cfg gx = gemm_cfg(phx, wsx, wgx, lx); \
        const size_t tstepA = (size_t)BM * gx.lda * 2, tstepB = (size_t)BM * gx.ldb * 2
    Unit cur, nxt; int ui = 0;
    if (!S.next(0, cur)) return;
    f32x4 acc[2][2][4][2];
#pragma unroll
    for (int a = 0; a < 2; ++a)
#pragma unroll
        for (int b = 0; b < 2; ++b)
#pragma unroll
            for (int m = 0; m < 4; ++m)
#pragma unroll
                for (int n = 0; n < 2; ++n) acc[a][b][m][n] = (f32x4){0.f, 0.f, 0.f, 0.f};
    bf16x8 At[4][2], B0[2][2], B1[2][2];
    const char* cA; const char* cB; { PG8_RECFG(); cA = PG8_ABASE(cur); cB = PG8_BBASE(cur); }
    PG8_STAGE(PG8_SB(0, 0), cB, voffB); PG8_STAGE(PG8_SB(0, 1), cB + hstepB, voffB); PG8_STAGE(PG8_SA(0, 0), cA, voffA); PG8_STAGE(PG8_SA(0, 1), cA + hstepA, voffA);
    if (wr == 1) PG8_BAR;
    PG8_WAIT_V(2); PG8_BAR;
    PG8_STAGE(PG8_SB(1, 0), cB + kstep, voffB); PG8_STAGE(PG8_SA(1, 0), cA + kstep, voffA); PG8_STAGE(PG8_SB(1, 1), cB + hstepB + kstep, voffB);
    PG8_WAIT_V(6); PG8_BAR;
    for (;;) {
        const bool has_next = S.next(ui + 1, nxt);
        const char* nA = cA; const char* nB = cB; if (has_next) { PG8_RECFG(); nA = PG8_ABASE(nxt); nB = PG8_BBASE(nxt); }
        for (int t = 0; t < nt; t += 2) {
            const bool last = (t == nt - 2);
            const char* a1 = PG8_KA(t + 1);
            const char* a2 = last ? nA : PG8_KA(t + 2); const char* b2 = last ? nB : PG8_KB(t + 2);
            const char* a3 = a2 + kstep; const char* b3 = b2 + kstep;
            if (zAb != 0 && t != 0 && (t & ntzm) == 0) { unsigned char* wsx = ws; asm volatile("" : "+s"(wsx)); int frx = fr; asm volatile("" : "+v"(frx)); merge_carry(acc, wsx, cur, (t >> lz) - 1, wr, wc, frx, fq); }
            PG8_LDB(B0, 0, 0); PG8_LDB(B1, 0, 1); PG8_SCHED; PG8_LDA(At, 0, 0); PG8_STAGE(PG8_SA(1, 1), a1 + hstepA, voffA);
            PG8_WAIT_V(8); PG8_WAIT_L(0); PG8_BAR; PG8_MMA(0, 0, At, B0); PG8_MMA(0, 1, At, B1); PG8_BAR; PG8_SCHED;
            PG8_LDA(At, 0, 1); PG8_STAGE(PG8_SB(0, 0), b2, voffB); PG8_STAGE(PG8_SB(0, 1), b2 + hstepB, voffB); PG8_STAGE(PG8_SA(0, 0), a2, voffA);
            PG8_WAIT_V(8); PG8_WAIT_L(0); PG8_BAR; PG8_MMA(1, 0, At, B0); PG8_MMA(1, 1, At, B1); PG8_BAR; PG8_SCHED;
            PG8_LDB(B0, 1, 0); PG8_LDB(B1, 1, 1); PG8_SCHED; PG8_LDA(At, 1, 0); PG8_STAGE(PG8_SA(0, 1), a2 + hstepA, voffA);
            PG8_WAIT_V(8); PG8_WAIT_L(0); PG8_BAR; PG8_MMA(0, 0, At, B0); PG8_MMA(0, 1, At, B1); PG8_BAR; PG8_SCHED;
            PG8_LDA(At, 1, 1); PG8_STAGE(PG8_SB(1, 0), b3, voffB); PG8_STAGE(PG8_SB(1, 1), b3 + hstepB, voffB); PG8_STAGE(PG8_SA(1, 0), a3, voffA);
            PG8_WAIT_V(8); PG8_WAIT_L(0); PG8_BAR; PG8_MMA(1, 0, At, B0); PG8_MMA(1, 1, At, B1); PG8_BAR; PG8_SCHED;
        }
        if (wr == 0) PG8_BAR;
        { int phx = ph; unsigned char* wsx = ws; asm volatile("" : "+s"(phx), "+s"(wsx)); int frx = fr; asm volatile("" : "+v"(frx)); epilogue(acc, phx, wsx, pscale, cur, wr, wc, frx, fq); }
        if (!has_next) break;
#pragma unroll
        for (int a = 0; a < 2; ++a)
#pragma unroll
            for (int b = 0; b < 2; ++b)
#pragma unroll
                for (int m = 0; m < 4; ++m)
#pragma unroll
                    for (int n = 0; n < 2; ++n) acc[a][b][m][n] = (f32x4){0.f, 0.f, 0.f, 0.f};
        cur = nxt; cA = nA; cB = nB; ++ui;
        if (wr == 1) PG8_BAR;
    }
    PG8_WAIT_V(0);
    PG8_BAR;
#undef PG8_SA
#undef PG8_SB
#undef PG8_STAGE
#undef PG8_LDA
#undef PG8_LDB
#undef PG8_MMA
#undef PG8_WAIT_V
#undef PG8_WAIT_L
#undef PG8_BAR
#undef PG8_SCHED
#undef PG8_ABASE
#undef PG8_BBASE
#undef PG8_RECFG
#undef PG8_KA
#undef PG8_KB
}
}

DI void transpose_item(const float* W, int K, int N, bf16_t* WT, int drow0, LAS float* scr, int k0, int n0, int lane) {
    const int kr = lane >> 3, n4 = lane & 7;
    f32x4 v[8];
#pragma unroll
    for (int i = 0; i < 8; ++i) v[i] = *(const f32x4*)(W + (size_t)(k0 + kr + 8 * i) * N + n0 + 4 * n4);
#pragma unroll
    for (int i = 0; i < 8; ++i) { LAS float* d = scr + (kr + 8 * i) * 33 + 4 * n4; d[0] = v[i].x; d[1] = v[i].y; d[2] = v[i].z; d[3] = v[i].w; }
    asm volatile("s_waitcnt lgkmcnt(0)" ::: "memory");
    const int c = lane & 7;
#pragma unroll
    for (int j = 0; j < 4; ++j) { const int n = (lane >> 3) + 8 * j; const LAS float* s = scr + (8 * c) * 33 + n;
        u32x4 o; o.x = pk2(s[0 * 33], s[1 * 33]); o.y = pk2(s[2 * 33], s[3 * 33]); o.z = pk2(s[4 * 33], s[5 * 33]); o.w = pk2(s[6 * 33], s[7 * 33]);
        *(u32x4*)(WT + (size_t)(drow0 + n) * K + k0 + 8 * c) = o; }
    asm volatile("s_waitcnt lgkmcnt(0)" ::: "memory");
}
DI int win_perm(int n) {
    if (n < 1024) return PC_Q + n;
    if (n < 1280) return PC_K + (n - 1024);
    if (n < 1536) return PC_V + (n - 1280);
    if (n < 2560) return PC_X + (n - 1536);
    if (n < 3584) return PC_Y + (n - 2560);
    if (n < 4608) return PC_P + (n - 3584);
    return n;
}

struct Params {
    const float* in[22]; float* out; unsigned char* ws; float inv_freq[8]; int lo, hi;
};
enum { I_X = 0, I_NMIXPRE, I_NMIXPOST, I_WIN, I_SINKS, I_WATT, I_CONVW, I_CONVB, I_WRGA, I_BRGA, I_WRGI, I_BRGI, I_LAM, I_WRNN, I_WPG, I_PSCALE, I_WPOOL, I_WOUT, I_NMLPPRE, I_NMLPPOST, I_WUP, I_WDN };

DI void prologue(const Params& p, LAS unsigned char* lds, int l_lo, int l_hi, bool do_rope, int gw, int NGW, int wave, int lane) {
    LAS float* scr = (LAS float*)(lds + wave * 16384);
    bf16_t* Wall = (bf16_t*)(p.ws + WS_W);
    constexpr int IT_IN = 16 * 240, IT_SQ = 512, IT_PG = 128, IT_UP = 2048, IT_DN = 2048, IT_RG = 32;
    constexpr int IT_LAYER = IT_IN + 4 * IT_SQ + IT_PG + IT_UP + IT_DN + 2 * IT_RG;
    for (int it = l_lo * IT_LAYER + gw; it < IT_LAYER * l_hi; it += NGW) {
        const int l = it / IT_LAYER; int r = it - l * IT_LAYER; bf16_t* Wl = Wall + (size_t)l * WO_LAYER;
        if (r < IT_IN) { const int kb = r / 240, nb = r % 240; transpose_item(p.in[I_WIN] + (size_t)l * D * DIN, D, DIN, Wl + WO_IN, win_perm(nb * 32), scr, kb * 64, nb * 32, lane); continue; } r -= IT_IN;
        if (r < 4 * IT_SQ) { const int which = r / IT_SQ; r -= which * IT_SQ; const int kb = r / 32, nb = r % 32;
            const float* src = (which == 0 ? p.in[I_WATT] : which == 1 ? p.in[I_WRNN] : which == 2 ? p.in[I_WPOOL] : p.in[I_WOUT]) + (size_t)l * D * D;
            bf16_t* dst = which < 3 ? Wl + WO_BR + (size_t)which * D * D : Wl + WO_OUT;
            transpose_item(src, D, D, dst, nb * 32, scr, kb * 64, nb * 32, lane); continue; } r -= 4 * IT_SQ;
        if (r < IT_PG) { const int gq = r / 32; r -= gq * 32; const int kb = r / 8, nb = r % 8;
            transpose_item(p.in[I_WPG] + ((size_t)l * 4 + gq) * 65536, 256, 256, Wl + WO_PG, gq * 256 + nb * 32, scr, kb * 64, nb * 32, lane); continue; } r -= IT_PG;
        if (r < IT_UP) { const int kb = r / 128, nb = r % 128; transpose_item(p.in[I_WUP] + (size_t)l * D * DFF, D, DFF, Wl + WO_UP, nb * 32, scr, kb * 64, nb * 32, lane); continue; } r -= IT_UP;
        if (r < IT_DN) { const int kb = r / 32, nb = r % 32; transpose_item(p.in[I_WDN] + (size_t)l * DFF * D, DFF, D, Wl + WO_DN, nb * 32, scr, kb * 64, nb * 32, lane); continue; } r -= IT_DN;
        { const int which = r / IT_RG; r -= which * IT_RG; const int hb = r / 2, nb = r % 2;
          transpose_item((which ? p.in[I_WRGI] : p.in[I_WRGA]) + ((size_t)l * 16 + hb) * 4096, 64, 64, Wl + (which ? WO_RI : WO_RA), hb * 64 + nb * 32, scr, 0, nb * 32, lane); }
    }
    float* rope = (float*)(p.ws + WS_ROPE);
    if (do_rope) for (int i = gw * 64 + lane; i < SEQ * 8; i += NGW * 64) {
        const int pos = i >> 3, j = i & 7;
        const float ang = (float)pos * p.inv_freq[j];
        const double a = (double)ang * 0.15915494309189535; const double n = __builtin_rint(a); const float fr = (float)(a - n);
        rope[pos * 16 + j] = __builtin_amdgcn_cosf(fr); rope[pos * 16 + 8 + j] = __builtin_amdgcn_sinf(fr);
    }
}

DI void rowpass(const float* hsrc, const bf16_t* mix, const float* gpost, const float* gnext, float* hdst, bf16_t* hb, int gw, int NGW, int lane) {
    for (int m0 = gw * 2; m0 < MC; m0 += NGW * 2) {
        f32x4 hv[2][4], mv[2][4];
#pragma unroll
        for (int r = 0; r < 2; ++r)
#pragma unroll
            for (int j = 0; j < 4; ++j) hv[r][j] = __builtin_nontemporal_load((const f32x4*)(hsrc + (size_t)(m0 + r) * D + 256 * j + 4 * lane));
        if (mix) {
#pragma unroll
            for (int r = 0; r < 2; ++r)
#pragma unroll
                for (int j = 0; j < 4; ++j) { const u32x2 w = __builtin_nontemporal_load((const u32x2*)(mix + (size_t)(m0 + r) * D + 256 * j + 4 * lane)); mv[r][j] = (f32x4){bflo(w.x), bfhi(w.x), bflo(w.y), bfhi(w.y)}; }
            float ss[2] = {0.f, 0.f};
#pragma unroll
            for (int r = 0; r < 2; ++r)
#pragma unroll
                for (int j = 0; j < 4; ++j) ss[r] += (mv[r][j].x * mv[r][j].x + mv[r][j].y * mv[r][j].y) + (mv[r][j].z * mv[r][j].z + mv[r][j].w * mv[r][j].w);
#pragma unroll
            for (int o = 1; o < 64; o <<= 1) { ss[0] += __shfl_xor(ss[0], o); ss[1] += __shfl_xor(ss[1], o); }
#pragma unroll
            for (int r = 0; r < 2; ++r) { const float rs = 1.0f / sqrtf(ss[r] * (1.0f / D) + EPS);
#pragma unroll
                for (int j = 0; j < 4; ++j) { const f32x4 gp = *(const f32x4*)(gpost + 256 * j + 4 * lane); hv[r][j] += mv[r][j] * rs * gp; *(f32x4*)(hdst + (size_t)(m0 + r) * D + 256 * j + 4 * lane) = hv[r][j]; } }
        }
        if (gnext) {
            float ss[2] = {0.f, 0.f};
#pragma unroll
            for (int r = 0; r < 2; ++r)
#pragma unroll
                for (int j = 0; j < 4; ++j) ss[r] += (hv[r][j].x * hv[r][j].x + hv[r][j].y * hv[r][j].y) + (hv[r][j].z * hv[r][j].z + hv[r][j].w * hv[r][j].w);
#pragma unroll
            for (int o = 1; o < 64; o <<= 1) { ss[0] += __shfl_xor(ss[0], o); ss[1] += __shfl_xor(ss[1], o); }
#pragma unroll
            for (int r = 0; r < 2; ++r) { const float rs = 1.0f / sqrtf(ss[r] * (1.0f / D) + EPS);
#pragma unroll
                for (int j = 0; j < 4; ++j) { const f32x4 gn = *(const f32x4*)(gnext + 256 * j + 4 * lane); const f32x4 o = hv[r][j] * rs * gn;
                    u32x2 w; w.x = pk2(o.x, o.y); w.y = pk2(o.z, o.w); *(u32x2*)(hb + (size_t)(m0 + r) * D + 256 * j + 4 * lane) = w; } }
        }
    }
}

DI void rope8(u32x4& v, const u32x4& pr, const float* tab, bool second) {
    const f32x4 c0 = *(const f32x4*)tab, c1 = *(const f32x4*)(tab + 4), s0 = *(const f32x4*)(tab + 8), s1 = *(const f32x4*)(tab + 12);
    const float sg = second ? 1.f : -1.f;
    float x[8] = {bflo(v.x), bfhi(v.x), bflo(v.y), bfhi(v.y), bflo(v.z), bfhi(v.z), bflo(v.w), bfhi(v.w)};
    const float y[8] = {bflo(pr.x), bfhi(pr.x), bflo(pr.y), bfhi(pr.y), bflo(pr.z), bfhi(pr.z), bflo(pr.w), bfhi(pr.w)};
    const float cs[8] = {c0.x, c0.y, c0.z, c0.w, c1.x, c1.y, c1.z, c1.w}, sn[8] = {s0.x, s0.y, s0.z, s0.w, s1.x, s1.y, s1.z, s1.w};
#pragma unroll
    for (int j = 0; j < 8; ++j) x[j] = x[j] * cs[j] + sg * y[j] * sn[j];
    v.x = pk2(x[0], x[1]); v.y = pk2(x[2], x[3]); v.z = pk2(x[4], x[5]); v.w = pk2(x[6], x[7]);
}
constexpr int KS_LD = 72, VT_LD = 260, ATT_VT_OFF = 256 * KS_LD * 2;
DI void attn_unit(LAS unsigned char* lds, bf16_t* P, const float* rope, const float* sinks, int unit, int tid, int wid, int lane) {
    const int kvh = unit & 3, n = (unit >> 2) & 63, b = unit >> 8;
    const long rowblk = (long)b * SEQ + n * 128;
    LAS bf16_t* Ks = (LAS bf16_t*)lds; LAS bf16_t* Vt = (LAS bf16_t*)(lds + ATT_VT_OFF);
#pragma unroll
    for (int i = 0; i < 4; ++i) {
        const int pc = tid + 512 * i, key = pc >> 3, dg = pc & 7;
        const bool valid = (n > 0) || key >= 128;
        u32x4 kv = {0u, 0u, 0u, 0u}, vv = {0u, 0u, 0u, 0u};
        if (valid) { const bf16_t* src = P + (size_t)(rowblk - 128 + key) * DIN + kvh * 64 + dg * 8; kv = *(const u32x4*)(src + PC_K); vv = *(const u32x4*)(src + PC_V); }
        u32x4 pr; pr.x = __shfl_xor(kv.x, 1); pr.y = __shfl_xor(kv.y, 1); pr.z = __shfl_xor(kv.z, 1); pr.w = __shfl_xor(kv.w, 1);
        if (dg < 2) { const int pos = valid ? (n * 128 - 128 + key) : 0; rope8(kv, pr, rope + pos * 16, dg == 1); }
        *(LAS u32x4*)(Ks + key * KS_LD + dg * 8) = kv;
        const unsigned vw[4] = {vv.x, vv.y, vv.z, vv.w};
#pragma unroll
        for (int j = 0; j < 4; ++j) { Vt[(dg * 8 + 2 * j) * VT_LD + key] = (bf16_t)(vw[j] & 0xffffu); Vt[(dg * 8 + 2 * j + 1) * VT_LD + key] = (bf16_t)(vw[j] >> 16); }
    }
    __syncthreads();
    const int g = wid >> 1, head = kvh * 4 + g, q = lane & 31, hl = lane >> 5;
    const float sinkv = sinks[head] * LOG2E;
    const float cscale = 0.125f * LOG2E;
#pragma unroll 1
    for (int sb = 0; sb < 2; ++sb) {
        const int r0 = 64 * (wid & 1) + 32 * sb;
        bf16_t* qrow = P + (size_t)(rowblk + r0 + q) * DIN + PC_Q + head * 64;
        u32x4 qf[4];
#pragma unroll
        for (int s = 0; s < 4; ++s) qf[s] = *(const u32x4*)(qrow + 16 * s + 8 * hl);
        { u32x4 pr; pr.x = __shfl_xor(qf[0].x, 32); pr.y = __shfl_xor(qf[0].y, 32); pr.z = __shfl_xor(qf[0].z, 32); pr.w = __shfl_xor(qf[0].w, 32);
          rope8(qf[0], pr, rope + (n * 128 + r0 + q) * 16, hl == 1); }
        f32x16 S[5];
#pragma unroll
        for (int kt = 0; kt < 5; ++kt) {
#pragma unroll
            for (int i = 0; i < 16; ++i) S[kt][i] = 0.f;
#pragma unroll
            for (int s = 0; s < 4; ++s) { const bf16x8 kf = *(const LAS bf16x8*)(Ks + (r0 + 32 * kt + q) * KS_LD + 16 * s + 8 * hl);
                S[kt] = MFMA32(kf, __builtin_bit_cast(bf16x8, qf[s]), S[kt]); }
        }
#pragma unroll
        for (int i = 0; i < 16; ++i) { const int kl = 8 * (i >> 2) + 4 * hl + (i & 3);
            if (kl <= q) S[0][i] = -1e30f;
            if (kl > q) S[4][i] = -1e30f; }
        if (n == 0) {
#pragma unroll
            for (int kt = 0; kt < 4; ++kt) if (r0 + 32 * kt < 128) {
#pragma unroll
                for (int i = 0; i < 16; ++i) S[kt][i] = -1e30f; }
        }
        float mx = -1e30f;
#pragma unroll
        for (int kt = 0; kt < 5; ++kt)
#pragma unroll
            for (int i = 0; i < 16; ++i) mx = fmaxf(mx, S[kt][i]);
        mx = fmaxf(mx, __shfl_xor(mx, 32));
        const float M2 = fmaxf(mx * cscale, sinkv);
        float l = 0.f;
#pragma unroll
        for (int kt = 0; kt < 5; ++kt)
#pragma unroll
            for (int i = 0; i < 16; ++i) { const float pv = __builtin_amdgcn_exp2f(S[kt][i] * cscale - M2); l += pv; S[kt][i] = pv; }
        l += __shfl_xor(l, 32);
        l += __builtin_amdgcn_exp2f(sinkv - M2);
        const float inv = 1.0f / l;
        f32x16 O[2];
#pragma unroll
        for (int i = 0; i < 16; ++i) { O[0][i] = 0.f; O[1][i] = 0.f; }
#pragma unroll
        for (int kt = 0; kt < 5; ++kt)
#pragma unroll
            for (int s2 = 0; s2 < 2; ++s2) {
                u32x4 pw; pw.x = pk2(S[kt][8 * s2 + 0], S[kt][8 * s2 + 1]); pw.y = pk2(S[kt][8 * s2 + 2], S[kt][8 * s2 + 3]); pw.z = pk2(S[kt][8 * s2 + 4], S[kt][8 * s2 + 5]); pw.w = pk2(S[kt][8 * s2 + 6], S[kt][8 * s2 + 7]);
                const bf16x8 pf = __builtin_bit_cast(bf16x8, pw);
#pragma unroll
                for (int dt = 0; dt < 2; ++dt) {
                    const LAS bf16_t* vp = Vt + (32 * dt + q) * VT_LD + r0 + 32 * kt + 16 * s2 + 4 * hl;
                    const u32x2 v0 = *(const LAS u32x2*)vp, v1 = *(const LAS u32x2*)(vp + 8);
                    u32x4 vw; vw.x = v0.x; vw.y = v0.y; vw.z = v1.x; vw.w = v1.y;
                    O[dt] = MFMA32(__builtin_bit_cast(bf16x8, vw), pf, O[dt]);
                }
            }
        bf16_t* orow = qrow;
#pragma unroll
        for (int dt = 0; dt < 2; ++dt)
#pragma unroll
            for (int a = 0; a < 4; ++a) { u32x2 w; w.x = pk2(O[dt][4 * a] * inv, O[dt][4 * a + 1] * inv); w.y = pk2(O[dt][4 * a + 2] * inv, O[dt][4 * a + 3] * inv);
                *(u32x2*)(orow + 32 * dt + 8 * a + 4 * hl) = w; }
    }
    __syncthreads();
}

constexpr int NCH = SEQ / 128;
DI void rnn_phase(LAS unsigned char* lds, bf16_t* P, const bf16_t* WaT, const bf16_t* WiT, const float* convw, const float* convb, const float* ba, const float* bi, const float* lam,
                  f32x2* sums, bool fin, int bx, int G, int tid, int wid, int lane) {
    constexpr int NU = BPC * NCH * 16;
    LAS float* XC = (LAS float*)lds; LAS float* AA = (LAS float*)(lds + 32768); LAS bf16_t* XB = (LAS bf16_t*)(lds + 65536); LAS bf16_t* WL = (LAS bf16_t*)(lds + 83968);
    LAS float* SG = (LAS float*)(lds + 102400); LAS float* PF = (LAS float*)(lds + 106496); LAS float* CW = (LAS float*)(lds + 110592);
    const int t = tid >> 2, cq = tid & 3;
    const int tt = wid >> 1, nt = wid & 1, l32 = lane & 31, hl = lane >> 5;
    int cur_hbk = -1; float bac = 0.f, bic = 0.f, k8c = 0.f;
    u32x4 xr[4][2];
#define RNN_LOAD_XR(uu) do { const int hb_ = (uu) & 15, c_ = ((uu) >> 4) & 63, b_ = (uu) >> 10; const size_t rb_ = (size_t)b_ * SEQ + c_ * 128; \
        _Pragma("unroll") for (int tap = 0; tap < 4; ++tap) { const int tp_ = c_ * 128 + t + tap - 3; \
            if (tp_ >= 0) { const bf16_t* src_ = P + (rb_ + t + tap - 3) * DIN + PC_X + hb_ * 64 + 16 * cq; xr[tap][0] = *(const u32x4*)src_; xr[tap][1] = *(const u32x4*)(src_ + 8); } \
            else { xr[tap][0] = (u32x4){0u, 0u, 0u, 0u}; xr[tap][1] = (u32x4){0u, 0u, 0u, 0u}; } } } while (0)
    int u = bx; if (u >= NU) return;
    RNN_LOAD_XR(u);
    for (; u < NU; u += G) {
        const int hbk = u & 15, c = (u >> 4) & 63, b = u >> 10;
        const size_t rowbase = (size_t)b * SEQ + c * 128; const int ch0 = hbk * 64;
        if (hbk != cur_hbk) {
            const int nn = tid >> 3, k8 = tid & 7;
            *(LAS u32x4*)(WL + nn * 72 + 8 * k8) = *(const u32x4*)(WaT + (size_t)hbk * 4096 + nn * 64 + 8 * k8);
            *(LAS u32x4*)(WL + 64 * 72 + nn * 72 + 8 * k8) = *(const u32x4*)(WiT + (size_t)hbk * 4096 + nn * 64 + 8 * k8);
            if (tid < 320) CW[tid] = tid < 256 ? convw[(tid >> 6) * D + ch0 + (tid & 63)] : convb[ch0 + tid - 256];
            const int chg = ch0 + 32 * nt + l32;
            bac = ba[chg]; bic = bi[chg]; k8c = -8.0f * LOG2E * log1pf(expf(-lam[chg]));
            cur_hbk = hbk;
            __syncthreads();
        }
        unsigned short yv[16]; float Ap = 1.f, Hp = 0.f;
        bf16_t* yp = P + (rowbase + 16 * wid) * DIN + PC_Y + ch0 + lane;
        if (fin) {
#pragma unroll
            for (int j = 0; j < 16; ++j) yv[j] = yp[(size_t)j * DIN];
#pragma unroll
            for (int k = 0; k < 8; ++k) { const int j = 8 * wid + k; if (j < c) { const f32x2 sv = sums[((size_t)b * NCH + j) * D + ch0 + lane]; Hp = sv.x * Hp + sv.y; Ap *= sv.x; } }
        }
        {
            f32x4 acc[4];
#pragma unroll
            for (int j = 0; j < 4; ++j) acc[j] = *(const LAS f32x4*)(CW + 256 + 16 * cq + 4 * j);
#pragma unroll
            for (int tap = 0; tap < 4; ++tap) {
                const u32x4 x0 = xr[tap][0], x1 = xr[tap][1];
                const LAS float* wp = CW + tap * 64 + 16 * cq;
                const f32x4 w0 = *(const LAS f32x4*)wp, w1 = *(const LAS f32x4*)(wp + 4), w2 = *(const LAS f32x4*)(wp + 8), w3 = *(const LAS f32x4*)(wp + 12);
                acc[0] += (f32x4){bflo(x0.x), bfhi(x0.x), bflo(x0.y), bfhi(x0.y)} * w0; acc[1] += (f32x4){bflo(x0.z), bfhi(x0.z), bflo(x0.w), bfhi(x0.w)} * w1;
                acc[2] += (f32x4){bflo(x1.x), bfhi(x1.x), bflo(x1.y), bfhi(x1.y)} * w2; acc[3] += (f32x4){bflo(x1.z), bfhi(x1.z), bflo(x1.w), bfhi(x1.w)} * w3;
            }
#pragma unroll
            for (int j = 0; j < 4; ++j) *(LAS f32x4*)(XC + t * 64 + 16 * cq + 4 * j) = acc[j];
            u32x4 o0, o1; o0.x = pk2(acc[0].x, acc[0].y); o0.y = pk2(acc[0].z, acc[0].w); o0.z = pk2(acc[1].x, acc[1].y); o0.w = pk2(acc[1].z, acc[1].w);
            o1.x = pk2(acc[2].x, acc[2].y); o1.y = pk2(acc[2].z, acc[2].w); o1.z = pk2(acc[3].x, acc[3].y); o1.w = pk2(acc[3].z, acc[3].w);
            *(LAS u32x4*)(XB + t * 72 + 16 * cq) = o0; *(LAS u32x4*)(XB + t * 72 + 16 * cq + 8) = o1;
        }
        if (u + G < NU) RNN_LOAD_XR(u + G);
        if (fin) { PF[wid * 64 + lane] = Ap; PF[512 + wid * 64 + lane] = Hp; }
        __syncthreads();
        {
            f32x16 aR, aI;
#pragma unroll
            for (int i = 0; i < 16; ++i) { aR[i] = 0.f; aI[i] = 0.f; }
#pragma unroll
            for (int s = 0; s < 4; ++s) {
                const bf16x8 af = *(const LAS bf16x8*)(XB + (32 * tt + l32) * 72 + 16 * s + 8 * hl);
                const bf16x8 bR = *(const LAS bf16x8*)(WL + (32 * nt + l32) * 72 + 16 * s + 8 * hl);
                const bf16x8 bI = *(const LAS bf16x8*)(WL + 64 * 72 + (32 * nt + l32) * 72 + 16 * s + 8 * hl);
                aR = MFMA32(af, bR, aR); aI = MFMA32(af, bI, aI);
            }
            const int ch = 32 * nt + l32;
#pragma unroll
            for (int i = 0; i < 16; ++i) { const int tok = 32 * tt + 8 * (i >> 2) + 4 * hl + (i & 3);
                const float r = sigm(aR[i] + bac), ig = sigm(aI[i] + bic);
                const float a = __builtin_amdgcn_exp2f(k8c * r);
                const float mult = sqrtf(fmaxf(1.0f - a * a, 0.f));
                const float xv = XC[tok * 64 + ch];
                AA[tok * 64 + ch] = a; XC[tok * 64 + ch] = mult * ig * xv; }
        }
        __syncthreads();
        {
            const int ch = lane, seg = wid;
            float A = 1.f, H = 0.f;
#pragma unroll
            for (int j = 0; j < 16; ++j) { const int tk = 16 * seg + j; const float a = AA[tk * 64 + ch], uu = XC[tk * 64 + ch]; H = a * H + uu; A *= a; }
            SG[seg * 64 + ch] = A; SG[512 + seg * 64 + ch] = H;
            __syncthreads();
            if (!fin) {
                if (wid == 0) { float Ac = 1.f, Hc = 0.f;
#pragma unroll
                    for (int s = 0; s < 8; ++s) { const float sa = SG[s * 64 + ch]; Hc = sa * Hc + SG[512 + s * 64 + ch]; Ac *= sa; }
                    sums[((size_t)b * NCH + c) * D + ch0 + ch] = (f32x2){Ac, Hc}; }
            } else {
                float h = 0.f;
#pragma unroll
                for (int w = 0; w < 8; ++w) h = PF[w * 64 + ch] * h + PF[512 + w * 64 + ch];
                for (int s = 0; s < seg; ++s) h = SG[s * 64 + ch] * h + SG[512 + s * 64 + ch];
#pragma unroll
                for (int j = 0; j < 16; ++j) { const int tk = 16 * seg + j; const float a = AA[tk * 64 + ch], uu = XC[tk * 64 + ch]; h = a * h + uu;
                    const float o = h * gelu_tanh(bf1(yv[j]));
                    yp[(size_t)j * DIN] = (bf16_t)(pk2(o, 0.f) & 0xffffu); }
            }
        }
        __syncthreads();
    }
#undef RNN_LOAD_XR
}

DI void pool_item(const bf16_t* P, bf16_t* pooled, int idx) {
    const int cg8 = idx & 127, run = idx >> 7; const size_t row0 = (size_t)run * 8; const int t0 = (int)(row0 & (SEQ - 1));
    const int ch = cg8 * 8, w = 2 << (ch >> 8);
    const bf16_t* src = P + PC_P + ch;
    float sum[8];
#pragma unroll
    for (int j = 0; j < 8; ++j) sum[j] = 0.f;
    for (int k = 1; k < w; ++k) if (t0 - k >= 0) { const u32x4 x = *(const u32x4*)(src + (row0 - k) * DIN);
        sum[0] += bflo(x.x); sum[1] += bfhi(x.x); sum[2] += bflo(x.y); sum[3] += bfhi(x.y); sum[4] += bflo(x.z); sum[5] += bfhi(x.z); sum[6] += bflo(x.w); sum[7] += bfhi(x.w); }
#pragma unroll
    for (int j = 0; j < 8; ++j) {
        const int t = t0 + j; const u32x4 x = *(const u32x4*)(src + (row0 + j) * DIN);
        const float cur[8] = {bflo(x.x), bfhi(x.x), bflo(x.y), bfhi(x.y), bflo(x.z), bfhi(x.z), bflo(x.w), bfhi(x.w)};
#pragma unroll
        for (int e = 0; e < 8; ++e) sum[e] += cur[e];
        const float ic = 1.0f / (float)(t + 1 < w ? t + 1 : w);
        u32x4 o; o.x = pk2(sum[0] * ic - cur[0], sum[1] * ic - cur[1]); o.y = pk2(sum[2] * ic - cur[2], sum[3] * ic - cur[3]);
        o.z = pk2(sum[4] * ic - cur[4], sum[5] * ic - cur[5]); o.w = pk2(sum[6] * ic - cur[6], sum[7] * ic - cur[7]);
        *(u32x4*)(pooled + (row0 + j) * D + ch) = o;
        if (t - w + 1 >= 0) { const u32x4 y = *(const u32x4*)(src + (row0 + j - w + 1) * DIN);
            sum[0] -= bflo(y.x); sum[1] -= bfhi(y.x); sum[2] -= bflo(y.y); sum[3] -= bfhi(y.y); sum[4] -= bflo(y.z); sum[5] -= bfhi(y.z); sum[6] -= bflo(y.w); sum[7] -= bfhi(y.w); }
    }
}


#define XB_TMO      128
#define XB_XCNT(j)  (256  + 64 * (j))
#define XB_XSUB(j)  (1280 + 64 * (j))
#define XB_XGEN(j)  (2304 + 64 * (j))
#define XB_TOP      3328
#define XB_TOPGEN   3392
#define XCD_BAR_WORDS 3456
#define XB_SPIN_CAP (1u << 22)
DI unsigned xb_ld(unsigned* p)              { return __hip_atomic_load(p, __ATOMIC_RELAXED, __HIP_MEMORY_SCOPE_AGENT); }
DI unsigned xb_add(unsigned* p, unsigned v) { return __hip_atomic_fetch_add(p, v, __ATOMIC_RELAXED, __HIP_MEMORY_SCOPE_AGENT); }
DI unsigned xb_xcc_id() { return (unsigned)__builtin_amdgcn_s_getreg((3 << 11) | 20) & 0xFu; }
#define XB_SPIN(cond, bar) do { unsigned _sp = 0; while (cond) { __builtin_amdgcn_s_sleep(1); \
    if ((++_sp & 255u) == 0u) { if (xb_ld(&(bar)[XB_TMO])) break; if (_sp > XB_SPIN_CAP) { atomicAdd(&(bar)[XB_TMO], 1u); break; } } } } while (0)
struct XcdBarrier { unsigned* bar; unsigned x; volatile LAS unsigned* st; unsigned n; };
DI XcdBarrier xcd_barrier_post(unsigned* bar, volatile LAS unsigned* st, unsigned n) {
    XcdBarrier b; b.bar = bar; b.x = xb_xcc_id(); b.st = st; b.n = n;
    if (threadIdx.x == 0) (void)xb_add(&bar[XB_XCNT(b.x)], 1u);
    return b;
}
DI void xcd_barrier_complete(unsigned* bar, unsigned x, unsigned G, unsigned& nloc, unsigned& nx) {
    unsigned sum, cnt, mine, sp = 0u;
    for (;;) {
        sum = 0u; cnt = 0u; mine = 0u;
#pragma unroll
        for (unsigned j = 0; j < 16; ++j) { const unsigned c = xb_ld(&bar[XB_XCNT(j)]); sum += c; cnt += (c > 0u) ? 1u : 0u; mine = (j == x) ? c : mine; }
        if (sum == G) break;
        __builtin_amdgcn_s_sleep(1);
        if ((++sp & 255u) == 0u) { if (xb_ld(&bar[XB_TMO])) break; if (sp > XB_SPIN_CAP) { atomicAdd(&bar[XB_TMO], 1u); break; } }
    }
    nloc = mine > 0u ? mine : 1u; nx = cnt > 0u ? cnt : 1u;
}
DI void xcd_barrier(const XcdBarrier& b) {
    asm volatile("s_waitcnt vmcnt(0)" ::: "memory");
    __syncthreads();
    if (threadIdx.x == 0) {
        unsigned* bar = b.bar;
        __builtin_amdgcn_s_waitcnt(0);
        unsigned nloc = b.st[0], nx = b.st[1];
        if (nloc == 0u) { xcd_barrier_complete(bar, b.x, b.n, nloc, nx); b.st[0] = nloc; b.st[1] = nx; }
        const unsigned old = xb_add(&bar[XB_XSUB(b.x)], 1u);
        const unsigned gen = old / nloc;
        if (old + 1u == (gen + 1u) * nloc) {
            __builtin_amdgcn_fence(__ATOMIC_RELEASE, "agent");
            asm volatile("s_waitcnt vmcnt(0)" ::: "memory");
            const unsigned og = xb_add(&bar[XB_TOP], 1u);
            const unsigned tg = og / nx;
            if (og + 1u == (tg + 1u) * nx) xb_add(&bar[XB_TOPGEN], 1u);
            else XB_SPIN(xb_ld(&bar[XB_TOPGEN]) == tg, bar);
            __builtin_amdgcn_fence(__ATOMIC_ACQUIRE, "agent");
            xb_add(&bar[XB_XGEN(b.x)], 1u);
            asm volatile("s_waitcnt vmcnt(0)" ::: "memory");
        } else {
            XB_SPIN(xb_ld(&bar[XB_XGEN(b.x)]) == gen, bar);
            __builtin_amdgcn_fence(__ATOMIC_ACQUIRE, "agent");
            asm volatile("s_waitcnt vmcnt(0)" ::: "memory");
        }
    }
    __syncthreads();
}

__global__ void __launch_bounds__(512, 2) mega_fwd(Params p) {
    extern __shared__ __attribute__((aligned(16))) unsigned char lds_raw[];
    LAS unsigned char* lds = (LAS unsigned char*)lds_raw;
    cg::grid_group grid = cg::this_grid();
    const int Gfull = gridDim.x, bfull = blockIdx.x;
    const int half = (bfull & 7) >> 2, bx = (bfull >> 3) * 4 + (bfull & 3), G = Gfull >> 1, NGW = G * 8;
#define TID_LOCAL() int tid_ = threadIdx.x; asm volatile("" : "+v"(tid_)); const int tid = tid_, lane = tid & 63, wid = __builtin_amdgcn_readfirstlane(tid >> 6), gw = bx * 8 + wid; (void)lane; (void)gw; (void)tid
    volatile LAS unsigned* xst = (volatile LAS unsigned*)(lds + 131072 + 512);
    if (threadIdx.x < 2) xst[threadIdx.x] = 0u;
    __syncthreads();
    unsigned* ctl = (unsigned*)(p.ws + WS_CTL);
    XcdBarrier xbar = xcd_barrier_post(ctl + half * 4096, xst, (unsigned)G);
    unsigned* wflag = ctl + 8192 + 64;
    { TID_LOCAL(); const int gwf = bfull * 8 + wid; prologue(p, lds, 0, 1, true, gwf, Gfull * 8, wid, lane); }
    grid.sync();
    if (half == 1) {
        TID_LOCAL(); prologue(p, lds, 1, DEPTH, false, gw, NGW, wid, lane);
        asm volatile("s_waitcnt vmcnt(0)" ::: "memory"); __syncthreads();
        if (tid == 0) { __builtin_amdgcn_fence(__ATOMIC_RELEASE, "agent"); asm volatile("s_waitcnt vmcnt(0)" ::: "memory"); __hip_atomic_fetch_add(wflag, 1u, __ATOMIC_RELAXED, __HIP_MEMORY_SCOPE_AGENT); }
    }
    bool first = true, wready = (half == 1);
#define STEP_SYNC() do { if (!first) xcd_barrier(xbar); first = false; } while (0)
    for (int cj = 0; cj < NCHUNK / 2; ++cj) {
        const int ck = half * (NCHUNK / 2) + cj;
        { STEP_SYNC(); TID_LOCAL(); int ckx = ck; unsigned char* ws = p.ws + (size_t)half * HALF_STRIDE; asm volatile("" : "+s"(ckx), "+s"(ws));
            rowpass(p.in[I_X] + (size_t)ckx * MC * D, nullptr, nullptr, p.in[I_NMIXPRE], p.out + (size_t)ckx * MC * D, (bf16_t*)(ws + WS_HB), gw, NGW, lane); }
        for (int l = 0; l < DEPTH; ++l) {
            if (!wready && l >= 1) {
                if (threadIdx.x == 0) { unsigned sp = 0; while (__hip_atomic_load(wflag, __ATOMIC_RELAXED, __HIP_MEMORY_SCOPE_AGENT) < (unsigned)G) { __builtin_amdgcn_s_sleep(2); if (++sp > (1u << 24)) break; }
                    __builtin_amdgcn_fence(__ATOMIC_ACQUIRE, "agent"); asm volatile("s_waitcnt vmcnt(0)" ::: "memory"); }
                __syncthreads(); wready = true;
            }
            for (int ph = 0; ph < 9; ++ph) {
                STEP_SYNC();
                if (ph == 1) {
                    TID_LOCAL(); int lx = l; unsigned char* ws = p.ws + (size_t)half * HALF_STRIDE; unsigned char* wg = p.ws; asm volatile("" : "+s"(lx), "+s"(ws), "+s"(wg));
                    bf16_t* proj = (bf16_t*)(ws + WS_PROJ);
                    for (int u = bx; u < BPC * 64 * 4; u += G) attn_unit(lds, proj, (const float*)(wg + WS_ROPE), p.in[I_SINKS] + lx * 16, u, tid, wid, lane);
                    for (int idx = bx * 512 + tid; idx < (MC / 8) * 128; idx += G * 512) pool_item(proj, (bf16_t*)(ws + WS_POOLED), idx);
                }
                if (ph == 1 || ph == 2) {
                    TID_LOCAL(); int lx = l; unsigned char* ws = p.ws + (size_t)half * HALF_STRIDE; unsigned char* wg = p.ws; asm volatile("" : "+s"(lx), "+s"(ws), "+s"(wg));
                    const bf16_t* Wl = (const bf16_t*)(wg + WS_W) + (size_t)lx * WO_LAYER;
                    rnn_phase(lds, (bf16_t*)(ws + WS_PROJ), Wl + WO_RA, Wl + WO_RI, p.in[I_CONVW] + (size_t)lx * 4 * D, p.in[I_CONVB] + lx * D, p.in[I_BRGA] + lx * D, p.in[I_BRGI] + lx * D, p.in[I_LAM] + lx * D,
                              (f32x2*)(ws + WS_SUMS), ph == 2, bx, G, tid, wid, lane);
                }
                if (ph == 5 || ph == 8) {
                    TID_LOCAL(); int lx = l, ckx = ck; unsigned char* ws = p.ws + (size_t)half * HALF_STRIDE; asm volatile("" : "+s"(lx), "+s"(ckx), "+s"(ws));
                    const float* gpost = (ph == 5 ? p.in[I_NMIXPOST] : p.in[I_NMLPPOST]) + lx * D;
                    const float* gnext = ph == 5 ? p.in[I_NMLPPRE] + lx * D : (lx + 1 < DEPTH ? p.in[I_NMIXPRE] + (lx + 1) * D : nullptr);
                    float* hck = p.out + (size_t)ckx * MC * D;
                    rowpass(lx == 0 && ph == 5 ? p.in[I_X] + (size_t)ckx * MC * D : hck, (const bf16_t*)(ws + WS_PROJ + PROJ_MIX_OFF), gpost, gnext, hck, (bf16_t*)(ws + WS_HB), gw, NGW, lane);
                }
                if (ph == 0 || ph == 2 || ph == 3 || ph == 4 || ph == 6 || ph == 7) {
                    int lx = l; unsigned char* ws = p.ws + (size_t)half * HALF_STRIDE; unsigned char* wg = p.ws; asm volatile("" : "+s"(lx), "+s"(ws), "+s"(wg));
                    pg8::gemm_phase(lds, ph, ws, wg, lx, p.in[I_PSCALE] + lx * D, G, bx, (Gfull & 7) == 0 ? 4 : 1);
                }
            }
        }
    }
}

#ifndef MK_MULTI
#define MK_MULTI 0
#endif
extern "C" void kernel_launch(void* const* d_in, const int* in_sizes, int n_in, void* d_out, int out_size, void* d_ws, size_t ws_size, hipStream_t stream) {
    static int grid = 0;
    if (grid == 0) {
        if (n_in != 22 || ws_size < WS_END) { fprintf(stderr, "kernel_launch: unexpected n_in %d / ws_size %zu (need %zu)\n", n_in, ws_size, (size_t)WS_END); grid = -1; return; }
        int dev = 0, cus = 0, per_cu = 0;
        hipGetDevice(&dev); hipDeviceGetAttribute(&cus, hipDeviceAttributeMultiprocessorCount, dev);
        if (hipFuncSetAttribute((const void*)mega_fwd, hipFuncAttributeMaxDynamicSharedMemorySize, LDS_BYTES) != hipSuccess) { fprintf(stderr, "kernel_launch: hipFuncSetAttribute failed\n"); grid = -1; return; }
        if (hipOccupancyMaxActiveBlocksPerMultiprocessor(&per_cu, (const void*)mega_fwd, 512, LDS_BYTES) != hipSuccess || per_cu < 1) { fprintf(stderr, "kernel_launch: occupancy query gave %d\n", per_cu); per_cu = 1; }
        (void)hipGetLastError();
        grid = (cus * per_cu) & ~7;
        fprintf(stderr, "kernel_launch: grid %d (cus %d x %d)\n", grid, cus, per_cu);
    }
    if (grid < 0) return;
    if (hipMemsetAsync((char*)d_ws + WS_CTL, 0, CTL_ZERO_BYTES, stream) != hipSuccess) { fprintf(stderr, "kernel_launch: memset failed\n"); return; }
    Params p{};
    for (int i = 0; i < 22; ++i) p.in[i] = (const float*)d_in[i];
    p.out = (float*)d_out; p.ws = (unsigned char*)d_ws;
    for (int j = 0; j < 8; ++j) p.inv_freq[j] = (float)pow(500000.0, -(double)j / 8.0);
    p.lo = 0; p.hi = 0; void* args[] = {&p};
    hipError_t e = hipLaunchCooperativeKernel((const void*)mega_fwd, dim3(grid), dim3(512), args, LDS_BYTES, stream);
    if (e != hipSuccess) fprintf(stderr, "cooperative launch failed: %s (grid %d)\n", hipGetErrorString(e), grid);
}
```

```cpp
#include <hip/hip_runtime.h>
#include <hip/hip_cooperative_groups.h>
#include <cstdio>
#include <cstdint>
#include <cmath>
namespace cg = cooperative_groups;

#define LAS __attribute__((address_space(3)))
#define DI __device__ __forceinline__
typedef unsigned short bf16_t;
typedef short bf16x8 __attribute__((ext_vector_type(8)));
typedef short s16x4 __attribute__((ext_vector_type(4)));
typedef float f32x2 __attribute__((ext_vector_type(2)));
typedef float f32x4 __attribute__((ext_vector_type(4)));
typedef float f32x16 __attribute__((ext_vector_type(16)));
typedef unsigned u32x2 __attribute__((ext_vector_type(2)));
typedef unsigned u32x4 __attribute__((ext_vector_type(4)));
typedef __bf16 bf16x2_t __attribute__((ext_vector_type(2)));

constexpr int D = 1024, SEQ = 8192, BATCH = 8, DEPTH = 4, DIN = 7680, DFF = 4096;
constexpr int NCHUNK = 4, BPC = BATCH / NCHUNK, MC = BPC * SEQ;
constexpr int PC_Q = 0, PC_Y = 1024, PC_P = 2048, PC_K = 3072, PC_V = 3328, PC_X = 3584, PC_G = 4608;
constexpr size_t WO_IN = 0, WO_BR = WO_IN + (size_t)DIN * D, WO_OUT = WO_BR + 3ull * D * D, WO_PG = WO_OUT + (size_t)D * D, WO_UP = WO_PG + 4ull * 256 * 256,
                 WO_DN = WO_UP + (size_t)DFF * D, WO_RA = WO_DN + (size_t)DFF * D, WO_RI = WO_RA + 16ull * 64 * 64, WO_LAYER = WO_RI + 16ull * 64 * 64;
constexpr size_t MiB = 1ull << 20;
constexpr size_t WS_ROPE = 0, WS_W = 3 * MiB, WS_SUMS = 163 * MiB, WS_HB = 164 * MiB, WS_POOLED = 196 * MiB, WS_MERGED = 228 * MiB, WS_PROJ = 260 * MiB, HALF_STRIDE = 337 * MiB,
                 WS_CTL = 838 * MiB, WS_END = 839 * MiB;
constexpr size_t CTL_ZERO_BYTES = 65536;
static_assert(WO_LAYER * 2 * DEPTH <= 160 * MiB, "weights fit");
static_assert((size_t)MC * DIN * 2 == 240 * MiB && WS_PROJ + 240 * MiB <= WS_SUMS + HALF_STRIDE, "proj size");
constexpr size_t PROJ_MIX_OFF = 128 * MiB;
constexpr int LDS_BYTES = 147456;
constexpr float EPS = 1e-6f;
constexpr float LOG2E = 1.4426950408889634f;

DI unsigned pk2(float lo, float hi) { f32x2 v = {lo, hi}; bf16x2_t b = __builtin_convertvector(v, bf16x2_t); return __builtin_bit_cast(unsigned, b); }
DI float bflo(unsigned u) { return __uint_as_float(u << 16); }
DI float bfhi(unsigned u) { return __uint_as_float(u & 0xffff0000u); }
DI float bf1(bf16_t u) { return __uint_as_float(((unsigned)u) << 16); }
DI float wave_sum(float v) {
#pragma unroll
    for (int o = 1; o < 64; o <<= 1) v += __shfl_xor(v, o);
    return v;
}
DI float sigm(float x) { return __builtin_amdgcn_rcpf(1.0f + __builtin_amdgcn_exp2f(-x * LOG2E)); }
DI float gelu_tanh(float y) { const float z = 0.7978845608028654f * (y + 0.044715f * y * y * y); const float t = 1.0f - 2.0f * __builtin_amdgcn_rcpf(1.0f + __builtin_amdgcn_exp2f(2.0f * LOG2E * z)); return 0.5f * y * (1.0f + t); }
#define MFMA32(a, b, c) __builtin_amdgcn_mfma_f32_32x32x16_bf16((a), (b), (c), 0, 0, 0)

namespace pg8 {
constexpr int BM = 256, BK = 64, HALF = 128, HTB = HALF * BK * 2, STAGE_BYTES = 8 * HTB, NXCD = 8, WGM = 8;
__host__ __device__ __forceinline__ int lds_byte(int r, int c) { const int st = (r >> 4) * 2 + (c >> 5), rr = r & 15, cc = c & 31, ob = rr * 64 + cc * 2; return st * 1024 + (ob ^ (((ob >> 9) & 1) << 5)); }
__host__ __device__ __forceinline__ void stage_rc(int b, int& R, int& C) { const int st = b / 1024, sb = b % 1024, swz = sb ^ (((sb >> 9) & 1) << 5); R = (st >> 1) * 16 + swz / 64; C = (st & 1) * 32 + (swz % 64) / 2; }
__host__ __device__ __forceinline__ int perm32(int rho) { const int n = rho >> 4, i = rho & 15; return 8 * (i >> 2) + 4 * n + (i & 3); }

struct Unit { int pm, pn, z; };
enum { EP_BF16 = 0, EP_RELU2 = 1, EP_SCALE = 2, EP_MERGE = 4 };
struct Cfg { const bf16_t* A; const bf16_t* Bt; int lda, ldb, K, N, lz, zA, zB, pnA; };
DI Cfg gemm_cfg(int ph, unsigned char* ws, unsigned char* wg, int l) {
    const bf16_t* Wl = (const bf16_t*)(wg + WS_W) + (size_t)l * WO_LAYER; const bf16_t* proj = (const bf16_t*)(ws + WS_PROJ);
    Cfg c; c.zA = 0; c.zB = 0; c.pnA = 0; c.lda = D; c.ldb = D; c.K = D; c.N = D; c.lz = 4;
    if (ph == 0) { c.A = (const bf16_t*)(ws + WS_HB); c.Bt = Wl + WO_IN; c.N = DIN; }
    else if (ph == 2) { c.A = (const bf16_t*)(ws + WS_POOLED); c.pnA = 256; c.Bt = Wl + WO_PG; c.K = 256; c.ldb = 256; c.lz = 2; }
    else if (ph == 3) { c.A = proj + PC_Q; c.lda = DIN; c.zA = D; c.Bt = Wl + WO_BR; c.zB = D * D; c.K = 3 * D; }
    else if (ph == 4) { c.A = (const bf16_t*)(ws + WS_MERGED); c.Bt = Wl + WO_OUT; }
    else if (ph == 6) { c.A = (const bf16_t*)(ws + WS_HB); c.Bt = Wl + WO_UP; c.N = DFF; }
    else { c.A = proj; c.lda = DFF; c.Bt = Wl + WO_DN; c.K = DFF; c.ldb = DFF; c.lz = 6; }
    return c;
}
struct Sched {
    int nM, nN, nZ, nwg, G, c, nx;
    DI void init(int M, int N, int nZ_, int G_, int c_, int nx_) { nM = M / BM; nN = N / BM; nZ = nZ_; nwg = nM * nN; G = G_; c = c_; nx = nx_; }
    DI bool next(int i, Unit& u) const {
        const int t = i; u.z = 0;
        const long L = (long)t * G + c; if (L >= nwg) return false;
        int wgid = (int)L; { const int q = nwg / nx, r = nwg % nx, xcd = wgid % nx, off = wgid / nx; wgid = (xcd < r ? xcd * (q + 1) : r * (q + 1) + (xcd - r) * q) + off; }
        const int nig = WGM * nN, gid = wgid / nig, fm = gid * WGM, gsz = (nM - fm) < WGM ? (nM - fm) : WGM;
        u.pm = fm + ((wgid % nig) % gsz); u.pn = (wgid % nig) / gsz; return true;
    }
};

DI unsigned ror8(unsigned x) { return (unsigned)__builtin_amdgcn_mov_dpp((int)x, 0x128, 0xf, 0xf, true); }
DI void store_lines(bf16_t* Ob, size_t row, int ldc, int colw, int fr, int fq, const u32x4& w0, const u32x4& w1) {
    const bool lo = (fr & 8) == 0;
    const u32x4 snd = lo ? w1 : w0;
    u32x4 rcv; rcv.x = ror8(snd.x); rcv.y = ror8(snd.y); rcv.z = ror8(snd.z); rcv.w = ror8(snd.w);
    const u32x4 dA = lo ? w0 : rcv, dB = lo ? rcv : w1;
    const int col = colw + 8 * fq + (lo ? 0 : 32);
    __builtin_nontemporal_store(dA, (u32x4*)(Ob + (lo ? row : row - 8) * ldc + col));
    __builtin_nontemporal_store(dB, (u32x4*)(Ob + (lo ? row + 8 : row) * ldc + col));
}
DI void epilogue(const f32x4 (&acc)[2][2][4][2], int ph, unsigned char* ws, const float* pscale, const Unit& u, int wr, int wc, int fr, int fq) {
    const int row0 = u.pm * BM + wr * 64 + fr, colw = u.pn * BM + wc * 64, col0 = colw + 8 * fq;
    const int mode = (ph == 0 || ph == 4 || ph == 7) ? EP_BF16 : ph == 2 ? EP_SCALE : ph == 3 ? EP_MERGE : EP_RELU2;
    bf16_t* Ob = ph == 3 ? (bf16_t*)(ws + WS_MERGED) : (ph == 4 || ph == 7) ? (bf16_t*)(ws + WS_PROJ + PROJ_MIX_OFF) : (bf16_t*)(ws + WS_PROJ) + (ph == 2 ? PC_P : 0);
    const int ldc = (ph == 0 || ph == 2) ? DIN : (ph == 6 ? DFF : D);
    if (mode == EP_BF16 || mode == EP_RELU2) {
        const bool r2 = mode == EP_RELU2;
#pragma unroll
        for (int ai = 0; ai < 2; ++ai)
#pragma unroll
            for (int m = 0; m < 4; ++m) { u32x4 w[2];
#pragma unroll
                for (int bj = 0; bj < 2; ++bj) { f32x4 v0 = acc[ai][bj][m][0], v1 = acc[ai][bj][m][1];
                    if (r2) {
#pragma unroll
                        for (int j = 0; j < 4; ++j) { const float a = fmaxf(v0[j], 0.f), b = fmaxf(v1[j], 0.f); v0[j] = a * a; v1[j] = b * b; } }
                    w[bj].x = pk2(v0[0], v0[1]); w[bj].y = pk2(v0[2], v0[3]); w[bj].z = pk2(v1[0], v1[1]); w[bj].w = pk2(v1[2], v1[3]); }
                store_lines(Ob, (size_t)(row0 + ai * HALF + m * 16), ldc, colw, fr, fq, w[0], w[1]); }
    } else if (mode == EP_SCALE) {
        f32x4 sc[2][2];
#pragma unroll
        for (int bj = 0; bj < 2; ++bj)
#pragma unroll
            for (int n = 0; n < 2; ++n) sc[bj][n] = *(const f32x4*)(pscale + col0 + bj * 32 + 4 * n);
#pragma unroll
        for (int ai = 0; ai < 2; ++ai)
#pragma unroll
            for (int m = 0; m < 4; ++m) { u32x4 w[2];
#pragma unroll
                for (int bj = 0; bj < 2; ++bj) { const f32x4 v0 = acc[ai][bj][m][0] * sc[bj][0], v1 = acc[ai][bj][m][1] * sc[bj][1];
                    w[bj].x = pk2(v0[0], v0[1]); w[bj].y = pk2(v0[2], v0[3]); w[bj].z = pk2(v1[0], v1[1]); w[bj].w = pk2(v1[2], v1[3]); }
                store_lines(Ob, (size_t)(row0 + ai * HALF + m * 16), ldc, colw, fr, fq, w[0], w[1]); }
    } else {
        const bf16_t* gate = (const bf16_t*)(ws + WS_PROJ) + PC_G + 2 * D;
#pragma unroll
        for (int ai = 0; ai < 2; ++ai)
#pragma unroll
            for (int m = 0; m < 4; ++m) { const size_t row = (size_t)(row0 + ai * HALF + m * 16); u32x4 w[2];
#pragma unroll
                for (int bj = 0; bj < 2; ++bj) { const int col = col0 + bj * 32;
                    const u32x4 gw = *(const u32x4*)(gate + row * DIN + col);
                    const float ga[8] = {bflo(gw.x), bfhi(gw.x), bflo(gw.y), bfhi(gw.y), bflo(gw.z), bfhi(gw.z), bflo(gw.w), bfhi(gw.w)};
                    float f[8];
#pragma unroll
                    for (int j = 0; j < 8; ++j) f[j] = __builtin_amdgcn_rcpf(1.0f + __builtin_amdgcn_exp2f(-fmaxf(ga[j], -30.f) * LOG2E));
                    const f32x4 v0 = acc[ai][bj][m][0] * (f32x4){f[0], f[1], f[2], f[3]}, v1 = acc[ai][bj][m][1] * (f32x4){f[4], f[5], f[6], f[7]};
                    w[bj].x = pk2(v0[0], v0[1]); w[bj].y = pk2(v0[2], v0[3]); w[bj].z = pk2(v1[0], v1[1]); w[bj].w = pk2(v1[2], v1[3]); }
                store_lines(Ob, row, ldc, colw, fr, fq, w[0], w[1]);
                asm volatile("" ::: "memory"); }
    }
}
DI void merge_carry(f32x4 (&acc)[2][2][4][2], unsigned char* ws, const Unit& u, int z, int wr, int wc, int fr, int fq) {
    const int row0 = u.pm * BM + wr * 64 + fr, col0 = u.pn * BM + wc * 64 + 8 * fq;
    const bf16_t* gate = (const bf16_t*)(ws + WS_PROJ) + PC_G + (size_t)z * D;
#pragma unroll
    for (int ai = 0; ai < 2; ++ai)
#pragma unroll
        for (int m = 0; m < 4; ++m) { const size_t row = (size_t)(row0 + ai * HALF + m * 16);
#pragma unroll
            for (int bj = 0; bj < 2; ++bj) { const int col = col0 + bj * 32;
                const u32x4 gw = *(const u32x4*)(gate + row * DIN + col), hw = *(const u32x4*)(gate + row * DIN + D + col);
                const float ga[8] = {bflo(gw.x), bfhi(gw.x), bflo(gw.y), bfhi(gw.y), bflo(gw.z), bfhi(gw.z), bflo(gw.w), bfhi(gw.w)};
                const float gb[8] = {bflo(hw.x), bfhi(hw.x), bflo(hw.y), bfhi(hw.y), bflo(hw.z), bfhi(hw.z), bflo(hw.w), bfhi(hw.w)};
                float f[8];
#pragma unroll
                for (int j = 0; j < 8; ++j) { const float ea = __builtin_amdgcn_exp2f(-fmaxf(ga[j], -30.f) * LOG2E), eb = __builtin_amdgcn_exp2f(-fmaxf(gb[j], -30.f) * LOG2E);
                    f[j] = (1.0f + eb) * __builtin_amdgcn_rcpf(1.0f + ea); }
                acc[ai][bj][m][0] = acc[ai][bj][m][0] * (f32x4){f[0], f[1], f[2], f[3]}; acc[ai][bj][m][1] = acc[ai][bj][m][1] * (f32x4){f[4], f[5], f[6], f[7]};
                asm volatile("" ::: "memory"); } }
}

DI void gemm_phase(LAS unsigned char* lds, int ph, unsigned char* ws, unsigned char* wg, int l, const float* pscale, int G, int cidx, int nx) {
    int tid_ = threadIdx.x; asm volatile("" : "+v"(tid_));
    const int tid = tid_, wid = __builtin_amdgcn_readfirstlane(tid >> 6), lane = tid & 63, wr = wid >> 2, wc = wid & 3, fr = lane & 15, fq = lane >> 4;
    const Cfg g0 = gemm_cfg(ph, ws, wg, l);
    const int nt = g0.K / BK, lda = g0.lda, ldb = g0.ldb, lz = g0.lz, ntzm = (1 << g0.lz) - 1;
    const size_t zAb = (size_t)g0.zA * 2, zBb = (size_t)g0.zB * 2;
    Sched S; S.init(MC, g0.N, 1, G, cidx, nx);
    unsigned voffA[2], voffB[2];
#pragma unroll
    for (int i = 0; i < 2; ++i) { int R, C; stage_rc(tid * 16 + i * 8192, R, C); const int Rb = (R >> 5) * 64 + perm32(R & 31);
        voffA[i] = (unsigned)(R * lda + C) * 2u; voffB[i] = (unsigned)(Rb * ldb + C) * 2u; }
    const size_t kstep = (size_t)(BK * 2);
    const size_t hstepA = (size_t)HALF * lda * 2, hstepB = (size_t)32 * ldb * 2;
    const unsigned ldsw = (unsigned)wid * 1024u;
    const int aoff = lds_byte(wr * 64 + fr, fq * 8), boff = lds_byte(wc * 32 + fr, fq * 8);
#define PG8_SA(b, h) (((b) * 2 + (h)) * HTB)
#define PG8_SB(b, h) ((4 + (b) * 2 + (h)) * HTB)
#define PG8_STAGE(bufoff, gbase, voff) do { _Pragma("unroll") for (int _i = 0; _i < 2; ++_i) \
        __builtin_amdgcn_global_load_lds((const unsigned*)((const char*)(gbase) + (voff)[_i]), (LAS unsigned*)(lds + (bufoff) + ldsw + _i * 8192), 16, 0, 0); } while (0)
#define PG8_LDA(dst, b, h) do { _Pragma("unroll") for (int m = 0; m < 4; ++m) _Pragma("unroll") for (int k = 0; k < 2; ++k) dst[m][k] = *(const LAS bf16x8*)(lds + PG8_SA(b, h) + aoff + m * 2048 + k * 1024); } while (0)
#define PG8_LDB(dst, b, h) do { _Pragma("unroll") for (int n = 0; n < 2; ++n) _Pragma("unroll") for (int k = 0; k < 2; ++k) dst[n][k] = *(const LAS bf16x8*)(lds + PG8_SB(b, h) + boff + n * 2048 + k * 1024); } while (0)
#define PG8_MMA(ai, bj, At, Bt) do { __builtin_amdgcn_s_setprio(1); _Pragma("unroll") for (int m = 0; m < 4; ++m) _Pragma("unroll") for (int n = 0; n < 2; ++n) _Pragma("unroll") for (int k = 0; k < 2; ++k) \
        acc[ai][bj][m][n] = __builtin_amdgcn_mfma_f32_16x16x32_bf16(Bt[n][k], At[m][k], acc[ai][bj][m][n], 0, 0, 0); __builtin_amdgcn_s_setprio(0); } while (0)
#define PG8_WAIT_V(n) asm volatile("s_waitcnt vmcnt(" #n ")" ::: "memory")
#define PG8_WAIT_L(n) asm volatile("s_waitcnt lgkmcnt(" #n ")" ::: "memory")
#define PG8_BAR __builtin_amdgcn_s_barrier()
#define PG8_SCHED __builtin_amdgcn_sched_barrier(0)
#define PG8_ABASE(u) ((const char*)gx.A + (size_t)(u).pm * tstepA + (size_t)(u).pn * gx.pnA * 2)
#define PG8_BBASE(u) ((const char*)gx.Bt + (size_t)(u).pn * tstepB)
#define PG8_KA(t_) (cA + (size_t)((t_) >> lz) * zAb + (size_t)((t_) & ntzm) * kstep)
#define PG8_KB(t_) (cB + (size_t)((t_) >> lz) * zBb + (size_t)((t_) & ntzm) * kstep)
#define PG8_RECFG() int phx = ph; int lx = l; unsigned char* wsx = ws; unsigned char* wgx = wg; asm volatile("" : "+s"(phx), "+s"(lx), "+s"(wsx), "+s"(wgx)); const Cfg gx = gemm_cfg(phx, wsx, wgx, lx); \
        const size_t tstepA = (size_t)BM * gx.lda * 2, tstepB = (size_t)BM * gx.ldb * 2
    Unit cur, nxt; int ui = 0;
    if (!S.next(0, cur)) return;
    f32x4 acc[2][2][4][2];
#pragma unroll
    for (int a = 0; a < 2; ++a)
#pragma unroll
        for (int b = 0; b < 2; ++b)
#pragma unroll
            for (int m = 0; m < 4; ++m)
#pragma unroll
                for (int n = 0; n < 2; ++n) acc[a][b][m][n] = (f32x4){0.f, 0.f, 0.f, 0.f};
    bf16x8 At[4][2], B0[2][2], B1[2][2];
    const char* cA; const char* cB; { PG8_RECFG(); cA = PG8_ABASE(cur); cB = PG8_BBASE(cur); }
    PG8_STAGE(PG8_SB(0, 0), cB, voffB); PG8_STAGE(PG8_SB(0, 1), cB + hstepB, voffB); PG8_STAGE(PG8_SA(0, 0), cA, voffA); PG8_STAGE(PG8_SA(0, 1), cA + hstepA, voffA);
    if (wr == 1) PG8_BAR;
    PG8_WAIT_V(2); PG8_BAR;
    PG8_STAGE(PG8_SB(1, 0), cB + kstep, voffB); PG8_STAGE(PG8_SA(1, 0), cA + kstep, voffA); PG8_STAGE(PG8_SB(1, 1), cB + hstepB + kstep, voffB);
    PG8_WAIT_V(6); PG8_BAR;
    for (;;) {
        const bool has_next = S.next(ui + 1, nxt);
        const char* nA = cA; const char* nB = cB; if (has_next) { PG8_RECFG(); nA = PG8_ABASE(nxt); nB = PG8_BBASE(nxt); }
        for (int t = 0; t < nt; t += 2) {
            const bool last = (t == nt - 2);
            const char* a1 = PG8_KA(t + 1);
            const char* a2 = last ? nA : PG8_KA(t + 2); const char* b2 = last ? nB : PG8_KB(t + 2);
            const char* a3 = a2 + kstep; const char* b3 = b2 + kstep;
            if (zAb != 0 && t != 0 && (t & ntzm) == 0) { unsigned char* wsx = ws; asm volatile("" : "+s"(wsx)); int frx = fr; asm volatile("" : "+v"(frx)); merge_carry(acc, wsx, cur, (t >> lz) - 1, wr, wc, frx, fq); }
            PG8_LDB(B0, 0, 0); PG8_LDB(B1, 0, 1); PG8_SCHED; PG8_LDA(At, 0, 0); PG8_STAGE(PG8_SA(1, 1), a1 + hstepA, voffA);
            PG8_WAIT_V(8); PG8_WAIT_L(0); PG8_BAR; PG8_MMA(0, 0, At, B0); PG8_MMA(0, 1, At, B1); PG8_BAR; PG8_SCHED;
            PG8_LDA(At, 0, 1); PG8_STAGE(PG8_SB(0, 0), b2, voffB); PG8_STAGE(PG8_SB(0, 1), b2 + hstepB, voffB); PG8_STAGE(PG8_SA(0, 0), a2, voffA);
            PG8_WAIT_V(8); PG8_WAIT_L(0); PG8_BAR; PG8_MMA(1, 0, At, B0); PG8_MMA(1, 1, At, B1); PG8_BAR; PG8_SCHED;
            PG8_LDB(B0, 1, 0); PG8_LDB(B1, 1, 1); PG8_SCHED; PG8_LDA(At, 1, 0); PG8_STAGE(PG8_SA(0, 1), a2 + hstepA, voffA);
            PG8_WAIT_V(8); PG8_WAIT_L(0); PG8_BAR; PG8_MMA(0, 0, At, B0); PG8_MMA(0, 1, At, B1); PG8_BAR; PG8_SCHED;
            PG8_LDA(At, 1, 1); PG8_STAGE(PG8_SB(1, 0), b3, voffB); PG8_STAGE(PG8_SB(1, 1), b3 + hstepB, voffB); PG8_STAGE(PG8_SA(1, 0), a3, voffA);
            PG8_WAIT_V(8); PG8_WAIT_L(0); PG8_BAR; PG8_MMA(1, 0, At, B0); PG8_MMA(1, 1, At, B1); PG8_BAR; PG8_SCHED;
        }
        if (wr == 0) PG8_BAR;
        { int phx = ph; unsigned char* wsx = ws; asm volatile("" : "+s"(phx), "+s"(wsx)); int frx = fr; asm volatile("" : "+v"(frx)); epilogue(acc, phx, wsx, pscale, cur, wr, wc, frx, fq); }
        if (!has_next) break;
#pragma unroll
        for (int a = 0; a < 2; ++a)
#pragma unroll
            for (int b = 0; b < 2; ++b)
#pragma unroll
                for (int m = 0; m < 4; ++m)
#pragma unroll
                    for (int n = 0; n < 2; ++n) acc[a][b][m][n] = (f32x4){0.f, 0.f, 0.f, 0.f};
        cur = nxt; cA = nA; cB = nB; ++ui;
        if (wr == 1) PG8_BAR;
    }
    PG8_WAIT_V(0);
    PG8_BAR;
#undef PG8_SA
#undef PG8_SB
#undef PG8_STAGE
#undef PG8_LDA
#undef PG8_LDB
#undef PG8_MMA
#undef PG8_WAIT_V
#undef PG8_WAIT_L
#undef PG8_BAR
#undef PG8_SCHED
#undef PG8_ABASE
#undef PG8_BBASE
#undef PG8_RECFG
#undef PG8_KA
#undef PG8_KB
}
}

DI void transpose_item(const float* W, int K, int N, bf16_t* WT, int drow0, LAS float* scr, int k0, int n0, int lane) {
#pragma unroll 8
    for (int i = 0; i < 32; ++i) { const int kk = 2 * i + (lane >> 5); scr[kk * 33 + (lane & 31)] = W[(size_t)(k0 + kk) * N + n0 + (lane & 31)]; }
    asm volatile("s_waitcnt lgkmcnt(0)" ::: "memory");
    const int c = lane & 7;
#pragma unroll
    for (int j = 0; j < 4; ++j) { const int n = (lane >> 3) + 8 * j; const LAS float* s = scr + (8 * c) * 33 + n;
        u32x4 o; o.x = pk2(s[0 * 33], s[1 * 33]); o.y = pk2(s[2 * 33], s[3 * 33]); o.z = pk2(s[4 * 33], s[5 * 33]); o.w = pk2(s[6 * 33], s[7 * 33]);
        *(u32x4*)(WT + (size_t)(drow0 + n) * K + k0 + 8 * c) = o; }
    asm volatile("s_waitcnt lgkmcnt(0)" ::: "memory");
}
DI int win_perm(int n) {
    if (n < 1024) return PC_Q + n;
    if (n < 1280) return PC_K + (n - 1024);
    if (n < 1536) return PC_V + (n - 1280);
    if (n < 2560) return PC_X + (n - 1536);
    if (n < 3584) return PC_Y + (n - 2560);
    if (n < 4608) return PC_P + (n - 3584);
    return n;
}

struct Params {
    const float* in[22]; float* out; unsigned char* ws; float inv_freq[8]; int lo, hi;
};
enum { I_X = 0, I_NMIXPRE, I_NMIXPOST, I_WIN, I_SINKS, I_WATT, I_CONVW, I_CONVB, I_WRGA, I_BRGA, I_WRGI, I_BRGI, I_LAM, I_WRNN, I_WPG, I_PSCALE, I_WPOOL, I_WOUT, I_NMLPPRE, I_NMLPPOST, I_WUP, I_WDN };

DI void prologue(const Params& p, LAS unsigned char* lds, int l_lo, int l_hi, bool do_rope, int gw, int NGW, int wave, int lane) {
    LAS float* scr = (LAS float*)(lds + wave * 16384);
    bf16_t* Wall = (bf16_t*)(p.ws + WS_W);
    constexpr int IT_IN = 16 * 240, IT_SQ = 512, IT_PG = 128, IT_UP = 2048, IT_DN = 2048, IT_RG = 32;
    constexpr int IT_LAYER = IT_IN + 4 * IT_SQ + IT_PG + IT_UP + IT_DN + 2 * IT_RG;
    for (int it = l_lo * IT_LAYER + gw; it < IT_LAYER * l_hi; it += NGW) {
        const int l = it / IT_LAYER; int r = it - l * IT_LAYER; bf16_t* Wl = Wall + (size_t)l * WO_LAYER;
        if (r < IT_IN) { const int kb = r / 240, nb = r % 240; transpose_item(p.in[I_WIN] + (size_t)l * D * DIN, D, DIN, Wl + WO_IN, win_perm(nb * 32), scr, kb * 64, nb * 32, lane); continue; } r -= IT_IN;
        if (r < 4 * IT_SQ) { const int which = r / IT_SQ; r -= which * IT_SQ; const int kb = r / 32, nb = r % 32;
            const float* src = (which == 0 ? p.in[I_WATT] : which == 1 ? p.in[I_WRNN] : which == 2 ? p.in[I_WPOOL] : p.in[I_WOUT]) + (size_t)l * D * D;
            bf16_t* dst = which < 3 ? Wl + WO_BR + (size_t)which * D * D : Wl + WO_OUT;
            transpose_item(src, D, D, dst, nb * 32, scr, kb * 64, nb * 32, lane); continue; } r -= 4 * IT_SQ;
        if (r < IT_PG) { const int gq = r / 32; r -= gq * 32; const int kb = r / 8, nb = r % 8;
            transpose_item(p.in[I_WPG] + ((size_t)l * 4 + gq) * 65536, 256, 256, Wl + WO_PG, gq * 256 + nb * 32, scr, kb * 64, nb * 32, lane); continue; } r -= IT_PG;
        if (r < IT_UP) { const int kb = r / 128, nb = r % 128; transpose_item(p.in[I_WUP] + (size_t)l * D * DFF, D, DFF, Wl + WO_UP, nb * 32, scr, kb * 64, nb * 32, lane); continue; } r -= IT_UP;
        if (r < IT_DN) { const int kb = r / 32, nb = r % 32; transpose_item(p.in[I_WDN] + (size_t)l * DFF * D, DFF, D, Wl + WO_DN, nb * 32, scr, kb * 64, nb * 32, lane); continue; } r -= IT_DN;
        { const int which = r / IT_RG; r -= which * IT_RG; const int hb = r / 2, nb = r % 2;
          transpose_item((which ? p.in[I_WRGI] : p.in[I_WRGA]) + ((size_t)l * 16 + hb) * 4096, 64, 64, Wl + (which ? WO_RI : WO_RA), hb * 64 + nb * 32, scr, 0, nb * 32, lane); }
    }
    float* rope = (float*)(p.ws + WS_ROPE);
    if (do_rope) for (int i = gw * 64 + lane; i < SEQ * 8; i += NGW * 64) {
        const int pos = i >> 3, j = i & 7;
        const float ang = (float)pos * p.inv_freq[j];
        const double a = (double)ang * 0.15915494309189535; const double n = __builtin_rint(a); const float fr = (float)(a - n);
        rope[pos * 16 + j] = __builtin_amdgcn_cosf(fr); rope[pos * 16 + 8 + j] = __builtin_amdgcn_sinf(fr);
    }
}

DI void rowpass(const float* hsrc, const bf16_t* mix, const float* gpost, const float* gnext, float* hdst, bf16_t* hb, int gw, int NGW, int lane) {
    for (int m0 = gw * 2; m0 < MC; m0 += NGW * 2) {
        f32x4 hv[2][4], mv[2][4];
#pragma unroll
        for (int r = 0; r < 2; ++r)
#pragma unroll
            for (int j = 0; j < 4; ++j) hv[r][j] = __builtin_nontemporal_load((const f32x4*)(hsrc + (size_t)(m0 + r) * D + 256 * j + 4 * lane));
        if (mix) {
#pragma unroll
            for (int r = 0; r < 2; ++r)
#pragma unroll
                for (int j = 0; j < 4; ++j) { const u32x2 w = __builtin_nontemporal_load((const u32x2*)(mix + (size_t)(m0 + r) * D + 256 * j + 4 * lane)); mv[r][j] = (f32x4){bflo(w.x), bfhi(w.x), bflo(w.y), bfhi(w.y)}; }
            float ss[2] = {0.f, 0.f};
#pragma unroll
            for (int r = 0; r < 2; ++r)
#pragma unroll
                for (int j = 0; j < 4; ++j) ss[r] += (mv[r][j].x * mv[r][j].x + mv[r][j].y * mv[r][j].y) + (mv[r][j].z * mv[r][j].z + mv[r][j].w * mv[r][j].w);
#pragma unroll
            for (int o = 1; o < 64; o <<= 1) { ss[0] += __shfl_xor(ss[0], o); ss[1] += __shfl_xor(ss[1], o); }
#pragma unroll
            for (int r = 0; r < 2; ++r) { const float rs = 1.0f / sqrtf(ss[r] * (1.0f / D) + EPS);
#pragma unroll
                for (int j = 0; j < 4; ++j) { const f32x4 gp = *(const f32x4*)(gpost + 256 * j + 4 * lane); hv[r][j] += mv[r][j] * rs * gp; *(f32x4*)(hdst + (size_t)(m0 + r) * D + 256 * j + 4 * lane) = hv[r][j]; } }
        }
        if (gnext) {
            float ss[2] = {0.f, 0.f};
#pragma unroll
            for (int r = 0; r < 2; ++r)
#pragma unroll
                for (int j = 0; j < 4; ++j) ss[r] += (hv[r][j].x * hv[r][j].x + hv[r][j].y * hv[r][j].y) + (hv[r][j].z * hv[r][j].z + hv[r][j].w * hv[r][j].w);
#pragma unroll
            for (int o = 1; o < 64; o <<= 1) { ss[0] += __shfl_xor(ss[0], o); ss[1] += __shfl_xor(ss[1], o); }
#pragma unroll
            for (int r = 0; r < 2; ++r) { const float rs = 1.0f / sqrtf(ss[r] * (1.0f / D) + EPS);
#pragma unroll
                for (int j = 0; j < 4; ++j) { const f32x4 gn = *(const f32x4*)(gnext + 256 * j + 4 * lane); const f32x4 o = hv[r][j] * rs * gn;
                    u32x2 w; w.x = pk2(o.x, o.y); w.y = pk2(o.z, o.w); *(u32x2*)(hb + (size_t)(m0 + r) * D + 256 * j + 4 * lane) = w; } }
        }
    }
}

DI void rope8(u32x4& v, const u32x4& pr, const float* tab, bool second) {
    const f32x4 c0 = *(const f32x4*)tab, c1 = *(const f32x4*)(tab + 4), s0 = *(const f32x4*)(tab + 8), s1 = *(const f32x4*)(tab + 12);
    const float sg = second ? 1.f : -1.f;
    float x[8] = {bflo(v.x), bfhi(v.x), bflo(v.y), bfhi(v.y), bflo(v.z), bfhi(v.z), bflo(v.w), bfhi(v.w)};
    const float y[8] = {bflo(pr.x), bfhi(pr.x), bflo(pr.y), bfhi(pr.y), bflo(pr.z), bfhi(pr.z), bflo(pr.w), bfhi(pr.w)};
    const float cs[8] = {c0.x, c0.y, c0.z, c0.w, c1.x, c1.y, c1.z, c1.w}, sn[8] = {s0.x, s0.y, s0.z, s0.w, s1.x, s1.y, s1.z, s1.w};
#pragma unroll
    for (int j = 0; j < 8; ++j) x[j] = x[j] * cs[j] + sg * y[j] * sn[j];
    v.x = pk2(x[0], x[1]); v.y = pk2(x[2], x[3]); v.z = pk2(x[4], x[5]); v.w = pk2(x[6], x[7]);
}
constexpr int KS_LD = 72, VT_LD = 260, ATT_VT_OFF = 256 * KS_LD * 2;
DI void attn_unit(LAS unsigned char* lds, bf16_t* P, const float* rope, const float* sinks, int unit, int tid, int wid, int lane) {
    const int kvh = unit & 3, n = (unit >> 2) & 63, b = unit >> 8;
    const long rowblk = (long)b * SEQ + n * 128;
    LAS bf16_t* Ks = (LAS bf16_t*)lds; LAS bf16_t* Vt = (LAS bf16_t*)(lds + ATT_VT_OFF);
#pragma unroll
    for (int i = 0; i < 4; ++i) {
        const int pc = tid + 512 * i, key = pc >> 3, dg = pc & 7;
        const bool valid = (n > 0) || key >= 128;
        u32x4 kv = {0u, 0u, 0u, 0u}, vv = {0u, 0u, 0u, 0u};
        if (valid) { const bf16_t* src = P + (size_t)(rowblk - 128 + key) * DIN + kvh * 64 + dg * 8; kv = *(const u32x4*)(src + PC_K); vv = *(const u32x4*)(src + PC_V); }
        u32x4 pr; pr.x = __shfl_xor(kv.x, 1); pr.y = __shfl_xor(kv.y, 1); pr.z = __shfl_xor(kv.z, 1); pr.w = __shfl_xor(kv.w, 1);
        if (dg < 2) { const int pos = valid ? (n * 128 - 128 + key) : 0; rope8(kv, pr, rope + pos * 16, dg == 1); }
        *(LAS u32x4*)(Ks + key * KS_LD + dg * 8) = kv;
        const unsigned vw[4] = {vv.x, vv.y, vv.z, vv.w};
#pragma unroll
        for (int j = 0; j < 4; ++j) { Vt[(dg * 8 + 2 * j) * VT_LD + key] = (bf16_t)(vw[j] & 0xffffu); Vt[(dg * 8 + 2 * j + 1) * VT_LD + key] = (bf16_t)(vw[j] >> 16); }
    }
    __syncthreads();
    const int g = wid >> 1, head = kvh * 4 + g, q = lane & 31, hl = lane >> 5;
    const float sinkv = sinks[head] * LOG2E;
    const float cscale = 0.125f * LOG2E;
#pragma unroll 1
    for (int sb = 0; sb < 2; ++sb) {
        const int r0 = 64 * (wid & 1) + 32 * sb;
        bf16_t* qrow = P + (size_t)(rowblk + r0 + q) * DIN + PC_Q + head * 64;
        u32x4 qf[4];
#pragma unroll
        for (int s = 0; s < 4; ++s) qf[s] = *(const u32x4*)(qrow + 16 * s + 8 * hl);
        { u32x4 pr; pr.x = __shfl_xor(qf[0].x, 32); pr.y = __shfl_xor(qf[0].y, 32); pr.z = __shfl_xor(qf[0].z, 32); pr.w = __shfl_xor(qf[0].w, 32);
          rope8(qf[0], pr, rope + (n * 128 + r0 + q) * 16, hl == 1); }
        f32x16 S[5];
#pragma unroll
        for (int kt = 0; kt < 5; ++kt) {
#pragma unroll
            for (int i = 0; i < 16; ++i) S[kt][i] = 0.f;
#pragma unroll
            for (int s = 0; s < 4; ++s) { const bf16x8 kf = *(const LAS bf16x8*)(Ks + (r0 + 32 * kt + q) * KS_LD + 16 * s + 8 * hl);
                S[kt] = MFMA32(kf, __builtin_bit_cast(bf16x8, qf[s]), S[kt]); }
        }
#pragma unroll
        for (int i = 0; i < 16; ++i) { const int kl = 8 * (i >> 2) + 4 * hl + (i & 3);
            if (kl <= q) S[0][i] = -1e30f;
            if (kl > q) S[4][i] = -1e30f; }
        if (n == 0) {
#pragma unroll
            for (int kt = 0; kt < 4; ++kt) if (r0 + 32 * kt < 128) {
#pragma unroll
                for (int i = 0; i < 16; ++i) S[kt][i] = -1e30f; }
        }
        float mx = -1e30f;
#pragma unroll
        for (int kt = 0; kt < 5; ++kt)
#pragma unroll
            for (int i = 0; i < 16; ++i) mx = fmaxf(mx, S[kt][i]);
        mx = fmaxf(mx, __shfl_xor(mx, 32));
        const float M2 = fmaxf(mx * cscale, sinkv);
        float l = 0.f;
#pragma unroll
        for (int kt = 0; kt < 5; ++kt)
#pragma unroll
            for (int i = 0; i < 16; ++i) { const float pv = __builtin_amdgcn_exp2f(S[kt][i] * cscale - M2); l += pv; S[kt][i] = pv; }
        l += __shfl_xor(l, 32);
        l += __builtin_amdgcn_exp2f(sinkv - M2);
        const float inv = __builtin_amdgcn_rcpf(l);
        f32x16 O[2];
#pragma unroll
        for (int i = 0; i < 16; ++i) { O[0][i] = 0.f; O[1][i] = 0.f; }
#pragma unroll
        for (int kt = 0; kt < 5; ++kt)
#pragma unroll
            for (int s2 = 0; s2 < 2; ++s2) {
                u32x4 pw; pw.x = pk2(S[kt][8 * s2 + 0], S[kt][8 * s2 + 1]); pw.y = pk2(S[kt][8 * s2 + 2], S[kt][8 * s2 + 3]); pw.z = pk2(S[kt][8 * s2 + 4], S[kt][8 * s2 + 5]); pw.w = pk2(S[kt][8 * s2 + 6], S[kt][8 * s2 + 7]);
                const bf16x8 pf = __builtin_bit_cast(bf16x8, pw);
#pragma unroll
                for (int dt = 0; dt < 2; ++dt) {
                    const LAS bf16_t* vp = Vt + (32 * dt + q) * VT_LD + r0 + 32 * kt + 16 * s2 + 4 * hl;
                    const u32x2 v0 = *(const LAS u32x2*)vp, v1 = *(const LAS u32x2*)(vp + 8);
                    u32x4 vw; vw.x = v0.x; vw.y = v0.y; vw.z = v1.x; vw.w = v1.y;
                    O[dt] = MFMA32(__builtin_bit_cast(bf16x8, vw), pf, O[dt]);
                }
            }
        bf16_t* orow = qrow;
#pragma unroll
        for (int dt = 0; dt < 2; ++dt)
#pragma unroll
            for (int a = 0; a < 4; ++a) { u32x2 w; w.x = pk2(O[dt][4 * a] * inv, O[dt][4 * a + 1] * inv); w.y = pk2(O[dt][4 * a + 2] * inv, O[dt][4 * a + 3] * inv);
                *(u32x2*)(orow + 32 * dt + 8 * a + 4 * hl) = w; }
    }
    __syncthreads();
}

constexpr int NCH = SEQ / 128;
DI void rnn_phase(LAS unsigned char* lds, bf16_t* P, const bf16_t* WaT, const bf16_t* WiT, const float* convw, const float* convb, const float* ba, const float* bi, const float* lam,
                  f32x2* sums, bool fin, int bx, int G, int tid, int wid, int lane) {
    constexpr int NU = BPC * NCH * 16;
    LAS float* XC = (LAS float*)lds; LAS float* AA = (LAS float*)(lds + 32768); LAS bf16_t* XB = (LAS bf16_t*)(lds + 65536); LAS bf16_t* WL = (LAS bf16_t*)(lds + 83968);
    LAS float* SG = (LAS float*)(lds + 102400); LAS float* PF = (LAS float*)(lds + 106496); LAS float* CW = (LAS float*)(lds + 110592);
    const int t = tid >> 2, cq = tid & 3;
    const int tt = wid >> 1, nt = wid & 1, l32 = lane & 31, hl = lane >> 5;
    int cur_hbk = -1; float bac = 0.f, bic = 0.f, k8c = 0.f;
    u32x4 xr[4][2];
#define RNN_LOAD_XR(uu) do { const int hb_ = (uu) & 15, c_ = ((uu) >> 4) & 63, b_ = (uu) >> 10; const size_t rb_ = (size_t)b_ * SEQ + c_ * 128; \
        _Pragma("unroll") for (int tap = 0; tap < 4; ++tap) { const int tp_ = c_ * 128 + t + tap - 3; \
            if (tp_ >= 0) { const bf16_t* src_ = P + (rb_ + t + tap - 3) * DIN + PC_X + hb_ * 64 + 16 * cq; xr[tap][0] = *(const u32x4*)src_; xr[tap][1] = *(const u32x4*)(src_ + 8); } \
            else { xr[tap][0] = (u32x4){0u, 0u, 0u, 0u}; xr[tap][1] = (u32x4){0u, 0u, 0u, 0u}; } } } while (0)
    int u = bx; if (u >= NU) return;
    RNN_LOAD_XR(u);
    for (; u < NU; u += G) {
        const int hbk = u & 15, c = (u >> 4) & 63, b = u >> 10;
        const size_t rowbase = (size_t)b * SEQ + c * 128; const int ch0 = hbk * 64;
        if (hbk != cur_hbk) {
            const int nn = tid >> 3, k8 = tid & 7;
            *(LAS u32x4*)(WL + nn * 72 + 8 * k8) = *(const u32x4*)(WaT + (size_t)hbk * 4096 + nn * 64 + 8 * k8);
            *(LAS u32x4*)(WL + 64 * 72 + nn * 72 + 8 * k8) = *(const u32x4*)(WiT + (size_t)hbk * 4096 + nn * 64 + 8 * k8);
            if (tid < 320) CW[tid] = tid < 256 ? convw[(tid >> 6) * D + ch0 + (tid & 63)] : convb[ch0 + tid - 256];
            const int chg = ch0 + 32 * nt + l32;
            bac = ba[chg]; bic = bi[chg]; k8c = -8.0f * LOG2E * log1pf(expf(-lam[chg]));
            cur_hbk = hbk;
            __syncthreads();
        }
        unsigned short yv[16]; float Ap = 1.f, Hp = 0.f;
        bf16_t* yp = P + (rowbase + 16 * wid) * DIN + PC_Y + ch0 + lane;
        if (fin) {
#pragma unroll
            for (int j = 0; j < 16; ++j) yv[j] = yp[(size_t)j * DIN];
#pragma unroll
            for (int k = 0; k < 8; ++k) { const int j = 8 * wid + k; if (j < c) { const f32x2 sv = sums[((size_t)b * NCH + j) * D + ch0 + lane]; Hp = sv.x * Hp + sv.y; Ap *= sv.x; } }
        }
        {
            f32x4 acc[4];
#pragma unroll
            for (int j = 0; j < 4; ++j) acc[j] = *(const LAS f32x4*)(CW + 256 + 16 * cq + 4 * j);
#pragma unroll
            for (int tap = 0; tap < 4; ++tap) {
                const u32x4 x0 = xr[tap][0], x1 = xr[tap][1];
                const LAS float* wp = CW + tap * 64 + 16 * cq;
                const f32x4 w0 = *(const LAS f32x4*)wp, w1 = *(const LAS f32x4*)(wp + 4), w2 = *(const LAS f32x4*)(wp + 8), w3 = *(const LAS f32x4*)(wp + 12);
                acc[0] += (f32x4){bflo(x0.x), bfhi(x0.x), bflo(x0.y), bfhi(x0.y)} * w0; acc[1] += (f32x4){bflo(x0.z), bfhi(x0.z), bflo(x0.w), bfhi(x0.w)} * w1;
                acc[2] += (f32x4){bflo(x1.x), bfhi(x1.x), bflo(x1.y), bfhi(x1.y)} * w2; acc[3] += (f32x4){bflo(x1.z), bfhi(x1.z), bflo(x1.w), bfhi(x1.w)} * w3;
            }
#pragma unroll
            for (int j = 0; j < 4; ++j) *(LAS f32x4*)(XC + t * 64 + 16 * cq + 4 * j) = acc[j];
            u32x4 o0, o1; o0.x = pk2(acc[0].x, acc[0].y); o0.y = pk2(acc[0].z, acc[0].w); o0.z = pk2(acc[1].x, acc[1].y); o0.w = pk2(acc[1].z, acc[1].w);
            o1.x = pk2(acc[2].x, acc[2].y); o1.y = pk2(acc[2].z, acc[2].w); o1.z = pk2(acc[3].x, acc[3].y); o1.w = pk2(acc[3].z, acc[3].w);
            *(LAS u32x4*)(XB + t * 72 + 16 * cq) = o0; *(LAS u32x4*)(XB + t * 72 + 16 * cq + 8) = o1;
        }
        if (u + G < NU) RNN_LOAD_XR(u + G);
        if (fin) { PF[wid * 64 + lane] = Ap; PF[512 + wid * 64 + lane] = Hp; }
        __syncthreads();
        {
            f32x16 aR, aI;
#pragma unroll
            for (int i = 0; i < 16; ++i) { aR[i] = 0.f; aI[i] = 0.f; }
#pragma unroll
            for (int s = 0; s < 4; ++s) {
                const bf16x8 af = *(const LAS bf16x8*)(XB + (32 * tt + l32) * 72 + 16 * s + 8 * hl);
                const bf16x8 bR = *(const LAS bf16x8*)(WL + (32 * nt + l32) * 72 + 16 * s + 8 * hl);
                const bf16x8 bI = *(const LAS bf16x8*)(WL + 64 * 72 + (32 * nt + l32) * 72 + 16 * s + 8 * hl);
                aR = MFMA32(af, bR, aR); aI = MFMA32(af, bI, aI);
            }
            const int ch = 32 * nt + l32;
#pragma unroll
            for (int i = 0; i < 16; ++i) { const int tok = 32 * tt + 8 * (i >> 2) + 4 * hl + (i & 3);
                const float r = sigm(aR[i] + bac), ig = sigm(aI[i] + bic);
                const float a = __builtin_amdgcn_exp2f(k8c * r);
                const float mult = __builtin_amdgcn_sqrtf(fmaxf(1.0f - a * a, 0.f));
                const float xv = XC[tok * 64 + ch];
                AA[tok * 64 + ch] = a; XC[tok * 64 + ch] = mult * ig * xv; }
        }
        __syncthreads();
        {
            const int ch = lane, seg = wid;
            float A = 1.f, H = 0.f;
#pragma unroll
            for (int j = 0; j < 16; ++j) { const int tk = 16 * seg + j; const float a = AA[tk * 64 + ch], uu = XC[tk * 64 + ch]; H = a * H + uu; A *= a; }
            SG[seg * 64 + ch] = A; SG[512 + seg * 64 + ch] = H;
            __syncthreads();
            if (!fin) {
                if (wid == 0) { float Ac = 1.f, Hc = 0.f;
#pragma unroll
                    for (int s = 0; s < 8; ++s) { const float sa = SG[s * 64 + ch]; Hc = sa * Hc + SG[512 + s * 64 + ch]; Ac *= sa; }
                    sums[((size_t)b * NCH + c) * D + ch0 + ch] = (f32x2){Ac, Hc}; }
            } else {
                float h = 0.f;
#pragma unroll
                for (int w = 0; w < 8; ++w) h = PF[w * 64 + ch] * h + PF[512 + w * 64 + ch];
                for (int s = 0; s < seg; ++s) h = SG[s * 64 + ch] * h + SG[512 + s * 64 + ch];
#pragma unroll
                for (int j = 0; j < 16; ++j) { const int tk = 16 * seg + j; const float a = AA[tk * 64 + ch], uu = XC[tk * 64 + ch]; h = a * h + uu;
                    const float o = h * gelu_tanh(bf1(yv[j]));
                    yp[(size_t)j * DIN] = (bf16_t)(pk2(o, 0.f) & 0xffffu); }
            }
        }
        __syncthreads();
    }
#undef RNN_LOAD_XR
}

DI void pool_item(const bf16_t* P, bf16_t* pooled, int idx) {
    const int cg8 = idx & 127, run = idx >> 7; const size_t row0 = (size_t)run * 8; const int t0 = (int)(row0 & (SEQ - 1));
    const int ch = cg8 * 8, w = 2 << (ch >> 8);
    const bf16_t* src = P + PC_P + ch;
    float sum[8];
#pragma unroll
    for (int j = 0; j < 8; ++j) sum[j] = 0.f;
    for (int k = 1; k < w; ++k) if (t0 - k >= 0) { const u32x4 x = *(const u32x4*)(src + (row0 - k) * DIN);
        sum[0] += bflo(x.x); sum[1] += bfhi(x.x); sum[2] += bflo(x.y); sum[3] += bfhi(x.y); sum[4] += bflo(x.z); sum[5] += bfhi(x.z); sum[6] += bflo(x.w); sum[7] += bfhi(x.w); }
#pragma unroll
    for (int j = 0; j < 8; ++j) {
        const int t = t0 + j; const u32x4 x = *(const u32x4*)(src + (row0 + j) * DIN);
        const float cur[8] = {bflo(x.x), bfhi(x.x), bflo(x.y), bfhi(x.y), bflo(x.z), bfhi(x.z), bflo(x.w), bfhi(x.w)};
#pragma unroll
        for (int e = 0; e < 8; ++e) sum[e] += cur[e];
        const float ic = __builtin_amdgcn_rcpf((float)(t + 1 < w ? t + 1 : w));
        u32x4 o; o.x = pk2(sum[0] * ic - cur[0], sum[1] * ic - cur[1]); o.y = pk2(sum[2] * ic - cur[2], sum[3] * ic - cur[3]);
        o.z = pk2(sum[4] * ic - cur[4], sum[5] * ic - cur[5]); o.w = pk2(sum[6] * ic - cur[6], sum[7] * ic - cur[7]);
        *(u32x4*)(pooled + (row0 + j) * D + ch) = o;
        if (t - w + 1 >= 0) { const u32x4 y = *(const u32x4*)(src + (row0 + j - w + 1) * DIN);
            sum[0] -= bflo(y.x); sum[1] -= bfhi(y.x); sum[2] -= bflo(y.y); sum[3] -= bfhi(y.y); sum[4] -= bflo(y.z); sum[5] -= bfhi(y.z); sum[6] -= bflo(y.w); sum[7] -= bfhi(y.w); }
    }
}


#define XB_TMO      128
#define XB_XCNT(j)  (256  + 64 * (j))
#define XB_XSUB(j)  (1280 + 64 * (j))
#define XB_XGEN(j)  (2304 + 64 * (j))
#define XB_TOP      3328
#define XB_TOPGEN   3392
#define XCD_BAR_WORDS 3456
#define XB_SPIN_CAP (1u << 22)
DI unsigned xb_ld(unsigned* p)              { return __hip_atomic_load(p, __ATOMIC_RELAXED, __HIP_MEMORY_SCOPE_AGENT); }
DI unsigned xb_add(unsigned* p, unsigned v) { return __hip_atomic_fetch_add(p, v, __ATOMIC_RELAXED, __HIP_MEMORY_SCOPE_AGENT); }
DI unsigned xb_xcc_id() { return (unsigned)__builtin_amdgcn_s_getreg((3 << 11) | 20) & 0xFu; }
#define XB_SPIN(cond, bar) do { unsigned _sp = 0; while (cond) { __builtin_amdgcn_s_sleep(1); \
    if ((++_sp & 255u) == 0u) { if (xb_ld(&(bar)[XB_TMO])) break; if (_sp > XB_SPIN_CAP) { atomicAdd(&(bar)[XB_TMO], 1u); break; } } } } while (0)
struct XcdBarrier { unsigned* bar; unsigned x; volatile LAS unsigned* st; unsigned n; };
DI XcdBarrier xcd_barrier_post(unsigned* bar, volatile LAS unsigned* st, unsigned n) {
    XcdBarrier b; b.bar = bar; b.x = xb_xcc_id(); b.st = st; b.n = n;
    if (threadIdx.x == 0) (void)xb_add(&bar[XB_XCNT(b.x)], 1u);
    return b;
}
DI void xcd_barrier_complete(unsigned* bar, unsigned x, unsigned G, unsigned& nloc, unsigned& nx) {
    unsigned sum, cnt, mine, sp = 0u;
    for (;;) {
        sum = 0u; cnt = 0u; mine = 0u;
#pragma unroll
        for (unsigned j = 0; j < 16; ++j) { const unsigned c = xb_ld(&bar[XB_XCNT(j)]); sum += c; cnt += (c > 0u) ? 1u : 0u; mine = (j == x) ? c : mine; }
        if (sum == G) break;
        __builtin_amdgcn_s_sleep(1);
        if ((++sp & 255u) == 0u) { if (xb_ld(&bar[XB_TMO])) break; if (sp > XB_SPIN_CAP) { atomicAdd(&bar[XB_TMO], 1u); break; } }
    }
    nloc = mine > 0u ? mine : 1u; nx = cnt > 0u ? cnt : 1u;
}
DI void xcd_barrier(const XcdBarrier& b) {
    asm volatile("s_waitcnt vmcnt(0)" ::: "memory");
    __syncthreads();
    if (threadIdx.x == 0) {
        unsigned* bar = b.bar;
        __builtin_amdgcn_s_waitcnt(0);
        unsigned nloc = b.st[0], nx = b.st[1];
        if (nloc == 0u) { xcd_barrier_complete(bar, b.x, b.n, nloc, nx); b.st[0] = nloc; b.st[1] = nx; }
        const unsigned old = xb_add(&bar[XB_XSUB(b.x)], 1u);
        const unsigned gen = old / nloc;
        if (old + 1u == (gen + 1u) * nloc) {
            __builtin_amdgcn_fence(__ATOMIC_RELEASE, "agent");
            asm volatile("s_waitcnt vmcnt(0)" ::: "memory");
            const unsigned og = xb_add(&bar[XB_TOP], 1u);
            const unsigned tg = og / nx;
            if (og + 1u == (tg + 1u) * nx) xb_add(&bar[XB_TOPGEN], 1u);
            else XB_SPIN(xb_ld(&bar[XB_TOPGEN]) == tg, bar);
            __builtin_amdgcn_fence(__ATOMIC_ACQUIRE, "agent");
            xb_add(&bar[XB_XGEN(b.x)], 1u);
            asm volatile("s_waitcnt vmcnt(0)" ::: "memory");
        } else {
            XB_SPIN(xb_ld(&bar[XB_XGEN(b.x)]) == gen, bar);
            __builtin_amdgcn_fence(__ATOMIC_ACQUIRE, "agent");
            asm volatile("s_waitcnt vmcnt(0)" ::: "memory");
        }
    }
    __syncthreads();
}

__global__ void __launch_bounds__(512, 2) mega_fwd(Params p) {
    extern __shared__ __attribute__((aligned(16))) unsigned char lds_raw[];
    LAS unsigned char* lds = (LAS unsigned char*)lds_raw;
    cg::grid_group grid = cg::this_grid();
    const int Gfull = gridDim.x, bfull = blockIdx.x;
    const int half = (bfull & 7) >> 2, bx = (bfull >> 3) * 4 + (bfull & 3), G = Gfull >> 1, NGW = G * 8;
#define TID_LOCAL() int tid_ = threadIdx.x; asm volatile("" : "+v"(tid_)); const int tid = tid_, lane = tid & 63, wid = __builtin_amdgcn_readfirstlane(tid >> 6), gw = bx * 8 + wid; (void)lane; (void)gw; (void)tid
    volatile LAS unsigned* xst = (volatile LAS unsigned*)(lds + 131072 + 512);
    if (threadIdx.x < 2) xst[threadIdx.x] = 0u;
    __syncthreads();
    unsigned* ctl = (unsigned*)(p.ws + WS_CTL);
    XcdBarrier xbar = xcd_barrier_post(ctl + half * 4096, xst, (unsigned)G);
    unsigned* wflag = ctl + 8192 + 64;
    { TID_LOCAL(); const int gwf = bfull * 8 + wid; prologue(p, lds, 0, 1, true, gwf, Gfull * 8, wid, lane); }
    grid.sync();
    if (half == 1) {
        TID_LOCAL(); prologue(p, lds, 1, DEPTH, false, gw, NGW, wid, lane);
        asm volatile("s_waitcnt vmcnt(0)" ::: "memory"); __syncthreads();
        if (tid == 0) { __builtin_amdgcn_fence(__ATOMIC_RELEASE, "agent"); asm volatile("s_waitcnt vmcnt(0)" ::: "memory"); __hip_atomic_fetch_add(wflag, 1u, __ATOMIC_RELAXED, __HIP_MEMORY_SCOPE_AGENT); }
    }
    bool first = true, wready = (half == 1);
#define STEP_SYNC() do { if (!first) xcd_barrier(xbar); first = false; } while (0)
    for (int cj = 0; cj < NCHUNK / 2; ++cj) {
        const int ck = half * (NCHUNK / 2) + cj;
        { STEP_SYNC(); TID_LOCAL(); int ckx = ck; unsigned char* ws = p.ws + (size_t)half * HALF_STRIDE; asm volatile("" : "+s"(ckx), "+s"(ws));
            rowpass(p.in[I_X] + (size_t)ckx * MC * D, nullptr, nullptr, p.in[I_NMIXPRE], p.out + (size_t)ckx * MC * D, (bf16_t*)(ws + WS_HB), gw, NGW, lane); }
        for (int l = 0; l < DEPTH; ++l) {
            if (!wready && l >= 1) {
                if (threadIdx.x == 0) { unsigned sp = 0; while (__hip_atomic_load(wflag, __ATOMIC_RELAXED, __HIP_MEMORY_SCOPE_AGENT) < (unsigned)G) { __builtin_amdgcn_s_sleep(2); if (++sp > (1u << 24)) break; }
                    __builtin_amdgcn_fence(__ATOMIC_ACQUIRE, "agent"); asm volatile("s_waitcnt vmcnt(0)" ::: "memory"); }
                __syncthreads(); wready = true;
            }
            for (int ph = 0; ph < 9; ++ph) {
                STEP_SYNC();
                if (ph == 1) {
                    TID_LOCAL(); int lx = l; unsigned char* ws = p.ws + (size_t)half * HALF_STRIDE; unsigned char* wg = p.ws; asm volatile("" : "+s"(lx), "+s"(ws), "+s"(wg));
                    bf16_t* proj = (bf16_t*)(ws + WS_PROJ);
                    for (int u = bx; u < BPC * 64 * 4; u += G) attn_unit(lds, proj, (const float*)(wg + WS_ROPE), p.in[I_SINKS] + lx * 16, u, tid, wid, lane);
                    for (int idx = bx * 512 + tid; idx < (MC / 8) * 128; idx += G * 512) pool_item(proj, (bf16_t*)(ws + WS_POOLED), idx);
                }
                if (ph == 1 || ph == 2) {
                    TID_LOCAL(); int lx = l; unsigned char* ws = p.ws + (size_t)half * HALF_STRIDE; unsigned char* wg = p.ws; asm volatile("" : "+s"(lx), "+s"(ws), "+s"(wg));
                    const bf16_t* Wl = (const bf16_t*)(wg + WS_W) + (size_t)lx * WO_LAYER;
                    rnn_phase(lds, (bf16_t*)(ws + WS_PROJ), Wl + WO_RA, Wl + WO_RI, p.in[I_CONVW] + (size_t)lx * 4 * D, p.in[I_CONVB] + lx * D, p.in[I_BRGA] + lx * D, p.in[I_BRGI] + lx * D, p.in[I_LAM] + lx * D,
                              (f32x2*)(ws + WS_SUMS), ph == 2, bx, G, tid, wid, lane);
                }
                if (ph == 5 || ph == 8) {
                    TID_LOCAL(); int lx = l, ckx = ck; unsigned char* ws = p.ws + (size_t)half * HALF_STRIDE; asm volatile("" : "+s"(lx), "+s"(ckx), "+s"(ws));
                    const float* gpost = (ph == 5 ? p.in[I_NMIXPOST] : p.in[I_NMLPPOST]) + lx * D;
                    const float* gnext = ph == 5 ? p.in[I_NMLPPRE] + lx * D : (lx + 1 < DEPTH ? p.in[I_NMIXPRE] + (lx + 1) * D : nullptr);
                    float* hck = p.out + (size_t)ckx * MC * D;
                    rowpass(lx == 0 && ph == 5 ? p.in[I_X] + (size_t)ckx * MC * D : hck, (const bf16_t*)(ws + WS_PROJ + PROJ_MIX_OFF), gpost, gnext, hck, (bf16_t*)(ws + WS_HB), gw, NGW, lane);
                }
                if (ph == 0 || ph == 2 || ph == 3 || ph == 4 || ph == 6 || ph == 7) {
                    int lx = l; unsigned char* ws = p.ws + (size_t)half * HALF_STRIDE; unsigned char* wg = p.ws; asm volatile("" : "+s"(lx), "+s"(ws), "+s"(wg));
                    pg8::gemm_phase(lds, ph, ws, wg, lx, p.in[I_PSCALE] + lx * D, G, bx, (Gfull & 7) == 0 ? 4 : 1);
                }
            }
        }
    }
}

#ifndef MK_MULTI
#define MK_MULTI 0
#endif
extern "C" void kernel_launch(void* const* d_in, const int* in_sizes, int n_in, void* d_out, int out_size, void* d_ws, size_t ws_size, hipStream_t stream) {
    static int grid = 0;
    if (grid == 0) {
        if (n_in != 22 || ws_size < WS_END) { fprintf(stderr, "kernel_launch: unexpected n_in %d / ws_size %zu (need %zu)\n", n_in, ws_size, (size_t)WS_END); grid = -1; return; }
        int dev = 0, cus = 0, per_cu = 0;
        hipGetDevice(&dev); hipDeviceGetAttribute(&cus, hipDeviceAttributeMultiprocessorCount, dev);
        if (hipFuncSetAttribute((const void*)mega_fwd, hipFuncAttributeMaxDynamicSharedMemorySize, LDS_BYTES) != hipSuccess) { fprintf(stderr, "kernel_launch: hipFuncSetAttribute failed\n"); grid = -1; return; }
        if (hipOccupancyMaxActiveBlocksPerMultiprocessor(&per_cu, (const void*)mega_fwd, 512, LDS_BYTES) != hipSuccess || per_cu < 1) { fprintf(stderr, "kernel_launch: occupancy query gave %d\n", per_cu); per_cu = 1; }
        (void)hipGetLastError();
        grid = (cus * per_cu) & ~7;
        fprintf(stderr, "kernel_launch: grid %d (cus %d x %d)\n", grid, cus, per_cu);
    }
    if (grid < 0) return;
    if (hipMemsetAsync((char*)d_ws + WS_CTL, 0, CTL_ZERO_BYTES, stream) != hipSuccess) { fprintf(stderr, "kernel_launch: memset failed\n"); return; }
    Params p{};
    for (int i = 0; i < 22; ++i) p.in[i] = (const float*)d_in[i];
    p.out = (float*)d_out; p.ws = (unsigned char*)d_ws;
    for (int j = 0; j < 8; ++j) p.inv_freq[j] = (float)pow(500000.0, -(double)j / 8.0);
    p.lo = 0; p.hi = 0; void* args[] = {&p};
    hipError_t e = hipLaunchCooperativeKernel((const void*)mega_fwd, dim3(grid), dim3(512), args, LDS_BYTES, stream);
    if (e != hipSuccess) fprintf(stderr, "cooperative launch failed: %s (grid %d)\n", hipGetErrorString(e), grid);
}
```

```cpp
#include <hip/hip_runtime.h>
#include <hip/hip_cooperative_groups.h>
#include <cstdio>
#include <cstdint>
#include <cmath>
namespace cg = cooperative_groups;

#define LAS __attribute__((address_space(3)))
#define DI __device__ __forceinline__
typedef unsigned short bf16_t;
typedef short bf16x8 __attribute__((ext_vector_type(8)));
typedef short s16x4 __attribute__((ext_vector_type(4)));
typedef float f32x2 __attribute__((ext_vector_type(2)));
typedef float f32x4 __attribute__((ext_vector_type(4)));
typedef float f32x16 __attribute__((ext_vector_type(16)));
typedef unsigned u32x2 __attribute__((ext_vector_type(2)));
typedef unsigned u32x4 __attribute__((ext_vector_type(4)));
typedef __bf16 bf16x2_t __attribute__((ext_vector_type(2)));

constexpr int D = 1024, SEQ = 8192, BATCH = 8, DEPTH = 4, DIN = 7680, DFF = 4096;
constexpr int NCHUNK = 4, BPC = BATCH / NCHUNK, MC = BPC * SEQ;
constexpr int PC_Q = 0, PC_Y = 1024, PC_P = 2048, PC_K = 3072, PC_V = 3328, PC_X = 3584, PC_G = 4608;
constexpr size_t WO_IN = 0, WO_BR = WO_IN + (size_t)DIN * D, WO_OUT = WO_BR + 3ull * D * D, WO_PG = WO_OUT + (size_t)D * D, WO_UP = WO_PG + 4ull * 256 * 256,
                 WO_DN = WO_UP + (size_t)DFF * D, WO_RA = WO_DN + (size_t)DFF * D, WO_RI = WO_RA + 16ull * 64 * 64, WO_LAYER = WO_RI + 16ull * 64 * 64;
constexpr size_t MiB = 1ull << 20;
constexpr size_t WS_ROPE = 0, WS_W = 3 * MiB, WS_SUMS = 163 * MiB, WS_HB = 164 * MiB, WS_POOLED = 196 * MiB, WS_MERGED = 228 * MiB, WS_PROJ = 260 * MiB, HALF_STRIDE = 337 * MiB,
                 WS_CTL = 838 * MiB, WS_AU = 840 * MiB  , WS_END = 968 * MiB;
constexpr size_t CTL_ZERO_BYTES = 65536;
static_assert(WO_LAYER * 2 * DEPTH <= 160 * MiB, "weights fit");
static_assert((size_t)MC * DIN * 2 == 240 * MiB && WS_PROJ + 240 * MiB <= WS_SUMS + HALF_STRIDE, "proj size");
constexpr size_t PROJ_MIX_OFF = 128 * MiB;
constexpr int LDS_BYTES = 147456;
constexpr float EPS = 1e-6f;
constexpr float LOG2E = 1.4426950408889634f;

DI unsigned pk2(float lo, float hi) { f32x2 v = {lo, hi}; bf16x2_t b = __builtin_convertvector(v, bf16x2_t); return __builtin_bit_cast(unsigned, b); }
DI float bflo(unsigned u) { return __uint_as_float(u << 16); }
DI float bfhi(unsigned u) { return __uint_as_float(u & 0xffff0000u); }
DI float bf1(bf16_t u) { return __uint_as_float(((unsigned)u) << 16); }
DI float wave_sum(float v) {
#pragma unroll
    for (int o = 1; o < 64; o <<= 1) v += __shfl_xor(v, o);
    return v;
}
DI float sigm(float x) { return __builtin_amdgcn_rcpf(1.0f + __builtin_amdgcn_exp2f(-x * LOG2E)); }
DI float gelu_tanh(float y) { const float z = 0.7978845608028654f * (y + 0.044715f * y * y * y); const float t = 1.0f - 2.0f * __builtin_amdgcn_rcpf(1.0f + __builtin_amdgcn_exp2f(2.0f * LOG2E * z)); return 0.5f * y * (1.0f + t); }
#define MFMA32(a, b, c) __builtin_amdgcn_mfma_f32_32x32x16_bf16((a), (b), (c), 0, 0, 0)

namespace pg8 {
constexpr int BM = 256, BK = 64, HALF = 128, HTB = HALF * BK * 2, STAGE_BYTES = 8 * HTB, NXCD = 8, WGM = 8;
__host__ __device__ __forceinline__ int lds_byte(int r, int c) { const int st = (r >> 4) * 2 + (c >> 5), rr = r & 15, cc = c & 31, ob = rr * 64 + cc * 2; return st * 1024 + (ob ^ (((ob >> 9) & 1) << 5)); }
__host__ __device__ __forceinline__ void stage_rc(int b, int& R, int& C) { const int st = b / 1024, sb = b % 1024, swz = sb ^ (((sb >> 9) & 1) << 5); R = (st >> 1) * 16 + swz / 64; C = (st & 1) * 32 + (swz % 64) / 2; }
__host__ __device__ __forceinline__ int perm32(int rho) { const int n = rho >> 4, i = rho & 15; return 8 * (i >> 2) + 4 * n + (i & 3); }

struct Unit { int pm, pn, z; };
enum { EP_BF16 = 0, EP_RELU2 = 1, EP_SCALE = 2, EP_MERGE = 4 };
struct Cfg { const bf16_t* A; const bf16_t* Bt; int lda, ldb, K, N, lz, zA, zB, pnA; };
DI Cfg gemm_cfg(int ph, unsigned char* ws, unsigned char* wg, int l) {
    const bf16_t* Wl = (const bf16_t*)(wg + WS_W) + (size_t)l * WO_LAYER; const bf16_t* proj = (const bf16_t*)(ws + WS_PROJ);
    Cfg c; c.zA = 0; c.zB = 0; c.pnA = 0; c.lda = D; c.ldb = D; c.K = D; c.N = D; c.lz = 4;
    if (ph == 0) { c.A = (const bf16_t*)(ws + WS_HB); c.Bt = Wl + WO_IN; c.N = DIN; }
    else if (ph == 2) { c.A = (const bf16_t*)(ws + WS_POOLED); c.pnA = 256; c.Bt = Wl + WO_PG; c.K = 256; c.ldb = 256; c.lz = 2; }
    else if (ph == 3) { c.A = proj + PC_Q; c.lda = DIN; c.zA = D; c.Bt = Wl + WO_BR; c.zB = D * D; c.K = 3 * D; }
    else if (ph == 4) { c.A = (const bf16_t*)(ws + WS_MERGED); c.Bt = Wl + WO_OUT; }
    else if (ph == 6) { c.A = (const bf16_t*)(ws + WS_HB); c.Bt = Wl + WO_UP; c.N = DFF; }
    else { c.A = proj; c.lda = DFF; c.Bt = Wl + WO_DN; c.K = DFF; c.ldb = DFF; c.lz = 6; }
    return c;
}
struct Sched {
    int nM, nN, nZ, nwg, G, c, nx;
    DI void init(int M, int N, int nZ_, int G_, int c_, int nx_) { nM = M / BM; nN = N / BM; nZ = nZ_; nwg = nM * nN; G = G_; c = c_; nx = nx_; }
    DI bool next(int i, Unit& u) const {
        const int t = i; u.z = 0;
        const long L = (long)t * G + c; if (L >= nwg) return false;
        int wgid = (int)L; { const int q = nwg / nx, r = nwg % nx, xcd = wgid % nx, off = wgid / nx; wgid = (xcd < r ? xcd * (q + 1) : r * (q + 1) + (xcd - r) * q) + off; }
        const int nig = WGM * nN, gid = wgid / nig, fm = gid * WGM, gsz = (nM - fm) < WGM ? (nM - fm) : WGM;
        u.pm = fm + ((wgid % nig) % gsz); u.pn = (wgid % nig) / gsz; return true;
    }
};

DI unsigned ror8(unsigned x) { return (unsigned)__builtin_amdgcn_mov_dpp((int)x, 0x128, 0xf, 0xf, true); }
DI void store_lines(bf16_t* Ob, size_t row, int ldc, int colw, int fr, int fq, const u32x4& w0, const u32x4& w1) {
    const bool lo = (fr & 8) == 0;
    const u32x4 snd = lo ? w1 : w0;
    u32x4 rcv; rcv.x = ror8(snd.x); rcv.y = ror8(snd.y); rcv.z = ror8(snd.z); rcv.w = ror8(snd.w);
    const u32x4 dA = lo ? w0 : rcv, dB = lo ? rcv : w1;
    const int col = colw + 8 * fq + (lo ? 0 : 32);
    __builtin_nontemporal_store(dA, (u32x4*)(Ob + (lo ? row : row - 8) * ldc + col));
    __builtin_nontemporal_store(dB, (u32x4*)(Ob + (lo ? row + 8 : row) * ldc + col));
}
DI void epilogue(const f32x4 (&acc)[2][2][4][2], int ph, unsigned char* ws, const float* pscale, const Unit& u, int wr, int wc, int fr, int fq) {
    const int row0 = u.pm * BM + wr * 64 + fr, colw = u.pn * BM + wc * 64, col0 = colw + 8 * fq;
    const int mode = (ph == 0 || ph == 4 || ph == 7) ? EP_BF16 : ph == 2 ? EP_SCALE : ph == 3 ? EP_MERGE : EP_RELU2;
    bf16_t* Ob = ph == 3 ? (bf16_t*)(ws + WS_MERGED) : (ph == 4 || ph == 7) ? (bf16_t*)(ws + WS_PROJ + PROJ_MIX_OFF) : (bf16_t*)(ws + WS_PROJ) + (ph == 2 ? PC_P : 0);
    const int ldc = (ph == 0 || ph == 2) ? DIN : (ph == 6 ? DFF : D);
    if (mode == EP_BF16 || mode == EP_RELU2) {
        const bool r2 = mode == EP_RELU2;
#pragma unroll
        for (int ai = 0; ai < 2; ++ai)
#pragma unroll
            for (int m = 0; m < 4; ++m) { u32x4 w[2];
#pragma unroll
                for (int bj = 0; bj < 2; ++bj) { f32x4 v0 = acc[ai][bj][m][0], v1 = acc[ai][bj][m][1];
                    if (r2) {
#pragma unroll
                        for (int j = 0; j < 4; ++j) { const float a = fmaxf(v0[j], 0.f), b = fmaxf(v1[j], 0.f); v0[j] = a * a; v1[j] = b * b; } }
                    w[bj].x = pk2(v0[0], v0[1]); w[bj].y = pk2(v0[2], v0[3]); w[bj].z = pk2(v1[0], v1[1]); w[bj].w = pk2(v1[2], v1[3]); }
                store_lines(Ob, (size_t)(row0 + ai * HALF + m * 16), ldc, colw, fr, fq, w[0], w[1]); }
    } else if (mode == EP_SCALE) {
        f32x4 sc[2][2];
#pragma unroll
        for (int bj = 0; bj < 2; ++bj)
#pragma unroll
            for (int n = 0; n < 2; ++n) sc[bj][n] = *(const f32x4*)(pscale + col0 + bj * 32 + 4 * n);
#pragma unroll
        for (int ai = 0; ai < 2; ++ai)
#pragma unroll
            for (int m = 0; m < 4; ++m) { u32x4 w[2];
#pragma unroll
                for (int bj = 0; bj < 2; ++bj) { const f32x4 v0 = acc[ai][bj][m][0] * sc[bj][0], v1 = acc[ai][bj][m][1] * sc[bj][1];
                    w[bj].x = pk2(v0[0], v0[1]); w[bj].y = pk2(v0[2], v0[3]); w[bj].z = pk2(v1[0], v1[1]); w[bj].w = pk2(v1[2], v1[3]); }
                store_lines(Ob, (size_t)(row0 + ai * HALF + m * 16), ldc, colw, fr, fq, w[0], w[1]); }
    } else {
        const bf16_t* gate = (const bf16_t*)(ws + WS_PROJ) + PC_G + 2 * D;
#pragma unroll
        for (int ai = 0; ai < 2; ++ai)
#pragma unroll
            for (int m = 0; m < 4; ++m) { const size_t row = (size_t)(row0 + ai * HALF + m * 16); u32x4 w[2];
#pragma unroll
                for (int bj = 0; bj < 2; ++bj) { const int col = col0 + bj * 32;
                    const u32x4 gw = *(const u32x4*)(gate + row * DIN + col);
                    const float ga[8] = {bflo(gw.x), bfhi(gw.x), bflo(gw.y), bfhi(gw.y), bflo(gw.z), bfhi(gw.z), bflo(gw.w), bfhi(gw.w)};
                    float f[8];
#pragma unroll
                    for (int j = 0; j < 8; ++j) f[j] = __builtin_amdgcn_rcpf(1.0f + __builtin_amdgcn_exp2f(-fmaxf(ga[j], -30.f) * LOG2E));
                    const f32x4 v0 = acc[ai][bj][m][0] * (f32x4){f[0], f[1], f[2], f[3]}, v1 = acc[ai][bj][m][1] * (f32x4){f[4], f[5], f[6], f[7]};
                    w[bj].x = pk2(v0[0], v0[1]); w[bj].y = pk2(v0[2], v0[3]); w[bj].z = pk2(v1[0], v1[1]); w[bj].w = pk2(v1[2], v1[3]); }
                store_lines(Ob, row, ldc, colw, fr, fq, w[0], w[1]);
                asm volatile("" ::: "memory"); }
    }
}
DI void merge_carry(f32x4 (&acc)[2][2][4][2], unsigned char* ws, const Unit& u, int z, int wr, int wc, int fr, int fq) {
    const int row0 = u.pm * BM + wr * 64 + fr, col0 = u.pn * BM + wc * 64 + 8 * fq;
    const bf16_t* gate = (const bf16_t*)(ws + WS_PROJ) + PC_G + (size_t)z * D;
#pragma unroll
    for (int ai = 0; ai < 2; ++ai)
#pragma unroll
        for (int m = 0; m < 4; ++m) { const size_t row = (size_t)(row0 + ai * HALF + m * 16);
#pragma unroll
            for (int bj = 0; bj < 2; ++bj) { const int col = col0 + bj * 32;
                const u32x4 gw = *(const u32x4*)(gate + row * DIN + col), hw = *(const u32x4*)(gate + row * DIN + D + col);
                const float ga[8] = {bflo(gw.x), bfhi(gw.x), bflo(gw.y), bfhi(gw.y), bflo(gw.z), bfhi(gw.z), bflo(gw.w), bfhi(gw.w)};
                const float gb[8] = {bflo(hw.x), bfhi(hw.x), bflo(hw.y), bfhi(hw.y), bflo(hw.z), bfhi(hw.z), bflo(hw.w), bfhi(hw.w)};
                float f[8];
#pragma unroll
                for (int j = 0; j < 8; ++j) { const float ea = __builtin_amdgcn_exp2f(-fmaxf(ga[j], -30.f) * LOG2E), eb = __builtin_amdgcn_exp2f(-fmaxf(gb[j], -30.f) * LOG2E);
                    f[j] = (1.0f + eb) * __builtin_amdgcn_rcpf(1.0f + ea); }
                acc[ai][bj][m][0] = acc[ai][bj][m][0] * (f32x4){f[0], f[1], f[2], f[3]}; acc[ai][bj][m][1] = acc[ai][bj][m][1] * (f32x4){f[4], f[5], f[6], f[7]};
                asm volatile("" ::: "memory"); } }
}

DI void gemm_phase(LAS unsigned char* lds, int ph, unsigned char* ws, unsigned char* wg, int l, const float* pscale, int G, int cidx, int nx) {
    int tid_ = threadIdx.x; asm volatile("" : "+v"(tid_));
    const int tid = tid_, wid = __builtin_amdgcn_readfirstlane(tid >> 6), lane = tid & 63, wr = wid >> 2, wc = wid & 3, fr = lane & 15, fq = lane >> 4;
    const Cfg g0 = gemm_cfg(ph, ws, wg, l);
    const int nt = g0.K / BK, lda = g0.lda, ldb = g0.ldb, lz = g0.lz, ntzm = (1 << g0.lz) - 1;
    const size_t zAb = (size_t)g0.zA * 2, zBb = (size_t)g0.zB * 2;
    Sched S; S.init(MC, g0.N, 1, G, cidx, nx);
    unsigned voffA[2], voffB[2];
#pragma unroll
    for (int i = 0; i < 2; ++i) { int R, C; stage_rc(tid * 16 + i * 8192, R, C); const int Rb = (R >> 5) * 64 + perm32(R & 31);
        voffA[i] = (unsigned)(R * lda + C) * 2u; voffB[i] = (unsigned)(Rb * ldb + C) * 2u; }
    const size_t kstep = (size_t)(BK * 2);
    const size_t hstepA = (size_t)HALF * lda * 2, hstepB = (size_t)32 * ldb * 2;
    const unsigned ldsw = (unsigned)wid * 1024u;
    const int aoff = lds_byte(wr * 64 + fr, fq * 8), boff = lds_byte(wc * 32 + fr, fq * 8);
#define PG8_SA(b, h) (((b) * 2 + (h)) * HTB)
#define PG8_SB(b, h) ((4 + (b) * 2 + (h)) * HTB)
#define PG8_STAGE(bufoff, gbase, voff) do { _Pragma("unroll") for (int _i = 0; _i < 2; ++_i) \
        __builtin_amdgcn_global_load_lds((const unsigned*)((const char*)(gbase) + (voff)[_i]), (LAS unsigned*)(lds + (bufoff) + ldsw + _i * 8192), 16, 0, 0); } while (0)
#define PG8_LDA(dst, b, h) do { _Pragma("unroll") for (int m = 0; m < 4; ++m) _Pragma("unroll") for (int k = 0; k < 2; ++k) dst[m][k] = *(const LAS bf16x8*)(lds + PG8_SA(b, h) + aoff + m * 2048 + k * 1024); } while (0)
#define PG8_LDB(dst, b, h) do { _Pragma("unroll") for (int n = 0; n < 2; ++n) _Pragma("unroll") for (int k = 0; k < 2; ++k) dst[n][k] = *(const LAS bf16x8*)(lds + PG8_SB(b, h) + boff + n * 2048 + k * 1024); } while (0)
#define PG8_MMA(ai, bj, At, Bt) do { __builtin_amdgcn_s_setprio(1); _Pragma("unroll") for (int m = 0; m < 4; ++m) _Pragma("unroll") for (int n = 0; n < 2; ++n) _Pragma("unroll") for (int k = 0; k < 2; ++k) \
        acc[ai][bj][m][n] = __builtin_amdgcn_mfma_f32_16x16x32_bf16(Bt[n][k], At[m][k], acc[ai][bj][m][n], 0, 0, 0); __builtin_amdgcn_s_setprio(0); } while (0)
#define PG8_WAIT_V(n) asm volatile("s_waitcnt vmcnt(" #n ")" ::: "memory")
#define PG8_WAIT_L(n) asm volatile("s_waitcnt lgkmcnt(" #n ")" ::: "memory")
#define PG8_BAR __builtin_amdgcn_s_barrier()
#define PG8_SCHED __builtin_amdgcn_sched_barrier(0)
#define PG8_ABASE(u) ((const char*)gx.A + (size_t)(u).pm * tstepA + (size_t)(u).pn * gx.pnA * 2)
#define PG8_BBASE(u) ((const char*)gx.Bt + (size_t)(u).pn * tstepB)
#define PG8_KA(t_) (cA + (size_t)((t_) >> lz) * zAb + (size_t)((t_) & ntzm) * kstep)
#define PG8_KB(t_) (cB + (size_t)((t_) >> lz) * zBb + (size_t)((t_) & ntzm) * kstep)
#define PG8_RECFG() int phx = ph; int lx = l; unsigned char* wsx = ws; unsigned char* wgx = wg; asm volatile("" : "+s"(phx), "+s"(lx), "+s"(wsx), "+s"(wgx)); const Cfg gx = gemm_cfg(phx, wsx, wgx, lx); \
        const size_t tstepA = (size_t)BM * gx.lda * 2, tstepB = (size_t)BM * gx.ldb * 2
    Unit cur, nxt; int ui = 0;
    if (!S.next(0, cur)) return;
    f32x4 acc[2][2][4][2];
#pragma unroll
    for (int a = 0; a < 2; ++a)
#pragma unroll
        for (int b = 0; b < 2; ++b)
#pragma unroll
            for (int m = 0; m < 4; ++m)
#pragma unroll
                for (int n = 0; n < 2; ++n) acc[a][b][m][n] = (f32x4){0.f, 0.f, 0.f, 0.f};
    bf16x8 At[4][2], B0[2][2], B1[2][2];
    const char* cA; const char* cB; { PG8_RECFG(); cA = PG8_ABASE(cur); cB = PG8_BBASE(cur); }
    PG8_STAGE(PG8_SB(0, 0), cB, voffB); PG8_STAGE(PG8_SB(0, 1), cB + hstepB, voffB); PG8_STAGE(PG8_SA(0, 0), cA, voffA); PG8_STAGE(PG8_SA(0, 1), cA + hstepA, voffA);
    if (wr == 1) PG8_BAR;
    PG8_WAIT_V(2); PG8_BAR;
    PG8_STAGE(PG8_SB(1, 0), cB + kstep, voffB); PG8_STAGE(PG8_SA(1, 0), cA + kstep, voffA); PG8_STAGE(PG8_SB(1, 1), cB + hstepB + kstep, voffB);
    PG8_WAIT_V(6); PG8_BAR;
    for (;;) {
        const bool has_next = S.next(ui + 1, nxt);
        const char* nA = cA; const char* nB = cB; if (has_next) { PG8_RECFG(); nA = PG8_ABASE(nxt); nB = PG8_BBASE(nxt); }
        for (int t = 0; t < nt; t += 2) {
            const bool last = (t == nt - 2);
            const char* a1 = PG8_KA(t + 1);
            const char* a2 = last ? nA : PG8_KA(t + 2); const char* b2 = last ? nB : PG8_KB(t + 2);
            const char* a3 = a2 + kstep; const char* b3 = b2 + kstep;
            if (zAb != 0 && t != 0 && (t & ntzm) == 0) { unsigned char* wsx = ws; asm volatile("" : "+s"(wsx)); int frx = fr; asm volatile("" : "+v"(frx)); merge_carry(acc, wsx, cur, (t >> lz) - 1, wr, wc, frx, fq); }
            PG8_LDB(B0, 0, 0); PG8_LDB(B1, 0, 1); PG8_SCHED; PG8_LDA(At, 0, 0); PG8_STAGE(PG8_SA(1, 1), a1 + hstepA, voffA);
            PG8_WAIT_V(8); PG8_WAIT_L(0); PG8_BAR; PG8_MMA(0, 0, At, B0); PG8_MMA(0, 1, At, B1); PG8_BAR; PG8_SCHED;
            PG8_LDA(At, 0, 1); PG8_STAGE(PG8_SB(0, 0), b2, voffB); PG8_STAGE(PG8_SB(0, 1), b2 + hstepB, voffB); PG8_STAGE(PG8_SA(0, 0), a2, voffA);
            PG8_WAIT_V(8); PG8_WAIT_L(0); PG8_BAR; PG8_MMA(1, 0, At, B0); PG8_MMA(1, 1, At, B1); PG8_BAR; PG8_SCHED;
            PG8_LDB(B0, 1, 0); PG8_LDB(B1, 1, 1); PG8_SCHED; PG8_LDA(At, 1, 0); PG8_STAGE(PG8_SA(0, 1), a2 + hstepA, voffA);
            PG8_WAIT_V(8); PG8_WAIT_L(0); PG8_BAR; PG8_MMA(0, 0, At, B0); PG8_MMA(0, 1, At, B1); PG8_BAR; PG8_SCHED;
            PG8_LDA(At, 1, 1); PG8_STAGE(PG8_SB(1, 0), b3, voffB); PG8_STAGE(PG8_SB(1, 1), b3 + hstepB, voffB); PG8_STAGE(PG8_SA(1, 0), a3, voffA);
            PG8_WAIT_V(8); PG8_WAIT_L(0); PG8_BAR; PG8_MMA(1, 0, At, B0); PG8_MMA(1, 1, At, B1); PG8_BAR; PG8_SCHED;
        }
        if (wr == 0) PG8_BAR;
        { int phx = ph; unsigned char* wsx = ws; asm volatile("" : "+s"(phx), "+s"(wsx)); int frx = fr; asm volatile("" : "+v"(frx)); epilogue(acc, phx, wsx, pscale, cur, wr, wc, frx, fq); }
        if (!has_next) break;
#pragma unroll
        for (int a = 0; a < 2; ++a)
#pragma unroll
            for (int b = 0; b < 2; ++b)
#pragma unroll
                for (int m = 0; m < 4; ++m)
#pragma unroll
                    for (int n = 0; n < 2; ++n) acc[a][b][m][n] = (f32x4){0.f, 0.f, 0.f, 0.f};
        cur = nxt; cA = nA; cB = nB; ++ui;
        if (wr == 1) PG8_BAR;
    }
    PG8_WAIT_V(0);
    PG8_BAR;
#undef PG8_SA
#undef PG8_SB
#undef PG8_STAGE
#undef PG8_LDA
#undef PG8_LDB
#undef PG8_MMA
#undef PG8_WAIT_V
#undef PG8_WAIT_L
#undef PG8_BAR
#undef PG8_SCHED
#undef PG8_ABASE
#undef PG8_BBASE
#undef PG8_RECFG
#undef PG8_KA
#undef PG8_KB
}
}

DI void transpose_item(const float* W, int K, int N, bf16_t* WT, int drow0, LAS float* scr, int k0, int n0, int lane) {
#pragma unroll 8
    for (int i = 0; i < 32; ++i) { const int kk = 2 * i + (lane >> 5); scr[kk * 33 + (lane & 31)] = W[(size_t)(k0 + kk) * N + n0 + (lane & 31)]; }
    asm volatile("s_waitcnt lgkmcnt(0)" ::: "memory");
    const int c = lane & 7;
#pragma unroll
    for (int j = 0; j < 4; ++j) { const int n = (lane >> 3) + 8 * j; const LAS float* s = scr + (8 * c) * 33 + n;
        u32x4 o; o.x = pk2(s[0 * 33], s[1 * 33]); o.y = pk2(s[2 * 33], s[3 * 33]); o.z = pk2(s[4 * 33], s[5 * 33]); o.w = pk2(s[6 * 33], s[7 * 33]);
        *(u32x4*)(WT + (size_t)(drow0 + n) * K + k0 + 8 * c) = o; }
    asm volatile("s_waitcnt lgkmcnt(0)" ::: "memory");
}
DI int win_perm(int n) {
    if (n < 1024) return PC_Q + n;
    if (n < 1280) return PC_K + (n - 1024);
    if (n < 1536) return PC_V + (n - 1280);
    if (n < 2560) return PC_X + (n - 1536);
    if (n < 3584) return PC_Y + (n - 2560);
    if (n < 4608) return PC_P + (n - 3584);
    return n;
}

struct Params {
    const float* in[22]; float* out; unsigned char* ws; float inv_freq[8]; int lo, hi;
};
enum { I_X = 0, I_NMIXPRE, I_NMIXPOST, I_WIN, I_SINKS, I_WATT, I_CONVW, I_CONVB, I_WRGA, I_BRGA, I_WRGI, I_BRGI, I_LAM, I_WRNN, I_WPG, I_PSCALE, I_WPOOL, I_WOUT, I_NMLPPRE, I_NMLPPOST, I_WUP, I_WDN };

DI void prologue(const Params& p, LAS unsigned char* lds, int l_lo, int l_hi, bool do_rope, int gw, int NGW, int wave, int lane) {
    LAS float* scr = (LAS float*)(lds + wave * 16384);
    bf16_t* Wall = (bf16_t*)(p.ws + WS_W);
    constexpr int IT_IN = 16 * 240, IT_SQ = 512, IT_PG = 128, IT_UP = 2048, IT_DN = 2048, IT_RG = 32;
    constexpr int IT_LAYER = IT_IN + 4 * IT_SQ + IT_PG + IT_UP + IT_DN + 2 * IT_RG;
    for (int it = l_lo * IT_LAYER + gw; it < IT_LAYER * l_hi; it += NGW) {
        const int l = it / IT_LAYER; int r = it - l * IT_LAYER; bf16_t* Wl = Wall + (size_t)l * WO_LAYER;
        if (r < IT_IN) { const int kb = r / 240, nb = r % 240; transpose_item(p.in[I_WIN] + (size_t)l * D * DIN, D, DIN, Wl + WO_IN, win_perm(nb * 32), scr, kb * 64, nb * 32, lane); continue; } r -= IT_IN;
        if (r < 4 * IT_SQ) { const int which = r / IT_SQ; r -= which * IT_SQ; const int kb = r / 32, nb = r % 32;
            const float* src = (which == 0 ? p.in[I_WATT] : which == 1 ? p.in[I_WRNN] : which == 2 ? p.in[I_WPOOL] : p.in[I_WOUT]) + (size_t)l * D * D;
            bf16_t* dst = which < 3 ? Wl + WO_BR + (size_t)which * D * D : Wl + WO_OUT;
            transpose_item(src, D, D, dst, nb * 32, scr, kb * 64, nb * 32, lane); continue; } r -= 4 * IT_SQ;
        if (r < IT_PG) { const int gq = r / 32; r -= gq * 32; const int kb = r / 8, nb = r % 8;
            transpose_item(p.in[I_WPG] + ((size_t)l * 4 + gq) * 65536, 256, 256, Wl + WO_PG, gq * 256 + nb * 32, scr, kb * 64, nb * 32, lane); continue; } r -= IT_PG;
        if (r < IT_UP) { const int kb = r / 128, nb = r % 128; transpose_item(p.in[I_WUP] + (size_t)l * D * DFF, D, DFF, Wl + WO_UP, nb * 32, scr, kb * 64, nb * 32, lane); continue; } r -= IT_UP;
        if (r < IT_DN) { const int kb = r / 32, nb = r % 32; transpose_item(p.in[I_WDN] + (size_t)l * DFF * D, DFF, D, Wl + WO_DN, nb * 32, scr, kb * 64, nb * 32, lane); continue; } r -= IT_DN;
        { const int which = r / IT_RG; r -= which * IT_RG; const int hb = r / 2, nb = r % 2;
          transpose_item((which ? p.in[I_WRGI] : p.in[I_WRGA]) + ((size_t)l * 16 + hb) * 4096, 64, 64, Wl + (which ? WO_RI : WO_RA), hb * 64 + nb * 32, scr, 0, nb * 32, lane); }
    }
    float* rope = (float*)(p.ws + WS_ROPE);
    if (do_rope) for (int i = gw * 64 + lane; i < SEQ * 8; i += NGW * 64) {
        const int pos = i >> 3, j = i & 7;
        const float ang = (float)pos * p.inv_freq[j];
        const double a = (double)ang * 0.15915494309189535; const double n = __builtin_rint(a); const float fr = (float)(a - n);
        rope[pos * 16 + j] = __builtin_amdgcn_cosf(fr); rope[pos * 16 + 8 + j] = __builtin_amdgcn_sinf(fr);
    }
}

DI void rowpass(const float* hsrc, const bf16_t* mix, const float* gpost, const float* gnext, float* hdst, bf16_t* hb, int gw, int NGW, int lane) {
    for (int m0 = gw * 2; m0 < MC; m0 += NGW * 2) {
        f32x4 hv[2][4], mv[2][4];
#pragma unroll
        for (int r = 0; r < 2; ++r)
#pragma unroll
            for (int j = 0; j < 4; ++j) hv[r][j] = __builtin_nontemporal_load((const f32x4*)(hsrc + (size_t)(m0 + r) * D + 256 * j + 4 * lane));
        if (mix) {
#pragma unroll
            for (int r = 0; r < 2; ++r)
#pragma unroll
                for (int j = 0; j < 4; ++j) { const u32x2 w = __builtin_nontemporal_load((const u32x2*)(mix + (size_t)(m0 + r) * D + 256 * j + 4 * lane)); mv[r][j] = (f32x4){bflo(w.x), bfhi(w.x), bflo(w.y), bfhi(w.y)}; }
            float ss[2] = {0.f, 0.f};
#pragma unroll
            for (int r = 0; r < 2; ++r)
#pragma unroll
                for (int j = 0; j < 4; ++j) ss[r] += (mv[r][j].x * mv[r][j].x + mv[r][j].y * mv[r][j].y) + (mv[r][j].z * mv[r][j].z + mv[r][j].w * mv[r][j].w);
#pragma unroll
            for (int o = 1; o < 64; o <<= 1) { ss[0] += __shfl_xor(ss[0], o); ss[1] += __shfl_xor(ss[1], o); }
#pragma unroll
            for (int r = 0; r < 2; ++r) { const float rs = 1.0f / sqrtf(ss[r] * (1.0f / D) + EPS);
#pragma unroll
                for (int j = 0; j < 4; ++j) { const f32x4 gp = *(const f32x4*)(gpost + 256 * j + 4 * lane); hv[r][j] += mv[r][j] * rs * gp; *(f32x4*)(hdst + (size_t)(m0 + r) * D + 256 * j + 4 * lane) = hv[r][j]; } }
        }
        if (gnext) {
            float ss[2] = {0.f, 0.f};
#pragma unroll
            for (int r = 0; r < 2; ++r)
#pragma unroll
                for (int j = 0; j < 4; ++j) ss[r] += (hv[r][j].x * hv[r][j].x + hv[r][j].y * hv[r][j].y) + (hv[r][j].z * hv[r][j].z + hv[r][j].w * hv[r][j].w);
#pragma unroll
            for (int o = 1; o < 64; o <<= 1) { ss[0] += __shfl_xor(ss[0], o); ss[1] += __shfl_xor(ss[1], o); }
#pragma unroll
            for (int r = 0; r < 2; ++r) { const float rs = 1.0f / sqrtf(ss[r] * (1.0f / D) + EPS);
#pragma unroll
                for (int j = 0; j < 4; ++j) { const f32x4 gn = *(const f32x4*)(gnext + 256 * j + 4 * lane); const f32x4 o = hv[r][j] * rs * gn;
                    u32x2 w; w.x = pk2(o.x, o.y); w.y = pk2(o.z, o.w); *(u32x2*)(hb + (size_t)(m0 + r) * D + 256 * j + 4 * lane) = w; } }
        }
    }
}

DI void rope8(u32x4& v, const u32x4& pr, const float* tab, bool second) {
    const f32x4 c0 = *(const f32x4*)tab, c1 = *(const f32x4*)(tab + 4), s0 = *(const f32x4*)(tab + 8), s1 = *(const f32x4*)(tab + 12);
    const float sg = second ? 1.f : -1.f;
    float x[8] = {bflo(v.x), bfhi(v.x), bflo(v.y), bfhi(v.y), bflo(v.z), bfhi(v.z), bflo(v.w), bfhi(v.w)};
    const float y[8] = {bflo(pr.x), bfhi(pr.x), bflo(pr.y), bfhi(pr.y), bflo(pr.z), bfhi(pr.z), bflo(pr.w), bfhi(pr.w)};
    const float cs[8] = {c0.x, c0.y, c0.z, c0.w, c1.x, c1.y, c1.z, c1.w}, sn[8] = {s0.x, s0.y, s0.z, s0.w, s1.x, s1.y, s1.z, s1.w};
#pragma unroll
    for (int j = 0; j < 8; ++j) x[j] = x[j] * cs[j] + sg * y[j] * sn[j];
    v.x = pk2(x[0], x[1]); v.y = pk2(x[2], x[3]); v.z = pk2(x[4], x[5]); v.w = pk2(x[6], x[7]);
}
constexpr int KS_LD = 72, VT_LD = 260, ATT_VT_OFF = 256 * KS_LD * 2;
DI void attn_unit(LAS unsigned char* lds, bf16_t* P, const float* rope, const float* sinks, int unit, int tid, int wid, int lane) {
    const int kvh = unit & 3, n = (unit >> 2) & 63, b = unit >> 8;
    const long rowblk = (long)b * SEQ + n * 128;
    LAS bf16_t* Ks = (LAS bf16_t*)lds; LAS bf16_t* Vt = (LAS bf16_t*)(lds + ATT_VT_OFF);
#pragma unroll
    for (int i = 0; i < 4; ++i) {
        const int pc = tid + 512 * i, key = pc >> 3, dg = pc & 7;
        const bool valid = (n > 0) || key >= 128;
        u32x4 kv = {0u, 0u, 0u, 0u}, vv = {0u, 0u, 0u, 0u};
        if (valid) { const bf16_t* src = P + (size_t)(rowblk - 128 + key) * DIN + kvh * 64 + dg * 8; kv = *(const u32x4*)(src + PC_K); vv = *(const u32x4*)(src + PC_V); }
        u32x4 pr; pr.x = __shfl_xor(kv.x, 1); pr.y = __shfl_xor(kv.y, 1); pr.z = __shfl_xor(kv.z, 1); pr.w = __shfl_xor(kv.w, 1);
        if (dg < 2) { const int pos = valid ? (n * 128 - 128 + key) : 0; rope8(kv, pr, rope + pos * 16, dg == 1); }
        *(LAS u32x4*)(Ks + key * KS_LD + dg * 8) = kv;
        const unsigned vw[4] = {vv.x, vv.y, vv.z, vv.w};
#pragma unroll
        for (int j = 0; j < 4; ++j) { Vt[(dg * 8 + 2 * j) * VT_LD + key] = (bf16_t)(vw[j] & 0xffffu); Vt[(dg * 8 + 2 * j + 1) * VT_LD + key] = (bf16_t)(vw[j] >> 16); }
    }
    __syncthreads();
    const int g = wid >> 1, head = kvh * 4 + g, q = lane & 31, hl = lane >> 5;
    const float sinkv = sinks[head] * LOG2E;
    const float cscale = 0.125f * LOG2E;
#pragma unroll 1
    for (int sb = 0; sb < 2; ++sb) {
        const int r0 = 64 * (wid & 1) + 32 * sb;
        bf16_t* qrow = P + (size_t)(rowblk + r0 + q) * DIN + PC_Q + head * 64;
        u32x4 qf[4];
#pragma unroll
        for (int s = 0; s < 4; ++s) qf[s] = *(const u32x4*)(qrow + 16 * s + 8 * hl);
        { u32x4 pr; pr.x = __shfl_xor(qf[0].x, 32); pr.y = __shfl_xor(qf[0].y, 32); pr.z = __shfl_xor(qf[0].z, 32); pr.w = __shfl_xor(qf[0].w, 32);
          rope8(qf[0], pr, rope + (n * 128 + r0 + q) * 16, hl == 1); }
        f32x16 S[5];
#pragma unroll
        for (int kt = 0; kt < 5; ++kt) {
#pragma unroll
            for (int i = 0; i < 16; ++i) S[kt][i] = 0.f;
#pragma unroll
            for (int s = 0; s < 4; ++s) { const bf16x8 kf = *(const LAS bf16x8*)(Ks + (r0 + 32 * kt + q) * KS_LD + 16 * s + 8 * hl);
                S[kt] = MFMA32(kf, __builtin_bit_cast(bf16x8, qf[s]), S[kt]); }
        }
#pragma unroll
        for (int i = 0; i < 16; ++i) { const int kl = 8 * (i >> 2) + 4 * hl + (i & 3);
            if (kl <= q) S[0][i] = -1e30f;
            if (kl > q) S[4][i] = -1e30f; }
        if (n == 0) {
#pragma unroll
            for (int kt = 0; kt < 4; ++kt) if (r0 + 32 * kt < 128) {
#pragma unroll
                for (int i = 0; i < 16; ++i) S[kt][i] = -1e30f; }
        }
        float mx = -1e30f;
#pragma unroll
        for (int kt = 0; kt < 5; ++kt)
#pragma unroll
            for (int i = 0; i < 16; ++i) mx = fmaxf(mx, S[kt][i]);
        mx = fmaxf(mx, __shfl_xor(mx, 32));
        const float M2 = fmaxf(mx * cscale, sinkv);
        float l = 0.f;
#pragma unroll
        for (int kt = 0; kt < 5; ++kt)
#pragma unroll
            for (int i = 0; i < 16; ++i) { const float pv = __builtin_amdgcn_exp2f(S[kt][i] * cscale - M2); l += pv; S[kt][i] = pv; }
        l += __shfl_xor(l, 32);
        l += __builtin_amdgcn_exp2f(sinkv - M2);
        const float inv = __builtin_amdgcn_rcpf(l);
        f32x16 O[2];
#pragma unroll
        for (int i = 0; i < 16; ++i) { O[0][i] = 0.f; O[1][i] = 0.f; }
#pragma unroll
        for (int kt = 0; kt < 5; ++kt)
#pragma unroll
            for (int s2 = 0; s2 < 2; ++s2) {
                u32x4 pw; pw.x = pk2(S[kt][8 * s2 + 0], S[kt][8 * s2 + 1]); pw.y = pk2(S[kt][8 * s2 + 2], S[kt][8 * s2 + 3]); pw.z = pk2(S[kt][8 * s2 + 4], S[kt][8 * s2 + 5]); pw.w = pk2(S[kt][8 * s2 + 6], S[kt][8 * s2 + 7]);
                const bf16x8 pf = __builtin_bit_cast(bf16x8, pw);
#pragma unroll
                for (int dt = 0; dt < 2; ++dt) {
                    const LAS bf16_t* vp = Vt + (32 * dt + q) * VT_LD + r0 + 32 * kt + 16 * s2 + 4 * hl;
                    const u32x2 v0 = *(const LAS u32x2*)vp, v1 = *(const LAS u32x2*)(vp + 8);
                    u32x4 vw; vw.x = v0.x; vw.y = v0.y; vw.z = v1.x; vw.w = v1.y;
                    O[dt] = MFMA32(__builtin_bit_cast(bf16x8, vw), pf, O[dt]);
                }
            }
        bf16_t* orow = qrow;
#pragma unroll
        for (int dt = 0; dt < 2; ++dt)
#pragma unroll
            for (int a = 0; a < 4; ++a) { u32x2 w; w.x = pk2(O[dt][4 * a] * inv, O[dt][4 * a + 1] * inv); w.y = pk2(O[dt][4 * a + 2] * inv, O[dt][4 * a + 3] * inv);
                *(u32x2*)(orow + 32 * dt + 8 * a + 4 * hl) = w; }
    }
    __syncthreads();
}

constexpr int NCH = SEQ / 128;
DI void rnn_phase(LAS unsigned char* lds, bf16_t* P, const bf16_t* WaT, const bf16_t* WiT, const float* convw, const float* convb, const float* ba, const float* bi, const float* lam,
                  f32x2* sums, unsigned* au, bool fin, int bx, int G, int tid, int wid, int lane) {
    constexpr int NU = BPC * NCH * 16;
    typedef _Float16 h2_t __attribute__((ext_vector_type(2)));
    LAS float* XC = (LAS float*)lds; LAS float* AA = (LAS float*)(lds + 32768); LAS bf16_t* XB = (LAS bf16_t*)(lds + 65536); LAS bf16_t* WL = (LAS bf16_t*)(lds + 83968);
    LAS float* SG = (LAS float*)(lds + 102400); LAS float* PF = (LAS float*)(lds + 106496); LAS float* CW = (LAS float*)(lds + 110592);
    const int t = tid >> 2, cq = tid & 3;
    const int tt = wid >> 1, nt = wid & 1, l32 = lane & 31, hl = lane >> 5;
    int cur_hbk = -1; float bac = 0.f, bic = 0.f, k8c = 0.f;
    u32x4 xr[4][2];
#define RNN_LOAD_XR(uu) do { const int hb_ = (uu) & 15, c_ = ((uu) >> 4) & 63, b_ = (uu) >> 10; const size_t rb_ = (size_t)b_ * SEQ + c_ * 128; \
        _Pragma("unroll") for (int tap = 0; tap < 4; ++tap) { const int tp_ = c_ * 128 + t + tap - 3; \
            if (tp_ >= 0) { const bf16_t* src_ = P + (rb_ + t + tap - 3) * DIN + PC_X + hb_ * 64 + 16 * cq; xr[tap][0] = *(const u32x4*)src_; xr[tap][1] = *(const u32x4*)(src_ + 8); } \
            else { xr[tap][0] = (u32x4){0u, 0u, 0u, 0u}; xr[tap][1] = (u32x4){0u, 0u, 0u, 0u}; } } } while (0)
    if (fin) {
        for (int u2 = bx; u2 < NU; u2 += G) {
            const int hbk = u2 & 15, c = (u2 >> 4) & 63, b = u2 >> 10;
            const size_t rowbase = (size_t)b * SEQ + c * 128; const int ch0 = hbk * 64, ch = lane, seg = wid;
            const unsigned* aup = au + (rowbase + 16 * seg) * D + ch0 + ch;
            bf16_t* yp = P + (rowbase + 16 * seg) * DIN + PC_Y + ch0 + ch;
            unsigned w[16]; unsigned short yv[16];
#pragma unroll
            for (int j = 0; j < 16; ++j) { w[j] = aup[(size_t)j * D]; yv[j] = yp[(size_t)j * DIN]; }
            float Ap = 1.f, Hp = 0.f;
#pragma unroll
            for (int k = 0; k < 8; ++k) { const int j = 8 * wid + k; if (j < c) { const f32x2 sv = sums[((size_t)b * NCH + j) * D + ch0 + lane]; Hp = sv.x * Hp + sv.y; Ap *= sv.x; } }
            float av[16], uv[16]; float A = 1.f, H = 0.f;
#pragma unroll
            for (int j = 0; j < 16; ++j) { const h2_t v = __builtin_bit_cast(h2_t, w[j]); av[j] = 1.0f - (float)v.x; uv[j] = (float)v.y; H = av[j] * H + uv[j]; A *= av[j]; }
            SG[seg * 64 + ch] = A; SG[512 + seg * 64 + ch] = H; PF[wid * 64 + lane] = Ap; PF[512 + wid * 64 + lane] = Hp;
            __syncthreads();
            float h = 0.f;
#pragma unroll
            for (int q8 = 0; q8 < 8; ++q8) h = PF[q8 * 64 + ch] * h + PF[512 + q8 * 64 + ch];
            for (int s2 = 0; s2 < seg; ++s2) h = SG[s2 * 64 + ch] * h + SG[512 + s2 * 64 + ch];
#pragma unroll
            for (int j = 0; j < 16; ++j) { h = av[j] * h + uv[j]; const float o = h * gelu_tanh(bf1(yv[j])); yp[(size_t)j * DIN] = (bf16_t)(pk2(o, 0.f) & 0xffffu); }
            __syncthreads();
        }
        return;
    }
    int u = bx; if (u >= NU) return;
    RNN_LOAD_XR(u);
    for (; u < NU; u += G) {
        const int hbk = u & 15, c = (u >> 4) & 63, b = u >> 10;
        const size_t rowbase = (size_t)b * SEQ + c * 128; const int ch0 = hbk * 64;
        if (hbk != cur_hbk) {
            const int nn = tid >> 3, k8 = tid & 7;
            *(LAS u32x4*)(WL + nn * 72 + 8 * k8) = *(const u32x4*)(WaT + (size_t)hbk * 4096 + nn * 64 + 8 * k8);
            *(LAS u32x4*)(WL + 64 * 72 + nn * 72 + 8 * k8) = *(const u32x4*)(WiT + (size_t)hbk * 4096 + nn * 64 + 8 * k8);
            if (tid < 320) CW[tid] = tid < 256 ? convw[(tid >> 6) * D + ch0 + (tid & 63)] : convb[ch0 + tid - 256];
            const int chg = ch0 + 32 * nt + l32;
            bac = ba[chg]; bic = bi[chg]; k8c = -8.0f * LOG2E * log1pf(expf(-lam[chg]));
            cur_hbk = hbk;
            __syncthreads();
        }
        unsigned short yv[16]; float Ap = 1.f, Hp = 0.f;
        bf16_t* yp = P + (rowbase + 16 * wid) * DIN + PC_Y + ch0 + lane;
        if (fin) {
#pragma unroll
            for (int j = 0; j < 16; ++j) yv[j] = yp[(size_t)j * DIN];
#pragma unroll
            for (int k = 0; k < 8; ++k) { const int j = 8 * wid + k; if (j < c) { const f32x2 sv = sums[((size_t)b * NCH + j) * D + ch0 + lane]; Hp = sv.x * Hp + sv.y; Ap *= sv.x; } }
        }
        {
            f32x4 acc[4];
#pragma unroll
            for (int j = 0; j < 4; ++j) acc[j] = *(const LAS f32x4*)(CW + 256 + 16 * cq + 4 * j);
#pragma unroll
            for (int tap = 0; tap < 4; ++tap) {
                const u32x4 x0 = xr[tap][0], x1 = xr[tap][1];
                const LAS float* wp = CW + tap * 64 + 16 * cq;
                const f32x4 w0 = *(const LAS f32x4*)wp, w1 = *(const LAS f32x4*)(wp + 4), w2 = *(const LAS f32x4*)(wp + 8), w3 = *(const LAS f32x4*)(wp + 12);
                acc[0] += (f32x4){bflo(x0.x), bfhi(x0.x), bflo(x0.y), bfhi(x0.y)} * w0; acc[1] += (f32x4){bflo(x0.z), bfhi(x0.z), bflo(x0.w), bfhi(x0.w)} * w1;
                acc[2] += (f32x4){bflo(x1.x), bfhi(x1.x), bflo(x1.y), bfhi(x1.y)} * w2; acc[3] += (f32x4){bflo(x1.z), bfhi(x1.z), bflo(x1.w), bfhi(x1.w)} * w3;
            }
#pragma unroll
            for (int j = 0; j < 4; ++j) *(LAS f32x4*)(XC + t * 64 + 16 * cq + 4 * j) = acc[j];
            u32x4 o0, o1; o0.x = pk2(acc[0].x, acc[0].y); o0.y = pk2(acc[0].z, acc[0].w); o0.z = pk2(acc[1].x, acc[1].y); o0.w = pk2(acc[1].z, acc[1].w);
            o1.x = pk2(acc[2].x, acc[2].y); o1.y = pk2(acc[2].z, acc[2].w); o1.z = pk2(acc[3].x, acc[3].y); o1.w = pk2(acc[3].z, acc[3].w);
            *(LAS u32x4*)(XB + t * 72 + 16 * cq) = o0; *(LAS u32x4*)(XB + t * 72 + 16 * cq + 8) = o1;
        }
        if (u + G < NU) RNN_LOAD_XR(u + G);
        if (fin) { PF[wid * 64 + lane] = Ap; PF[512 + wid * 64 + lane] = Hp; }
        __syncthreads();
        {
            f32x16 aR, aI;
#pragma unroll
            for (int i = 0; i < 16; ++i) { aR[i] = 0.f; aI[i] = 0.f; }
#pragma unroll
            for (int s = 0; s < 4; ++s) {
                const bf16x8 af = *(const LAS bf16x8*)(XB + (32 * tt + l32) * 72 + 16 * s + 8 * hl);
                const bf16x8 bR = *(const LAS bf16x8*)(WL + (32 * nt + l32) * 72 + 16 * s + 8 * hl);
                const bf16x8 bI = *(const LAS bf16x8*)(WL + 64 * 72 + (32 * nt + l32) * 72 + 16 * s + 8 * hl);
                aR = MFMA32(af, bR, aR); aI = MFMA32(af, bI, aI);
            }
            const int ch = 32 * nt + l32;
#pragma unroll
            for (int i = 0; i < 16; ++i) { const int tok = 32 * tt + 8 * (i >> 2) + 4 * hl + (i & 3);
                const float r = sigm(aR[i] + bac), ig = sigm(aI[i] + bic);
                const float a = __builtin_amdgcn_exp2f(k8c * r);
                const float mult = __builtin_amdgcn_sqrtf(fmaxf(1.0f - a * a, 0.f));
                const float xv = XC[tok * 64 + ch];
                const float uu_ = mult * ig * xv; AA[tok * 64 + ch] = a; XC[tok * 64 + ch] = uu_;
                { const h2_t pv = {(_Float16)(1.0f - a), (_Float16)uu_}; au[(rowbase + tok) * D + ch0 + ch] = __builtin_bit_cast(unsigned, pv); } }
        }
        __syncthreads();
        {
            const int ch = lane, seg = wid;
            float A = 1.f, H = 0.f;
#pragma unroll
            for (int j = 0; j < 16; ++j) { const int tk = 16 * seg + j; const float a = AA[tk * 64 + ch], uu = XC[tk * 64 + ch]; H = a * H + uu; A *= a; }
            SG[seg * 64 + ch] = A; SG[512 + seg * 64 + ch] = H;
            __syncthreads();
            if (!fin) {
                if (wid == 0) { float Ac = 1.f, Hc = 0.f;
#pragma unroll
                    for (int s = 0; s < 8; ++s) { const float sa = SG[s * 64 + ch]; Hc = sa * Hc + SG[512 + s * 64 + ch]; Ac *= sa; }
                    sums[((size_t)b * NCH + c) * D + ch0 + ch] = (f32x2){Ac, Hc}; }
            } else {
                float h = 0.f;
#pragma unroll
                for (int w = 0; w < 8; ++w) h = PF[w * 64 + ch] * h + PF[512 + w * 64 + ch];
                for (int s = 0; s < seg; ++s) h = SG[s * 64 + ch] * h + SG[512 + s * 64 + ch];
#pragma unroll
                for (int j = 0; j < 16; ++j) { const int tk = 16 * seg + j; const float a = AA[tk * 64 + ch], uu = XC[tk * 64 + ch]; h = a * h + uu;
                    const float o = h * gelu_tanh(bf1(yv[j]));
                    yp[(size_t)j * DIN] = (bf16_t)(pk2(o, 0.f) & 0xffffu); }
            }
        }
        __syncthreads();
    }
#undef RNN_LOAD_XR
}

DI void pool_item(const bf16_t* P, bf16_t* pooled, int idx) {
    const int cg8 = idx & 127, run = idx >> 7; const size_t row0 = (size_t)run * 8; const int t0 = (int)(row0 & (SEQ - 1));
    const int ch = cg8 * 8, w = 2 << (ch >> 8);
    const bf16_t* src = P + PC_P + ch;
    float sum[8];
#pragma unroll
    for (int j = 0; j < 8; ++j) sum[j] = 0.f;
    for (int k = 1; k < w; ++k) if (t0 - k >= 0) { const u32x4 x = *(const u32x4*)(src + (row0 - k) * DIN);
        sum[0] += bflo(x.x); sum[1] += bfhi(x.x); sum[2] += bflo(x.y); sum[3] += bfhi(x.y); sum[4] += bflo(x.z); sum[5] += bfhi(x.z); sum[6] += bflo(x.w); sum[7] += bfhi(x.w); }
#pragma unroll
    for (int j = 0; j < 8; ++j) {
        const int t = t0 + j; const u32x4 x = *(const u32x4*)(src + (row0 + j) * DIN);
        const float cur[8] = {bflo(x.x), bfhi(x.x), bflo(x.y), bfhi(x.y), bflo(x.z), bfhi(x.z), bflo(x.w), bfhi(x.w)};
#pragma unroll
        for (int e = 0; e < 8; ++e) sum[e] += cur[e];
        const float ic = __builtin_amdgcn_rcpf((float)(t + 1 < w ? t + 1 : w));
        u32x4 o; o.x = pk2(sum[0] * ic - cur[0], sum[1] * ic - cur[1]); o.y = pk2(sum[2] * ic - cur[2], sum[3] * ic - cur[3]);
        o.z = pk2(sum[4] * ic - cur[4], sum[5] * ic - cur[5]); o.w = pk2(sum[6] * ic - cur[6], sum[7] * ic - cur[7]);
        *(u32x4*)(pooled + (row0 + j) * D + ch) = o;
        if (t - w + 1 >= 0) { const u32x4 y = *(const u32x4*)(src + (row0 + j - w + 1) * DIN);
            sum[0] -= bflo(y.x); sum[1] -= bfhi(y.x); sum[2] -= bflo(y.y); sum[3] -= bfhi(y.y); sum[4] -= bflo(y.z); sum[5] -= bfhi(y.z); sum[6] -= bflo(y.w); sum[7] -= bfhi(y.w); }
    }
}


#define XB_TMO      128
#define XB_XCNT(j)  (256  + 64 * (j))
#define XB_XSUB(j)  (1280 + 64 * (j))
#define XB_XGEN(j)  (2304 + 64 * (j))
#define XB_TOP      3328
#define XB_TOPGEN   3392
#define XCD_BAR_WORDS 3456
#define XB_SPIN_CAP (1u << 22)
DI unsigned xb_ld(unsigned* p)              { return __hip_atomic_load(p, __ATOMIC_RELAXED, __HIP_MEMORY_SCOPE_AGENT); }
DI unsigned xb_add(unsigned* p, unsigned v) { return __hip_atomic_fetch_add(p, v, __ATOMIC_RELAXED, __HIP_MEMORY_SCOPE_AGENT); }
DI unsigned xb_xcc_id() { return (unsigned)__builtin_amdgcn_s_getreg((3 << 11) | 20) & 0xFu; }
#define XB_SPIN(cond, bar) do { unsigned _sp = 0; while (cond) { __builtin_amdgcn_s_sleep(1); \
    if ((++_sp & 255u) == 0u) { if (xb_ld(&(bar)[XB_TMO])) break; if (_sp > XB_SPIN_CAP) { atomicAdd(&(bar)[XB_TMO], 1u); break; } } } } while (0)
struct XcdBarrier { unsigned* bar; unsigned x; volatile LAS unsigned* st; unsigned n; };
DI XcdBarrier xcd_barrier_post(unsigned* bar, volatile LAS unsigned* st, unsigned n) {
    XcdBarrier b; b.bar = bar; b.x = xb_xcc_id(); b.st = st; b.n = n;
    if (threadIdx.x == 0) (void)xb_add(&bar[XB_XCNT(b.x)], 1u);
    return b;
}
DI void xcd_barrier_complete(unsigned* bar, unsigned x, unsigned G, unsigned& nloc, unsigned& nx) {
    unsigned sum, cnt, mine, sp = 0u;
    for (;;) {
        sum = 0u; cnt = 0u; mine = 0u;
#pragma unroll
        for (unsigned j = 0; j < 16; ++j) { const unsigned c = xb_ld(&bar[XB_XCNT(j)]); sum += c; cnt += (c > 0u) ? 1u : 0u; mine = (j == x) ? c : mine; }
        if (sum == G) break;
        __builtin_amdgcn_s_sleep(1);
        if ((++sp & 255u) == 0u) { if (xb_ld(&bar[XB_TMO])) break; if (sp > XB_SPIN_CAP) { atomicAdd(&bar[XB_TMO], 1u); break; } }
    }
    nloc = mine > 0u ? mine : 1u; nx = cnt > 0u ? cnt : 1u;
}
DI void xcd_barrier(const XcdBarrier& b) {
    asm volatile("s_waitcnt vmcnt(0)" ::: "memory");
    __syncthreads();
    if (threadIdx.x == 0) {
        unsigned* bar = b.bar;
        __builtin_amdgcn_s_waitcnt(0);
        unsigned nloc = b.st[0], nx = b.st[1];
        if (nloc == 0u) { xcd_barrier_complete(bar, b.x, b.n, nloc, nx); b.st[0] = nloc; b.st[1] = nx; }
        const unsigned old = xb_add(&bar[XB_XSUB(b.x)], 1u);
        const unsigned gen = old / nloc;
        if (old + 1u == (gen + 1u) * nloc) {
            __builtin_amdgcn_fence(__ATOMIC_RELEASE, "agent");
            asm volatile("s_waitcnt vmcnt(0)" ::: "memory");
            const unsigned og = xb_add(&bar[XB_TOP], 1u);
            const unsigned tg = og / nx;
            if (og + 1u == (tg + 1u) * nx) xb_add(&bar[XB_TOPGEN], 1u);
            else XB_SPIN(xb_ld(&bar[XB_TOPGEN]) == tg, bar);
            __builtin_amdgcn_fence(__ATOMIC_ACQUIRE, "agent");
            xb_add(&bar[XB_XGEN(b.x)], 1u);
            asm volatile("s_waitcnt vmcnt(0)" ::: "memory");
        } else {
            XB_SPIN(xb_ld(&bar[XB_XGEN(b.x)]) == gen, bar);
            __builtin_amdgcn_fence(__ATOMIC_ACQUIRE, "agent");
            asm volatile("s_waitcnt vmcnt(0)" ::: "memory");
        }
    }
    __syncthreads();
}

__global__ void __launch_bounds__(512, 2) mega_fwd(Params p) {
    extern __shared__ __attribute__((aligned(16))) unsigned char lds_raw[];
    LAS unsigned char* lds = (LAS unsigned char*)lds_raw;
    cg::grid_group grid = cg::this_grid();
    const int Gfull = gridDim.x, bfull = blockIdx.x;
    const int half = (bfull & 7) >> 2, bx = (bfull >> 3) * 4 + (bfull & 3), G = Gfull >> 1, NGW = G * 8;
#define TID_LOCAL() int tid_ = threadIdx.x; asm volatile("" : "+v"(tid_)); const int tid = tid_, lane = tid & 63, wid = __builtin_amdgcn_readfirstlane(tid >> 6), gw = bx * 8 + wid; (void)lane; (void)gw; (void)tid
    volatile LAS unsigned* xst = (volatile LAS unsigned*)(lds + 131072 + 512);
    if (threadIdx.x < 2) xst[threadIdx.x] = 0u;
    __syncthreads();
    unsigned* ctl = (unsigned*)(p.ws + WS_CTL);
    XcdBarrier xbar = xcd_barrier_post(ctl + half * 4096, xst, (unsigned)G);
    unsigned* wflag = ctl + 8192 + 64;
    { TID_LOCAL(); const int gwf = bfull * 8 + wid; prologue(p, lds, 0, 1, true, gwf, Gfull * 8, wid, lane); }
    grid.sync();
    if (half == 1) {
        TID_LOCAL(); prologue(p, lds, 1, DEPTH, false, gw, NGW, wid, lane);
        asm volatile("s_waitcnt vmcnt(0)" ::: "memory"); __syncthreads();
        if (tid == 0) { __builtin_amdgcn_fence(__ATOMIC_RELEASE, "agent"); asm volatile("s_waitcnt vmcnt(0)" ::: "memory"); __hip_atomic_fetch_add(wflag, 1u, __ATOMIC_RELAXED, __HIP_MEMORY_SCOPE_AGENT); }
    }
    bool first = true, wready = (half == 1);
#define STEP_SYNC() do { if (!first) xcd_barrier(xbar); first = false; } while (0)
    for (int cj = 0; cj < NCHUNK / 2; ++cj) {
        const int ck = half * (NCHUNK / 2) + cj;
        { STEP_SYNC(); TID_LOCAL(); int ckx = ck; unsigned char* ws = p.ws + (size_t)half * HALF_STRIDE; asm volatile("" : "+s"(ckx), "+s"(ws));
            rowpass(p.in[I_X] + (size_t)ckx * MC * D, nullptr, nullptr, p.in[I_NMIXPRE], p.out + (size_t)ckx * MC * D, (bf16_t*)(ws + WS_HB), gw, NGW, lane); }
        for (int l = 0; l < DEPTH; ++l) {
            if (!wready && l >= 1) {
                if (threadIdx.x == 0) { unsigned sp = 0; while (__hip_atomic_load(wflag, __ATOMIC_RELAXED, __HIP_MEMORY_SCOPE_AGENT) < (unsigned)G) { __builtin_amdgcn_s_sleep(2); if (++sp > (1u << 24)) break; }
                    __builtin_amdgcn_fence(__ATOMIC_ACQUIRE, "agent"); asm volatile("s_waitcnt vmcnt(0)" ::: "memory"); }
                __syncthreads(); wready = true;
            }
            for (int ph = 0; ph < 9; ++ph) {
                STEP_SYNC();
                if (ph == 1) {
                    TID_LOCAL(); int lx = l; unsigned char* ws = p.ws + (size_t)half * HALF_STRIDE; unsigned char* wg = p.ws; asm volatile("" : "+s"(lx), "+s"(ws), "+s"(wg));
                    bf16_t* proj = (bf16_t*)(ws + WS_PROJ);
                    for (int u = bx; u < BPC * 64 * 4; u += G) attn_unit(lds, proj, (const float*)(wg + WS_ROPE), p.in[I_SINKS] + lx * 16, u, tid, wid, lane);
                    for (int idx = bx * 512 + tid; idx < (MC / 8) * 128; idx += G * 512) pool_item(proj, (bf16_t*)(ws + WS_POOLED), idx);
                }
                if (ph == 1 || ph == 2) {
                    TID_LOCAL(); int lx = l; unsigned char* ws = p.ws + (size_t)half * HALF_STRIDE; unsigned char* wg = p.ws; asm volatile("" : "+s"(lx), "+s"(ws), "+s"(wg));
                    const bf16_t* Wl = (const bf16_t*)(wg + WS_W) + (size_t)lx * WO_LAYER;
                    rnn_phase(lds, (bf16_t*)(ws + WS_PROJ), Wl + WO_RA, Wl + WO_RI, p.in[I_CONVW] + (size_t)lx * 4 * D, p.in[I_CONVB] + lx * D, p.in[I_BRGA] + lx * D, p.in[I_BRGI] + lx * D, p.in[I_LAM] + lx * D,
                              (f32x2*)(ws + WS_SUMS), (unsigned*)(wg + WS_AU + (size_t)half * 64 * MiB), ph == 2, bx, G, tid, wid, lane);
                }
                if (ph == 5 || ph == 8) {
                    TID_LOCAL(); int lx = l, ckx = ck; unsigned char* ws = p.ws + (size_t)half * HALF_STRIDE; asm volatile("" : "+s"(lx), "+s"(ckx), "+s"(ws));
                    const float* gpost = (ph == 5 ? p.in[I_NMIXPOST] : p.in[I_NMLPPOST]) + lx * D;
                    const float* gnext = ph == 5 ? p.in[I_NMLPPRE] + lx * D : (lx + 1 < DEPTH ? p.in[I_NMIXPRE] + (lx + 1) * D : nullptr);
                    float* hck = p.out + (size_t)ckx * MC * D;
                    rowpass(lx == 0 && ph == 5 ? p.in[I_X] + (size_t)ckx * MC * D : hck, (const bf16_t*)(ws + WS_PROJ + PROJ_MIX_OFF), gpost, gnext, hck, (bf16_t*)(ws + WS_HB), gw, NGW, lane);
                }
                if (ph == 0 || ph == 2 || ph == 3 || ph == 4 || ph == 6 || ph == 7) {
                    int lx = l; unsigned char* ws = p.ws + (size_t)half * HALF_STRIDE; unsigned char* wg = p.ws; asm volatile("" : "+s"(lx), "+s"(ws), "+s"(wg));
                    pg8::gemm_phase(lds, ph, ws, wg, lx, p.in[I_PSCALE] + lx * D, G, bx, (Gfull & 7) == 0 ? 4 : 1);
                }
            }
        }
    }
}

#ifndef MK_MULTI
#define MK_MULTI 0
#endif
extern "C" void kernel_launch(void* const* d_in, const int* in_sizes, int n_in, void* d_out, int out_size, void* d_ws, size_t ws_size, hipStream_t stream) {
    static int grid = 0;
    if (grid == 0) {
        if (n_in != 22 || ws_size < WS_END) { fprintf(stderr, "kernel_launch: unexpected n_in %d / ws_size %zu (need %zu)\n", n_in, ws_size, (size_t)WS_END); grid = -1; return; }
        int dev = 0, cus = 0, per_cu = 0;
        hipGetDevice(&dev); hipDeviceGetAttribute(&cus, hipDeviceAttributeMultiprocessorCount, dev);
        if (hipFuncSetAttribute((const void*)mega_fwd, hipFuncAttributeMaxDynamicSharedMemorySize, LDS_BYTES) != hipSuccess) { fprintf(stderr, "kernel_launch: hipFuncSetAttribute failed\n"); grid = -1; return; }
        if (hipOccupancyMaxActiveBlocksPerMultiprocessor(&per_cu, (const void*)mega_fwd, 512, LDS_BYTES) != hipSuccess || per_cu < 1) { fprintf(stderr, "kernel_launch: occupancy query gave %d\n", per_cu); per_cu = 1; }
        (void)hipGetLastError();
        grid = (cus * per_cu) & ~7;
        fprintf(stderr, "kernel_launch: grid %d (cus %d x %d)\n", grid, cus, per_cu);
    }
    if (grid < 0) return;
    if (hipMemsetAsync((char*)d_ws + WS_CTL, 0, CTL_ZERO_BYTES, stream) != hipSuccess) { fprintf(stderr, "kernel_launch: memset failed\n"); return; }
    Params p{};
    for (int i = 0; i < 22; ++i) p.in[i] = (const float*)d_in[i];
    p.out = (float*)d_out; p.ws = (unsigned char*)d_ws;
    for (int j = 0; j < 8; ++j) p.inv_freq[j] = (float)pow(500000.0, -(double)j / 8.0);
    p.lo = 0; p.hi = 0; void* args[] = {&p};
    hipError_t e = hipLaunchCooperativeKernel((const void*)mega_fwd, dim3(grid), dim3(512), args, LDS_BYTES, stream);
    if (e != hipSuccess) fprintf(stderr, "cooperative launch failed: %s (grid %d)\n", hipGetErrorString(e), grid);
}
```

```cpp
#include <hip/hip_runtime.h>
#include <hip/hip_cooperative_groups.h>
#include <cstdio>
#include <cstdint>
#include <cmath>
namespace cg = cooperative_groups;

#define LAS __attribute__((address_space(3)))
#define DI __device__ __forceinline__
typedef unsigned short bf16_t;
typedef short bf16x8 __attribute__((ext_vector_type(8)));
typedef short s16x4 __attribute__((ext_vector_type(4)));
typedef float f32x2 __attribute__((ext_vector_type(2)));
typedef float f32x4 __attribute__((ext_vector_type(4)));
typedef float f32x16 __attribute__((ext_vector_type(16)));
typedef unsigned u32x2 __attribute__((ext_vector_type(2)));
typedef unsigned u32x4 __attribute__((ext_vector_type(4)));
typedef __bf16 bf16x2_t __attribute__((ext_vector_type(2)));

constexpr int D = 1024, SEQ = 8192, BATCH = 8, DEPTH = 4, DIN = 7680, DFF = 4096;
constexpr int NCHUNK = 4, BPC = BATCH / NCHUNK, MC = BPC * SEQ;
constexpr int PC_Q = 0, PC_Y = 1024, PC_P = 2048, PC_K = 3072, PC_V = 3328, PC_X = 3584, PC_G = 4608;
constexpr size_t WO_IN = 0, WO_BR = WO_IN + (size_t)DIN * D, WO_OUT = WO_BR + 3ull * D * D, WO_PG = WO_OUT + (size_t)D * D, WO_UP = WO_PG + 4ull * 256 * 256,
                 WO_DN = WO_UP + (size_t)DFF * D, WO_RA = WO_DN + (size_t)DFF * D, WO_RI = WO_RA + 16ull * 64 * 64, WO_LAYER = WO_RI + 16ull * 64 * 64;
constexpr size_t MiB = 1ull << 20;
constexpr size_t WS_ROPE = 0, WS_W = 3 * MiB, WS_SUMS = 163 * MiB, WS_HB = 164 * MiB, WS_POOLED = 196 * MiB, WS_MERGED = 228 * MiB, WS_PROJ = 260 * MiB, HALF_STRIDE = 337 * MiB,
                 WS_CTL = 838 * MiB, WS_AU = 840 * MiB  , WS_END = 968 * MiB;
constexpr size_t CTL_ZERO_BYTES = 65536;
static_assert(WO_LAYER * 2 * DEPTH <= 160 * MiB, "weights fit");
static_assert((size_t)MC * DIN * 2 == 240 * MiB && WS_PROJ + 240 * MiB <= WS_SUMS + HALF_STRIDE, "proj size");
constexpr size_t PROJ_MIX_OFF = 128 * MiB;
constexpr int LDS_BYTES = 147456;
constexpr float EPS = 1e-6f;
constexpr float LOG2E = 1.4426950408889634f;

DI unsigned pk2(float lo, float hi) { f32x2 v = {lo, hi}; bf16x2_t b = __builtin_convertvector(v, bf16x2_t); return __builtin_bit_cast(unsigned, b); }
DI float bflo(unsigned u) { return __uint_as_float(u << 16); }
DI float bfhi(unsigned u) { return __uint_as_float(u & 0xffff0000u); }
DI float bf1(bf16_t u) { return __uint_as_float(((unsigned)u) << 16); }
DI float wave_sum(float v) {
#pragma unroll
    for (int o = 1; o < 64; o <<= 1) v += __shfl_xor(v, o);
    return v;
}
DI float sigm(float x) { return __builtin_amdgcn_rcpf(1.0f + __builtin_amdgcn_exp2f(-x * LOG2E)); }
DI float gelu_tanh(float y) { const float z = 0.7978845608028654f * (y + 0.044715f * y * y * y); const float t = 1.0f - 2.0f * __builtin_amdgcn_rcpf(1.0f + __builtin_amdgcn_exp2f(2.0f * LOG2E * z)); return 0.5f * y * (1.0f + t); }
#define MFMA32(a, b, c) __builtin_amdgcn_mfma_f32_32x32x16_bf16((a), (b), (c), 0, 0, 0)

namespace pg8 {
constexpr int BM = 256, BK = 64, HALF = 128, HTB = HALF * BK * 2, STAGE_BYTES = 8 * HTB, NXCD = 8, WGM = 8;
__host__ __device__ __forceinline__ int lds_byte(int r, int c) { const int st = (r >> 4) * 2 + (c >> 5), rr = r & 15, cc = c & 31, ob = rr * 64 + cc * 2; return st * 1024 + (ob ^ (((ob >> 9) & 1) << 5)); }
__host__ __device__ __forceinline__ void stage_rc(int b, int& R, int& C) { const int st = b / 1024, sb = b % 1024, swz = sb ^ (((sb >> 9) & 1) << 5); R = (st >> 1) * 16 + swz / 64; C = (st & 1) * 32 + (swz % 64) / 2; }
__host__ __device__ __forceinline__ int perm32(int rho) { const int n = rho >> 4, i = rho & 15; return 8 * (i >> 2) + 4 * n + (i & 3); }

struct Unit { int pm, pn, z; };
enum { EP_BF16 = 0, EP_RELU2 = 1, EP_SCALE = 2, EP_MERGE = 4 };
struct Cfg { const bf16_t* A; const bf16_t* Bt; int lda, ldb, K, N, lz, zA, zB, pnA; };
DI Cfg gemm_cfg(int ph, unsigned char* ws, unsigned char* wg, int l) {
    const bf16_t* Wl = (const bf16_t*)(wg + WS_W) + (size_t)l * WO_LAYER; const bf16_t* proj = (const bf16_t*)(ws + WS_PROJ);
    Cfg c; c.zA = 0; c.zB = 0; c.pnA = 0; c.lda = D; c.ldb = D; c.K = D; c.N = D; c.lz = 4;
    if (ph == 0) { c.A = (const bf16_t*)(ws + WS_HB); c.Bt = Wl + WO_IN; c.N = DIN; }
    else if (ph == 2) { c.A = (const bf16_t*)(ws + WS_POOLED); c.pnA = 256; c.Bt = Wl + WO_PG; c.K = 256; c.ldb = 256; c.lz = 2; }
    else if (ph == 3) { c.A = proj + PC_Q; c.lda = DIN; c.zA = D; c.Bt = Wl + WO_BR; c.zB = D * D; c.K = 3 * D; }
    else if (ph == 4) { c.A = (const bf16_t*)(ws + WS_MERGED); c.Bt = Wl + WO_OUT; }
    else if (ph == 6) { c.A = (const bf16_t*)(ws + WS_HB); c.Bt = Wl + WO_UP; c.N = DFF; }
    else { c.A = proj; c.lda = DFF; c.Bt = Wl + WO_DN; c.K = DFF; c.ldb = DFF; c.lz = 6; }
    return c;
}
struct Sched {
    int nM, nN, nZ, nwg, G, c, nx;
    DI void init(int M, int N, int nZ_, int G_, int c_, int nx_) { nM = M / BM; nN = N / BM; nZ = nZ_; nwg = nM * nN; G = G_; c = c_; nx = nx_; }
    DI bool next(int i, Unit& u) const {
        const int t = i; u.z = 0;
        const long L = (long)t * G + c; if (L >= nwg) return false;
        int wgid = (int)L; { const int q = nwg / nx, r = nwg % nx, xcd = wgid % nx, off = wgid / nx; wgid = (xcd < r ? xcd * (q + 1) : r * (q + 1) + (xcd - r) * q) + off; }
        const int nig = WGM * nN, gid = wgid / nig, fm = gid * WGM, gsz = (nM - fm) < WGM ? (nM - fm) : WGM;
        u.pm = fm + ((wgid % nig) % gsz); u.pn = (wgid % nig) / gsz; return true;
    }
};

DI unsigned ror8(unsigned x) { return (unsigned)__builtin_amdgcn_mov_dpp((int)x, 0x128, 0xf, 0xf, true); }
DI void store_lines(bf16_t* Ob, size_t row, int ldc, int colw, int fr, int fq, const u32x4& w0, const u32x4& w1) {
    const bool lo = (fr & 8) == 0;
    const u32x4 snd = lo ? w1 : w0;
    u32x4 rcv; rcv.x = ror8(snd.x); rcv.y = ror8(snd.y); rcv.z = ror8(snd.z); rcv.w = ror8(snd.w);
    const u32x4 dA = lo ? w0 : rcv, dB = lo ? rcv : w1;
    const int col = colw + 8 * fq + (lo ? 0 : 32);
    __builtin_nontemporal_store(dA, (u32x4*)(Ob + (lo ? row : row - 8) * ldc + col));
    __builtin_nontemporal_store(dB, (u32x4*)(Ob + (lo ? row + 8 : row) * ldc + col));
}
DI void epilogue(const f32x4 (&acc)[2][2][4][2], int ph, unsigned char* ws, const float* pscale, const Unit& u, int wr, int wc, int fr, int fq) {
    const int row0 = u.pm * BM + wr * 64 + fr, colw = u.pn * BM + wc * 64, col0 = colw + 8 * fq;
    const int mode = (ph == 0 || ph == 4 || ph == 7) ? EP_BF16 : ph == 2 ? EP_SCALE : ph == 3 ? EP_MERGE : EP_RELU2;
    bf16_t* Ob = ph == 3 ? (bf16_t*)(ws + WS_MERGED) : (ph == 4 || ph == 7) ? (bf16_t*)(ws + WS_PROJ + PROJ_MIX_OFF) : (bf16_t*)(ws + WS_PROJ) + (ph == 2 ? PC_P : 0);
    const int ldc = (ph == 0 || ph == 2) ? DIN : (ph == 6 ? DFF : D);
    if (mode == EP_BF16 || mode == EP_RELU2) {
        const bool r2 = mode == EP_RELU2;
#pragma unroll
        for (int ai = 0; ai < 2; ++ai)
#pragma unroll
            for (int m = 0; m < 4; ++m) { u32x4 w[2];
#pragma unroll
                for (int bj = 0; bj < 2; ++bj) { f32x4 v0 = acc[ai][bj][m][0], v1 = acc[ai][bj][m][1];
                    if (r2) {
#pragma unroll
                        for (int j = 0; j < 4; ++j) { const float a = fmaxf(v0[j], 0.f), b = fmaxf(v1[j], 0.f); v0[j] = a * a; v1[j] = b * b; } }
                    w[bj].x = pk2(v0[0], v0[1]); w[bj].y = pk2(v0[2], v0[3]); w[bj].z = pk2(v1[0], v1[1]); w[bj].w = pk2(v1[2], v1[3]); }
                store_lines(Ob, (size_t)(row0 + ai * HALF + m * 16), ldc, colw, fr, fq, w[0], w[1]); }
    } else if (mode == EP_SCALE) {
        f32x4 sc[2][2];
#pragma unroll
        for (int bj = 0; bj < 2; ++bj)
#pragma unroll
            for (int n = 0; n < 2; ++n) sc[bj][n] = *(const f32x4*)(pscale + col0 + bj * 32 + 4 * n);
#pragma unroll
        for (int ai = 0; ai < 2; ++ai)
#pragma unroll
            for (int m = 0; m < 4; ++m) { u32x4 w[2];
#pragma unroll
                for (int bj = 0; bj < 2; ++bj) { const f32x4 v0 = acc[ai][bj][m][0] * sc[bj][0], v1 = acc[ai][bj][m][1] * sc[bj][1];
                    w[bj].x = pk2(v0[0], v0[1]); w[bj].y = pk2(v0[2], v0[3]); w[bj].z = pk2(v1[0], v1[1]); w[bj].w = pk2(v1[2], v1[3]); }
                store_lines(Ob, (size_t)(row0 + ai * HALF + m * 16), ldc, colw, fr, fq, w[0], w[1]); }
    } else {
        const bf16_t* gate = (const bf16_t*)(ws + WS_PROJ) + PC_G + 2 * D;
#pragma unroll
        for (int ai = 0; ai < 2; ++ai)
#pragma unroll
            for (int m = 0; m < 4; ++m) { const size_t row = (size_t)(row0 + ai * HALF + m * 16); u32x4 w[2];
#pragma unroll
                for (int bj = 0; bj < 2; ++bj) { const int col = col0 + bj * 32;
                    const u32x4 gw = *(const u32x4*)(gate + row * DIN + col);
                    const float ga[8] = {bflo(gw.x), bfhi(gw.x), bflo(gw.y), bfhi(gw.y), bflo(gw.z), bfhi(gw.z), bflo(gw.w), bfhi(gw.w)};
                    float f[8];
#pragma unroll
                    for (int j = 0; j < 8; ++j) f[j] = __builtin_amdgcn_rcpf(1.0f + __builtin_amdgcn_exp2f(-fmaxf(ga[j], -30.f) * LOG2E));
                    const f32x4 v0 = acc[ai][bj][m][0] * (f32x4){f[0], f[1], f[2], f[3]}, v1 = acc[ai][bj][m][1] * (f32x4){f[4], f[5], f[6], f[7]};
                    w[bj].x = pk2(v0[0], v0[1]); w[bj].y = pk2(v0[2], v0[3]); w[bj].z = pk2(v1[0], v1[1]); w[bj].w = pk2(v1[2], v1[3]); }
                store_lines(Ob, row, ldc, colw, fr, fq, w[0], w[1]);
                asm volatile("" ::: "memory"); }
    }
}
DI void merge_carry(f32x4 (&acc)[2][2][4][2], unsigned char* ws, const Unit& u, int z, int wr, int wc, int fr, int fq) {
    const int row0 = u.pm * BM + wr * 64 + fr, col0 = u.pn * BM + wc * 64 + 8 * fq;
    const bf16_t* gate = (const bf16_t*)(ws + WS_PROJ) + PC_G + (size_t)z * D;
#pragma unroll
    for (int ai = 0; ai < 2; ++ai)
#pragma unroll
        for (int m = 0; m < 4; ++m) { const size_t row = (size_t)(row0 + ai * HALF + m * 16);
#pragma unroll
            for (int bj = 0; bj < 2; ++bj) { const int col = col0 + bj * 32;
                const u32x4 gw = *(const u32x4*)(gate + row * DIN + col), hw = *(const u32x4*)(gate + row * DIN + D + col);
                const float ga[8] = {bflo(gw.x), bfhi(gw.x), bflo(gw.y), bfhi(gw.y), bflo(gw.z), bfhi(gw.z), bflo(gw.w), bfhi(gw.w)};
                const float gb[8] = {bflo(hw.x), bfhi(hw.x), bflo(hw.y), bfhi(hw.y), bflo(hw.z), bfhi(hw.z), bflo(hw.w), bfhi(hw.w)};
                float f[8];
#pragma unroll
                for (int j = 0; j < 8; ++j) { const float ea = __builtin_amdgcn_exp2f(-fmaxf(ga[j], -30.f) * LOG2E), eb = __builtin_amdgcn_exp2f(-fmaxf(gb[j], -30.f) * LOG2E);
                    f[j] = (1.0f + eb) * __builtin_amdgcn_rcpf(1.0f + ea); }
                acc[ai][bj][m][0] = acc[ai][bj][m][0] * (f32x4){f[0], f[1], f[2], f[3]}; acc[ai][bj][m][1] = acc[ai][bj][m][1] * (f32x4){f[4], f[5], f[6], f[7]};
                asm volatile("" ::: "memory"); } }
}

DI void gemm_phase(LAS unsigned char* lds, int ph, unsigned char* ws, unsigned char* wg, int l, const float* pscale, int G, int cidx, int nx) {
    int tid_ = threadIdx.x; asm volatile("" : "+v"(tid_));
    const int tid = tid_, wid = __builtin_amdgcn_readfirstlane(tid >> 6), lane = tid & 63, wr = wid >> 2, wc = wid & 3, fr = lane & 15, fq = lane >> 4;
    const Cfg g0 = gemm_cfg(ph, ws, wg, l);
    const int nt = g0.K / BK, lda = g0.lda, ldb = g0.ldb, lz = g0.lz, ntzm = (1 << g0.lz) - 1;
    const size_t zAb = (size_t)g0.zA * 2, zBb = (size_t)g0.zB * 2;
    Sched S; S.init(MC, g0.N, 1, G, cidx, nx);
    unsigned voffA[2], voffB[2];
#pragma unroll
    for (int i = 0; i < 2; ++i) { int R, C; stage_rc(tid * 16 + i * 8192, R, C); const int Rb = (R >> 5) * 64 + perm32(R & 31);
        voffA[i] = (unsigned)(R * lda + C) * 2u; voffB[i] = (unsigned)(Rb * ldb + C) * 2u; }
    const size_t kstep = (size_t)(BK * 2);
    const size_t hstepA = (size_t)HALF * lda * 2, hstepB = (size_t)32 * ldb * 2;
    const unsigned ldsw = (unsigned)wid * 1024u;
    const int aoff = lds_byte(wr * 64 + fr, fq * 8), boff = lds_byte(wc * 32 + fr, fq * 8);
#define PG8_SA(b, h) (((b) * 2 + (h)) * HTB)
#define PG8_SB(b, h) ((4 + (b) * 2 + (h)) * HTB)
#define PG8_STAGE(bufoff, gbase, voff) do { _Pragma("unroll") for (int _i = 0; _i < 2; ++_i) \
        __builtin_amdgcn_global_load_lds((const unsigned*)((const char*)(gbase) + (voff)[_i]), (LAS unsigned*)(lds + (bufoff) + ldsw + _i * 8192), 16, 0, 0); } while (0)
#define PG8_LDA(dst, b, h) do { _Pragma("unroll") for (int m = 0; m < 4; ++m) _Pragma("unroll") for (int k = 0; k < 2; ++k) dst[m][k] = *(const LAS bf16x8*)(lds + PG8_SA(b, h) + aoff + m * 2048 + k * 1024); } while (0)
#define PG8_LDB(dst, b, h) do { _Pragma("unroll") for (int n = 0; n < 2; ++n) _Pragma("unroll") for (int k = 0; k < 2; ++k) dst[n][k] = *(const LAS bf16x8*)(lds + PG8_SB(b, h) + boff + n * 2048 + k * 1024); } while (0)
#define PG8_MMA(ai, bj, At, Bt) do { __builtin_amdgcn_s_setprio(1); _Pragma("unroll") for (int m = 0; m < 4; ++m) _Pragma("unroll") for (int n = 0; n < 2; ++n) _Pragma("unroll") for (int k = 0; k < 2; ++k) \
        acc[ai][bj][m][n] = __builtin_amdgcn_mfma_f32_16x16x32_bf16(Bt[n][k], At[m][k], acc[ai][bj][m][n], 0, 0, 0); __builtin_amdgcn_s_setprio(0); } while (0)
#define PG8_WAIT_V(n) asm volatile("s_waitcnt vmcnt(" #n ")" ::: "memory")
#define PG8_WAIT_L(n) asm volatile("s_waitcnt lgkmcnt(" #n ")" ::: "memory")
#define PG8_BAR __builtin_amdgcn_s_barrier()
#define PG8_SCHED __builtin_amdgcn_sched_barrier(0)
#define PG8_ABASE(u) ((const char*)gx.A + (size_t)(u).pm * tstepA + (size_t)(u).pn * gx.pnA * 2)
#define PG8_BBASE(u) ((const char*)gx.Bt + (size_t)(u).pn * tstepB)
#define PG8_KA(t_) (cA + (size_t)((t_) >> lz) * zAb + (size_t)((t_) & ntzm) * kstep)
#define PG8_KB(t_) (cB + (size_t)((t_) >> lz) * zBb + (size_t)((t_) & ntzm) * kstep)
#define PG8_RECFG() int phx = ph; int lx = l; unsigned char* wsx = ws; unsigned char* wgx = wg; asm volatile("" : "+s"(phx), "+s"(lx), "+s"(wsx), "+s"(wgx)); const Cfg gx = gemm_cfg(phx, wsx, wgx, lx); \
        const size_t tstepA = (size_t)BM * gx.lda * 2, tstepB = (size_t)BM * gx.ldb * 2
    Unit cur, nxt; int ui = 0;
    if (!S.next(0, cur)) return;
    f32x4 acc[2][2][4][2];
#pragma unroll
    for (int a = 0; a < 2; ++a)
#pragma unroll
        for (int b = 0; b < 2; ++b)
#pragma unroll
            for (int m = 0; m < 4; ++m)
#pragma unroll
                for (int n = 0; n < 2; ++n) acc[a][b][m][n] = (f32x4){0.f, 0.f, 0.f, 0.f};
    bf16x8 At[4][2], B0[2][2], B1[2][2];
    const char* cA; const char* cB; { PG8_RECFG(); cA = PG8_ABASE(cur); cB = PG8_BBASE(cur); }
    PG8_STAGE(PG8_SB(0, 0), cB, voffB); PG8_STAGE(PG8_SB(0, 1), cB + hstepB, voffB); PG8_STAGE(PG8_SA(0, 0), cA, voffA); PG8_STAGE(PG8_SA(0, 1), cA + hstepA, voffA);
    if (wr == 1) PG8_BAR;
    PG8_WAIT_V(2); PG8_BAR;
    PG8_STAGE(PG8_SB(1, 0), cB + kstep, voffB); PG8_STAGE(PG8_SA(1, 0), cA + kstep, voffA); PG8_STAGE(PG8_SB(1, 1), cB + hstepB + kstep, voffB);
    PG8_WAIT_V(6); PG8_BAR;
    for (;;) {
        const bool has_next = S.next(ui + 1, nxt);
        const char* nA = cA; const char* nB = cB; if (has_next) { PG8_RECFG(); nA = PG8_ABASE(nxt); nB = PG8_BBASE(nxt); }
        for (int t = 0; t < nt; t += 2) {
            const bool last = (t == nt - 2);
            const char* a1 = PG8_KA(t + 1);
            const char* a2 = last ? nA : PG8_KA(t + 2); const char* b2 = last ? nB : PG8_KB(t + 2);
            const char* a3 = a2 + kstep; const char* b3 = b2 + kstep;
            if (zAb != 0 && t != 0 && (t & ntzm) == 0) { unsigned char* wsx = ws; asm volatile("" : "+s"(wsx)); int frx = fr; asm volatile("" : "+v"(frx)); merge_carry(acc, wsx, cur, (t >> lz) - 1, wr, wc, frx, fq); }
            PG8_LDB(B0, 0, 0); PG8_LDB(B1, 0, 1); PG8_SCHED; PG8_LDA(At, 0, 0); PG8_STAGE(PG8_SA(1, 1), a1 + hstepA, voffA);
            PG8_WAIT_V(8); PG8_WAIT_L(0); PG8_BAR; PG8_MMA(0, 0, At, B0); PG8_MMA(0, 1, At, B1); PG8_BAR; PG8_SCHED;
            PG8_LDA(At, 0, 1); PG8_STAGE(PG8_SB(0, 0), b2, voffB); PG8_STAGE(PG8_SB(0, 1), b2 + hstepB, voffB); PG8_STAGE(PG8_SA(0, 0), a2, voffA);
            PG8_WAIT_V(8); PG8_WAIT_L(0); PG8_BAR; PG8_MMA(1, 0, At, B0); PG8_MMA(1, 1, At, B1); PG8_BAR; PG8_SCHED;
            PG8_LDB(B0, 1, 0); PG8_LDB(B1, 1, 1); PG8_SCHED; PG8_LDA(At, 1, 0); PG8_STAGE(PG8_SA(0, 1), a2 + hstepA, voffA);
            PG8_WAIT_V(8); PG8_WAIT_L(0); PG8_BAR; PG8_MMA(0, 0, At, B0); PG8_MMA(0, 1, At, B1); PG8_BAR; PG8_SCHED;
            PG8_LDA(At, 1, 1); PG8_STAGE(PG8_SB(1, 0), b3, voffB); PG8_STAGE(PG8_SB(1, 1), b3 + hstepB, voffB); PG8_STAGE(PG8_SA(1, 0), a3, voffA);
            PG8_WAIT_V(8); PG8_WAIT_L(0); PG8_BAR; PG8_MMA(1, 0, At, B0); PG8_MMA(1, 1, At, B1); PG8_BAR; PG8_SCHED;
        }
        if (wr == 0) PG8_BAR;
        { int phx = ph; unsigned char* wsx = ws; asm volatile("" : "+s"(phx), "+s"(wsx)); int frx = fr; asm volatile("" : "+v"(frx)); epilogue(acc, phx, wsx, pscale, cur, wr, wc, frx, fq); }
        if (!has_next) break;
#pragma unroll
        for (int a = 0; a < 2; ++a)
#pragma unroll
            for (int b = 0; b < 2; ++b)
#pragma unroll
                for (int m = 0; m < 4; ++m)
#pragma unroll
                    for (int n = 0; n < 2; ++n) acc[a][b][m][n] = (f32x4){0.f, 0.f, 0.f, 0.f};
        cur = nxt; cA = nA; cB = nB; ++ui;
        if (wr == 1) PG8_BAR;
    }
    PG8_WAIT_V(0);
    PG8_BAR;
#undef PG8_SA
#undef PG8_SB
#undef PG8_STAGE
#undef PG8_LDA
#undef PG8_LDB
#undef PG8_MMA
#undef PG8_WAIT_V
#undef PG8_WAIT_L
#undef PG8_BAR
#undef PG8_SCHED
#undef PG8_ABASE
#undef PG8_BBASE
#undef PG8_RECFG
#undef PG8_KA
#undef PG8_KB
}
}

DI void transpose_item(const float* W, int K, int N, bf16_t* WT, int drow0, LAS float* scr, int k0, int n0, int lane) {
#pragma unroll 8
    for (int i = 0; i < 32; ++i) { const int kk = 2 * i + (lane >> 5); scr[kk * 33 + (lane & 31)] = W[(size_t)(k0 + kk) * N + n0 + (lane & 31)]; }
    asm volatile("s_waitcnt lgkmcnt(0)" ::: "memory");
    const int c = lane & 7;
#pragma unroll
    for (int j = 0; j < 4; ++j) { const int n = (lane >> 3) + 8 * j; const LAS float* s = scr + (8 * c) * 33 + n;
        u32x4 o; o.x = pk2(s[0 * 33], s[1 * 33]); o.y = pk2(s[2 * 33], s[3 * 33]); o.z = pk2(s[4 * 33], s[5 * 33]); o.w = pk2(s[6 * 33], s[7 * 33]);
        *(u32x4*)(WT + (size_t)(drow0 + n) * K + k0 + 8 * c) = o; }
    asm volatile("s_waitcnt lgkmcnt(0)" ::: "memory");
}
DI int win_perm(int n) {
    if (n < 1024) return PC_Q + n;
    if (n < 1280) return PC_K + (n - 1024);
    if (n < 1536) return PC_V + (n - 1280);
    if (n < 2560) return PC_X + (n - 1536);
    if (n < 3584) return PC_Y + (n - 2560);
    if (n < 4608) return PC_P + (n - 3584);
    return n;
}

struct Params {
    const float* in[22]; float* out; unsigned char* ws; float inv_freq[8]; int lo, hi;
};
enum { I_X = 0, I_NMIXPRE, I_NMIXPOST, I_WIN, I_SINKS, I_WATT, I_CONVW, I_CONVB, I_WRGA, I_BRGA, I_WRGI, I_BRGI, I_LAM, I_WRNN, I_WPG, I_PSCALE, I_WPOOL, I_WOUT, I_NMLPPRE, I_NMLPPOST, I_WUP, I_WDN };

DI void prologue(const Params& p, LAS unsigned char* lds, int l_lo, int l_hi, bool do_rope, int gw, int NGW, int wave, int lane) {
    LAS float* scr = (LAS float*)(lds + wave * 16384);
    bf16_t* Wall = (bf16_t*)(p.ws + WS_W);
    constexpr int IT_IN = 16 * 240, IT_SQ = 512, IT_PG = 128, IT_UP = 2048, IT_DN = 2048, IT_RG = 32;
    constexpr int IT_LAYER = IT_IN + 4 * IT_SQ + IT_PG + IT_UP + IT_DN + 2 * IT_RG;
    for (int it = l_lo * IT_LAYER + gw; it < IT_LAYER * l_hi; it += NGW) {
        const int l = it / IT_LAYER; int r = it - l * IT_LAYER; bf16_t* Wl = Wall + (size_t)l * WO_LAYER;
        if (r < IT_IN) { const int kb = r / 240, nb = r % 240; transpose_item(p.in[I_WIN] + (size_t)l * D * DIN, D, DIN, Wl + WO_IN, win_perm(nb * 32), scr, kb * 64, nb * 32, lane); continue; } r -= IT_IN;
        if (r < 4 * IT_SQ) { const int which = r / IT_SQ; r -= which * IT_SQ; const int kb = r / 32, nb = r % 32;
            const float* src = (which == 0 ? p.in[I_WATT] : which == 1 ? p.in[I_WRNN] : which == 2 ? p.in[I_WPOOL] : p.in[I_WOUT]) + (size_t)l * D * D;
            bf16_t* dst = which < 3 ? Wl + WO_BR + (size_t)which * D * D : Wl + WO_OUT;
            transpose_item(src, D, D, dst, nb * 32, scr, kb * 64, nb * 32, lane); continue; } r -= 4 * IT_SQ;
        if (r < IT_PG) { const int gq = r / 32; r -= gq * 32; const int kb = r / 8, nb = r % 8;
            transpose_item(p.in[I_WPG] + ((size_t)l * 4 + gq) * 65536, 256, 256, Wl + WO_PG, gq * 256 + nb * 32, scr, kb * 64, nb * 32, lane); continue; } r -= IT_PG;
        if (r < IT_UP) { const int kb = r / 128, nb = r % 128; transpose_item(p.in[I_WUP] + (size_t)l * D * DFF, D, DFF, Wl + WO_UP, nb * 32, scr, kb * 64, nb * 32, lane); continue; } r -= IT_UP;
        if (r < IT_DN) { const int kb = r / 32, nb = r % 32; transpose_item(p.in[I_WDN] + (size_t)l * DFF * D, DFF, D, Wl + WO_DN, nb * 32, scr, kb * 64, nb * 32, lane); continue; } r -= IT_DN;
        { const int which = r / IT_RG; r -= which * IT_RG; const int hb = r / 2, nb = r % 2;
          transpose_item((which ? p.in[I_WRGI] : p.in[I_WRGA]) + ((size_t)l * 16 + hb) * 4096, 64, 64, Wl + (which ? WO_RI : WO_RA), hb * 64 + nb * 32, scr, 0, nb * 32, lane); }
    }
    float* rope = (float*)(p.ws + WS_ROPE);
    if (do_rope) for (int i = gw * 64 + lane; i < SEQ * 8; i += NGW * 64) {
        const int pos = i >> 3, j = i & 7;
        const float ang = (float)pos * p.inv_freq[j];
        const double a = (double)ang * 0.15915494309189535; const double n = __builtin_rint(a); const float fr = (float)(a - n);
        rope[pos * 16 + j] = __builtin_amdgcn_cosf(fr); rope[pos * 16 + 8 + j] = __builtin_amdgcn_sinf(fr);
    }
}

DI void rowpass(const float* hsrc, const bf16_t* mix, const float* gpost, const float* gnext, float* hdst, bf16_t* hb, int gw, int NGW, int lane) {
    for (int m0 = gw * 2; m0 < MC; m0 += NGW * 2) {
        f32x4 hv[2][4], mv[2][4];
#pragma unroll
        for (int r = 0; r < 2; ++r)
#pragma unroll
            for (int j = 0; j < 4; ++j) hv[r][j] = __builtin_nontemporal_load((const f32x4*)(hsrc + (size_t)(m0 + r) * D + 256 * j + 4 * lane));
        if (mix) {
#pragma unroll
            for (int r = 0; r < 2; ++r)
#pragma unroll
                for (int j = 0; j < 4; ++j) { const u32x2 w = __builtin_nontemporal_load((const u32x2*)(mix + (size_t)(m0 + r) * D + 256 * j + 4 * lane)); mv[r][j] = (f32x4){bflo(w.x), bfhi(w.x), bflo(w.y), bfhi(w.y)}; }
            float ss[2] = {0.f, 0.f};
#pragma unroll
            for (int r = 0; r < 2; ++r)
#pragma unroll
                for (int j = 0; j < 4; ++j) ss[r] += (mv[r][j].x * mv[r][j].x + mv[r][j].y * mv[r][j].y) + (mv[r][j].z * mv[r][j].z + mv[r][j].w * mv[r][j].w);
#pragma unroll
            for (int o = 1; o < 64; o <<= 1) { ss[0] += __shfl_xor(ss[0], o); ss[1] += __shfl_xor(ss[1], o); }
#pragma unroll
            for (int r = 0; r < 2; ++r) { const float rs = __builtin_amdgcn_rsqf(ss[r] * (1.0f / D) + EPS);
#pragma unroll
                for (int j = 0; j < 4; ++j) { const f32x4 gp = *(const f32x4*)(gpost + 256 * j + 4 * lane); hv[r][j] += mv[r][j] * rs * gp; *(f32x4*)(hdst + (size_t)(m0 + r) * D + 256 * j + 4 * lane) = hv[r][j]; } }
        }
        if (gnext) {
            float ss[2] = {0.f, 0.f};
#pragma unroll
            for (int r = 0; r < 2; ++r)
#pragma unroll
                for (int j = 0; j < 4; ++j) ss[r] += (hv[r][j].x * hv[r][j].x + hv[r][j].y * hv[r][j].y) + (hv[r][j].z * hv[r][j].z + hv[r][j].w * hv[r][j].w);
#pragma unroll
            for (int o = 1; o < 64; o <<= 1) { ss[0] += __shfl_xor(ss[0], o); ss[1] += __shfl_xor(ss[1], o); }
#pragma unroll
            for (int r = 0; r < 2; ++r) { const float rs = __builtin_amdgcn_rsqf(ss[r] * (1.0f / D) + EPS);
#pragma unroll
                for (int j = 0; j < 4; ++j) { const f32x4 gn = *(const f32x4*)(gnext + 256 * j + 4 * lane); const f32x4 o = hv[r][j] * rs * gn;
                    u32x2 w; w.x = pk2(o.x, o.y); w.y = pk2(o.z, o.w); *(u32x2*)(hb + (size_t)(m0 + r) * D + 256 * j + 4 * lane) = w; } }
        }
    }
}

DI void rope8(u32x4& v, const u32x4& pr, const float* tab, bool second) {
    const f32x4 c0 = *(const f32x4*)tab, c1 = *(const f32x4*)(tab + 4), s0 = *(const f32x4*)(tab + 8), s1 = *(const f32x4*)(tab + 12);
    const float sg = second ? 1.f : -1.f;
    float x[8] = {bflo(v.x), bfhi(v.x), bflo(v.y), bfhi(v.y), bflo(v.z), bfhi(v.z), bflo(v.w), bfhi(v.w)};
    const float y[8] = {bflo(pr.x), bfhi(pr.x), bflo(pr.y), bfhi(pr.y), bflo(pr.z), bfhi(pr.z), bflo(pr.w), bfhi(pr.w)};
    const float cs[8] = {c0.x, c0.y, c0.z, c0.w, c1.x, c1.y, c1.z, c1.w}, sn[8] = {s0.x, s0.y, s0.z, s0.w, s1.x, s1.y, s1.z, s1.w};
#pragma unroll
    for (int j = 0; j < 8; ++j) x[j] = x[j] * cs[j] + sg * y[j] * sn[j];
    v.x = pk2(x[0], x[1]); v.y = pk2(x[2], x[3]); v.z = pk2(x[4], x[5]); v.w = pk2(x[6], x[7]);
}
constexpr int KS_LD = 72, VT_LD = 260, ATT_VT_OFF = 256 * KS_LD * 2;
DI void attn_unit(LAS unsigned char* lds, bf16_t* P, const float* rope, const float* sinks, int unit, int tid, int wid, int lane) {
    const int kvh = unit & 3, n = (unit >> 2) & 63, b = unit >> 8;
    const long rowblk = (long)b * SEQ + n * 128;
    LAS bf16_t* Ks = (LAS bf16_t*)lds; LAS bf16_t* Vt = (LAS bf16_t*)(lds + ATT_VT_OFF);
#pragma unroll
    for (int i = 0; i < 4; ++i) {
        const int pc = tid + 512 * i, key = pc >> 3, dg = pc & 7;
        const bool valid = (n > 0) || key >= 128;
        u32x4 kv = {0u, 0u, 0u, 0u}, vv = {0u, 0u, 0u, 0u};
        if (valid) { const bf16_t* src = P + (size_t)(rowblk - 128 + key) * DIN + kvh * 64 + dg * 8; kv = *(const u32x4*)(src + PC_K); vv = *(const u32x4*)(src + PC_V); }
        u32x4 pr; pr.x = __shfl_xor(kv.x, 1); pr.y = __shfl_xor(kv.y, 1); pr.z = __shfl_xor(kv.z, 1); pr.w = __shfl_xor(kv.w, 1);
        if (dg < 2) { const int pos = valid ? (n * 128 - 128 + key) : 0; rope8(kv, pr, rope + pos * 16, dg == 1); }
        *(LAS u32x4*)(Ks + key * KS_LD + dg * 8) = kv;
        const unsigned vw[4] = {vv.x, vv.y, vv.z, vv.w};
#pragma unroll
        for (int j = 0; j < 4; ++j) { Vt[(dg * 8 + 2 * j) * VT_LD + key] = (bf16_t)(vw[j] & 0xffffu); Vt[(dg * 8 + 2 * j + 1) * VT_LD + key] = (bf16_t)(vw[j] >> 16); }
    }
    __syncthreads();
    const int g = wid >> 1, head = kvh * 4 + g, q = lane & 31, hl = lane >> 5;
    const float sinkv = sinks[head] * LOG2E;
    const float cscale = 0.125f * LOG2E;
#pragma unroll 1
    for (int sb = 0; sb < 2; ++sb) {
        const int r0 = 64 * (wid & 1) + 32 * sb;
        bf16_t* qrow = P + (size_t)(rowblk + r0 + q) * DIN + PC_Q + head * 64;
        u32x4 qf[4];
#pragma unroll
        for (int s = 0; s < 4; ++s) qf[s] = *(const u32x4*)(qrow + 16 * s + 8 * hl);
        { u32x4 pr; pr.x = __shfl_xor(qf[0].x, 32); pr.y = __shfl_xor(qf[0].y, 32); pr.z = __shfl_xor(qf[0].z, 32); pr.w = __shfl_xor(qf[0].w, 32);
          rope8(qf[0], pr, rope + (n * 128 + r0 + q) * 16, hl == 1); }
        f32x16 S[5];
#pragma unroll
        for (int kt = 0; kt < 5; ++kt) {
#pragma unroll
            for (int i = 0; i < 16; ++i) S[kt][i] = 0.f;
#pragma unroll
            for (int s = 0; s < 4; ++s) { const bf16x8 kf = *(const LAS bf16x8*)(Ks + (r0 + 32 * kt + q) * KS_LD + 16 * s + 8 * hl);
                S[kt] = MFMA32(kf, __builtin_bit_cast(bf16x8, qf[s]), S[kt]); }
        }
#pragma unroll
        for (int i = 0; i < 16; ++i) { const int kl = 8 * (i >> 2) + 4 * hl + (i & 3);
            if (kl <= q) S[0][i] = -1e30f;
            if (kl > q) S[4][i] = -1e30f; }
        if (n == 0) {
#pragma unroll
            for (int kt = 0; kt < 4; ++kt) if (r0 + 32 * kt < 128) {
#pragma unroll
                for (int i = 0; i < 16; ++i) S[kt][i] = -1e30f; }
        }
        float mx = -1e30f;
#pragma unroll
        for (int kt = 0; kt < 5; ++kt)
#pragma unroll
            for (int i = 0; i < 16; ++i) mx = fmaxf(mx, S[kt][i]);
        mx = fmaxf(mx, __shfl_xor(mx, 32));
        const float M2 = fmaxf(mx * cscale, sinkv);
        float l = 0.f;
#pragma unroll
        for (int kt = 0; kt < 5; ++kt)
#pragma unroll
            for (int i = 0; i < 16; ++i) { const float pv = __builtin_amdgcn_exp2f(S[kt][i] * cscale - M2); l += pv; S[kt][i] = pv; }
        l += __shfl_xor(l, 32);
        l += __builtin_amdgcn_exp2f(sinkv - M2);
        const float inv = __builtin_amdgcn_rcpf(l);
        f32x16 O[2];
#pragma unroll
        for (int i = 0; i < 16; ++i) { O[0][i] = 0.f; O[1][i] = 0.f; }
#pragma unroll
        for (int kt = 0; kt < 5; ++kt)
#pragma unroll
            for (int s2 = 0; s2 < 2; ++s2) {
                u32x4 pw; pw.x = pk2(S[kt][8 * s2 + 0], S[kt][8 * s2 + 1]); pw.y = pk2(S[kt][8 * s2 + 2], S[kt][8 * s2 + 3]); pw.z = pk2(S[kt][8 * s2 + 4], S[kt][8 * s2 + 5]); pw.w = pk2(S[kt][8 * s2 + 6], S[kt][8 * s2 + 7]);
                const bf16x8 pf = __builtin_bit_cast(bf16x8, pw);
#pragma unroll
                for (int dt = 0; dt < 2; ++dt) {
                    const LAS bf16_t* vp = Vt + (32 * dt + q) * VT_LD + r0 + 32 * kt + 16 * s2 + 4 * hl;
                    const u32x2 v0 = *(const LAS u32x2*)vp, v1 = *(const LAS u32x2*)(vp + 8);
                    u32x4 vw; vw.x = v0.x; vw.y = v0.y; vw.z = v1.x; vw.w = v1.y;
                    O[dt] = MFMA32(__builtin_bit_cast(bf16x8, vw), pf, O[dt]);
                }
            }
        bf16_t* orow = qrow;
#pragma unroll
        for (int dt = 0; dt < 2; ++dt)
#pragma unroll
            for (int a = 0; a < 4; ++a) { u32x2 w; w.x = pk2(O[dt][4 * a] * inv, O[dt][4 * a + 1] * inv); w.y = pk2(O[dt][4 * a + 2] * inv, O[dt][4 * a + 3] * inv);
                *(u32x2*)(orow + 32 * dt + 8 * a + 4 * hl) = w; }
    }
    __syncthreads();
}

constexpr int NCH = SEQ / 128;
DI void rnn_phase(LAS unsigned char* lds, bf16_t* P, const bf16_t* WaT, const bf16_t* WiT, const float* convw, const float* convb, const float* ba, const float* bi, const float* lam,
                  f32x2* sums, unsigned* au, bool fin, int bx, int G, int tid, int wid, int lane) {
    constexpr int NU = BPC * NCH * 16;
    typedef _Float16 h2_t __attribute__((ext_vector_type(2)));
    LAS float* XC = (LAS float*)lds; LAS float* AA = (LAS float*)(lds + 32768); LAS bf16_t* XB = (LAS bf16_t*)(lds + 65536); LAS bf16_t* WL = (LAS bf16_t*)(lds + 83968);
    LAS float* SG = (LAS float*)(lds + 102400); LAS float* PF = (LAS float*)(lds + 106496); LAS float* CW = (LAS float*)(lds + 110592);
    const int t = tid >> 2, cq = tid & 3;
    const int tt = wid >> 1, nt = wid & 1, l32 = lane & 31, hl = lane >> 5;
    int cur_hbk = -1; float bac = 0.f, bic = 0.f, k8c = 0.f;
    u32x4 xr[4][2];
#define RNN_LOAD_XR(uu) do { const int hb_ = (uu) & 15, c_ = ((uu) >> 4) & 63, b_ = (uu) >> 10; const size_t rb_ = (size_t)b_ * SEQ + c_ * 128; \
        _Pragma("unroll") for (int tap = 0; tap < 4; ++tap) { const int tp_ = c_ * 128 + t + tap - 3; \
            if (tp_ >= 0) { const bf16_t* src_ = P + (rb_ + t + tap - 3) * DIN + PC_X + hb_ * 64 + 16 * cq; xr[tap][0] = *(const u32x4*)src_; xr[tap][1] = *(const u32x4*)(src_ + 8); } \
            else { xr[tap][0] = (u32x4){0u, 0u, 0u, 0u}; xr[tap][1] = (u32x4){0u, 0u, 0u, 0u}; } } } while (0)
    if (fin) {
        for (int u2 = bx; u2 < NU; u2 += G) {
            const int hbk = u2 & 15, c = (u2 >> 4) & 63, b = u2 >> 10;
            const size_t rowbase = (size_t)b * SEQ + c * 128; const int ch0 = hbk * 64, ch = lane, seg = wid;
            const unsigned* aup = au + (rowbase + 16 * seg) * D + ch0 + ch;
            bf16_t* yp = P + (rowbase + 16 * seg) * DIN + PC_Y + ch0 + ch;
            unsigned w[16]; unsigned short yv[16];
#pragma unroll
            for (int j = 0; j < 16; ++j) { w[j] = aup[(size_t)j * D]; yv[j] = yp[(size_t)j * DIN]; }
            float Ap = 1.f, Hp = 0.f;
#pragma unroll
            for (int k = 0; k < 8; ++k) { const int j = 8 * wid + k; if (j < c) { const f32x2 sv = sums[((size_t)b * NCH + j) * D + ch0 + lane]; Hp = sv.x * Hp + sv.y; Ap *= sv.x; } }
            float av[16], uv[16]; float A = 1.f, H = 0.f;
#pragma unroll
            for (int j = 0; j < 16; ++j) { const h2_t v = __builtin_bit_cast(h2_t, w[j]); av[j] = 1.0f - (float)v.x; uv[j] = (float)v.y; H = av[j] * H + uv[j]; A *= av[j]; }
            SG[seg * 64 + ch] = A; SG[512 + seg * 64 + ch] = H; PF[wid * 64 + lane] = Ap; PF[512 + wid * 64 + lane] = Hp;
            __syncthreads();
            float h = 0.f;
#pragma unroll
            for (int q8 = 0; q8 < 8; ++q8) h = PF[q8 * 64 + ch] * h + PF[512 + q8 * 64 + ch];
            for (int s2 = 0; s2 < seg; ++s2) h = SG[s2 * 64 + ch] * h + SG[512 + s2 * 64 + ch];
#pragma unroll
            for (int j = 0; j < 16; ++j) { h = av[j] * h + uv[j]; const float o = h * gelu_tanh(bf1(yv[j])); yp[(size_t)j * DIN] = (bf16_t)(pk2(o, 0.f) & 0xffffu); }
            __syncthreads();
        }
        return;
    }
    int u = bx; if (u >= NU) return;
    RNN_LOAD_XR(u);
    for (; u < NU; u += G) {
        const int hbk = u & 15, c = (u >> 4) & 63, b = u >> 10;
        const size_t rowbase = (size_t)b * SEQ + c * 128; const int ch0 = hbk * 64;
        if (hbk != cur_hbk) {
            const int nn = tid >> 3, k8 = tid & 7;
            *(LAS u32x4*)(WL + nn * 72 + 8 * k8) = *(const u32x4*)(WaT + (size_t)hbk * 4096 + nn * 64 + 8 * k8);
            *(LAS u32x4*)(WL + 64 * 72 + nn * 72 + 8 * k8) = *(const u32x4*)(WiT + (size_t)hbk * 4096 + nn * 64 + 8 * k8);
            if (tid < 320) CW[tid] = tid < 256 ? convw[(tid >> 6) * D + ch0 + (tid & 63)] : convb[ch0 + tid - 256];
            const int chg = ch0 + 32 * nt + l32;
            bac = ba[chg]; bic = bi[chg]; k8c = -8.0f * LOG2E * log1pf(expf(-lam[chg]));
            cur_hbk = hbk;
            __syncthreads();
        }
        unsigned short yv[16]; float Ap = 1.f, Hp = 0.f;
        bf16_t* yp = P + (rowbase + 16 * wid) * DIN + PC_Y + ch0 + lane;
        if (fin) {
#pragma unroll
            for (int j = 0; j < 16; ++j) yv[j] = yp[(size_t)j * DIN];
#pragma unroll
            for (int k = 0; k < 8; ++k) { const int j = 8 * wid + k; if (j < c) { const f32x2 sv = sums[((size_t)b * NCH + j) * D + ch0 + lane]; Hp = sv.x * Hp + sv.y; Ap *= sv.x; } }
        }
        {
            f32x4 acc[4];
#pragma unroll
            for (int j = 0; j < 4; ++j) acc[j] = *(const LAS f32x4*)(CW + 256 + 16 * cq + 4 * j);
#pragma unroll
            for (int tap = 0; tap < 4; ++tap) {
                const u32x4 x0 = xr[tap][0], x1 = xr[tap][1];
                const LAS float* wp = CW + tap * 64 + 16 * cq;
                const f32x4 w0 = *(const LAS f32x4*)wp, w1 = *(const LAS f32x4*)(wp + 4), w2 = *(const LAS f32x4*)(wp + 8), w3 = *(const LAS f32x4*)(wp + 12);
                acc[0] += (f32x4){bflo(x0.x), bfhi(x0.x), bflo(x0.y), bfhi(x0.y)} * w0; acc[1] += (f32x4){bflo(x0.z), bfhi(x0.z), bflo(x0.w), bfhi(x0.w)} * w1;
                acc[2] += (f32x4){bflo(x1.x), bfhi(x1.x), bflo(x1.y), bfhi(x1.y)} * w2; acc[3] += (f32x4){bflo(x1.z), bfhi(x1.z), bflo(x1.w), bfhi(x1.w)} * w3;
            }
#pragma unroll
            for (int j = 0; j < 4; ++j) *(LAS f32x4*)(XC + t * 64 + 16 * cq + 4 * j) = acc[j];
            u32x4 o0, o1; o0.x = pk2(acc[0].x, acc[0].y); o0.y = pk2(acc[0].z, acc[0].w); o0.z = pk2(acc[1].x, acc[1].y); o0.w = pk2(acc[1].z, acc[1].w);
            o1.x = pk2(acc[2].x, acc[2].y); o1.y = pk2(acc[2].z, acc[2].w); o1.z = pk2(acc[3].x, acc[3].y); o1.w = pk2(acc[3].z, acc[3].w);
            *(LAS u32x4*)(XB + t * 72 + 16 * cq) = o0; *(LAS u32x4*)(XB + t * 72 + 16 * cq + 8) = o1;
        }
        if (u + G < NU) RNN_LOAD_XR(u + G);
        if (fin) { PF[wid * 64 + lane] = Ap; PF[512 + wid * 64 + lane] = Hp; }
        __syncthreads();
        {
            f32x16 aR, aI;
#pragma unroll
            for (int i = 0; i < 16; ++i) { aR[i] = 0.f; aI[i] = 0.f; }
#pragma unroll
            for (int s = 0; s < 4; ++s) {
                const bf16x8 af = *(const LAS bf16x8*)(XB + (32 * tt + l32) * 72 + 16 * s + 8 * hl);
                const bf16x8 bR = *(const LAS bf16x8*)(WL + (32 * nt + l32) * 72 + 16 * s + 8 * hl);
                const bf16x8 bI = *(const LAS bf16x8*)(WL + 64 * 72 + (32 * nt + l32) * 72 + 16 * s + 8 * hl);
                aR = MFMA32(af, bR, aR); aI = MFMA32(af, bI, aI);
            }
            const int ch = 32 * nt + l32;
#pragma unroll
            for (int i = 0; i < 16; ++i) { const int tok = 32 * tt + 8 * (i >> 2) + 4 * hl + (i & 3);
                const float r = sigm(aR[i] + bac), ig = sigm(aI[i] + bic);
                const float a = __builtin_amdgcn_exp2f(k8c * r);
                const float mult = __builtin_amdgcn_sqrtf(fmaxf(1.0f - a * a, 0.f));
                const float xv = XC[tok * 64 + ch];
                const float uu_ = mult * ig * xv; AA[tok * 64 + ch] = a; XC[tok * 64 + ch] = uu_;
                { const h2_t pv = {(_Float16)(1.0f - a), (_Float16)uu_}; au[(rowbase + tok) * D + ch0 + ch] = __builtin_bit_cast(unsigned, pv); } }
        }
        __syncthreads();
        {
            const int ch = lane, seg = wid;
            float A = 1.f, H = 0.f;
#pragma unroll
            for (int j = 0; j < 16; ++j) { const int tk = 16 * seg + j; const float a = AA[tk * 64 + ch], uu = XC[tk * 64 + ch]; H = a * H + uu; A *= a; }
            SG[seg * 64 + ch] = A; SG[512 + seg * 64 + ch] = H;
            __syncthreads();
            if (!fin) {
                if (wid == 0) { float Ac = 1.f, Hc = 0.f;
#pragma unroll
                    for (int s = 0; s < 8; ++s) { const float sa = SG[s * 64 + ch]; Hc = sa * Hc + SG[512 + s * 64 + ch]; Ac *= sa; }
                    sums[((size_t)b * NCH + c) * D + ch0 + ch] = (f32x2){Ac, Hc}; }
            } else {
                float h = 0.f;
#pragma unroll
                for (int w = 0; w < 8; ++w) h = PF[w * 64 + ch] * h + PF[512 + w * 64 + ch];
                for (int s = 0; s < seg; ++s) h = SG[s * 64 + ch] * h + SG[512 + s * 64 + ch];
#pragma unroll
                for (int j = 0; j < 16; ++j) { const int tk = 16 * seg + j; const float a = AA[tk * 64 + ch], uu = XC[tk * 64 + ch]; h = a * h + uu;
                    const float o = h * gelu_tanh(bf1(yv[j]));
                    yp[(size_t)j * DIN] = (bf16_t)(pk2(o, 0.f) & 0xffffu); }
            }
        }
        __syncthreads();
    }
#undef RNN_LOAD_XR
}

DI void pool_item(const bf16_t* P, bf16_t* pooled, int idx) {
    const int cg8 = idx & 127, run = idx >> 7; const size_t row0 = (size_t)run * 8; const int t0 = (int)(row0 & (SEQ - 1));
    const int ch = cg8 * 8, w = 2 << (ch >> 8);
    const bf16_t* src = P + PC_P + ch;
    float sum[8];
#pragma unroll
    for (int j = 0; j < 8; ++j) sum[j] = 0.f;
    for (int k = 1; k < w; ++k) if (t0 - k >= 0) { const u32x4 x = *(const u32x4*)(src + (row0 - k) * DIN);
        sum[0] += bflo(x.x); sum[1] += bfhi(x.x); sum[2] += bflo(x.y); sum[3] += bfhi(x.y); sum[4] += bflo(x.z); sum[5] += bfhi(x.z); sum[6] += bflo(x.w); sum[7] += bfhi(x.w); }
#pragma unroll
    for (int j = 0; j < 8; ++j) {
        const int t = t0 + j; const u32x4 x = *(const u32x4*)(src + (row0 + j) * DIN);
        const float cur[8] = {bflo(x.x), bfhi(x.x), bflo(x.y), bfhi(x.y), bflo(x.z), bfhi(x.z), bflo(x.w), bfhi(x.w)};
#pragma unroll
        for (int e = 0; e < 8; ++e) sum[e] += cur[e];
        const float ic = __builtin_amdgcn_rcpf((float)(t + 1 < w ? t + 1 : w));
        u32x4 o; o.x = pk2(sum[0] * ic - cur[0], sum[1] * ic - cur[1]); o.y = pk2(sum[2] * ic - cur[2], sum[3] * ic - cur[3]);
        o.z = pk2(sum[4] * ic - cur[4], sum[5] * ic - cur[5]); o.w = pk2(sum[6] * ic - cur[6], sum[7] * ic - cur[7]);
        *(u32x4*)(pooled + (row0 + j) * D + ch) = o;
        if (t - w + 1 >= 0) { const u32x4 y = *(const u32x4*)(src + (row0 + j - w + 1) * DIN);
            sum[0] -= bflo(y.x); sum[1] -= bfhi(y.x); sum[2] -= bflo(y.y); sum[3] -= bfhi(y.y); sum[4] -= bflo(y.z); sum[5] -= bfhi(y.z); sum[6] -= bflo(y.w); sum[7] -= bfhi(y.w); }
    }
}


#define XB_TMO      128
#define XB_XCNT(j)  (256  + 64 * (j))
#define XB_XSUB(j)  (1280 + 64 * (j))
#define XB_XGEN(j)  (2304 + 64 * (j))
#define XB_TOP      3328
#define XB_TOPGEN   3392
#define XCD_BAR_WORDS 3456
#define XB_SPIN_CAP (1u << 22)
DI unsigned xb_ld(unsigned* p)              { return __hip_atomic_load(p, __ATOMIC_RELAXED, __HIP_MEMORY_SCOPE_AGENT); }
DI unsigned xb_add(unsigned* p, unsigned v) { return __hip_atomic_fetch_add(p, v, __ATOMIC_RELAXED, __HIP_MEMORY_SCOPE_AGENT); }
DI unsigned xb_xcc_id() { return (unsigned)__builtin_amdgcn_s_getreg((3 << 11) | 20) & 0xFu; }
#define XB_SPIN(cond, bar) do { unsigned _sp = 0; while (cond) { __builtin_amdgcn_s_sleep(1); \
    if ((++_sp & 255u) == 0u) { if (xb_ld(&(bar)[XB_TMO])) break; if (_sp > XB_SPIN_CAP) { atomicAdd(&(bar)[XB_TMO], 1u); break; } } } } while (0)
struct XcdBarrier { unsigned* bar; unsigned x; volatile LAS unsigned* st; unsigned n; };
DI XcdBarrier xcd_barrier_post(unsigned* bar, volatile LAS unsigned* st, unsigned n) {
    XcdBarrier b; b.bar = bar; b.x = xb_xcc_id(); b.st = st; b.n = n;
    if (threadIdx.x == 0) (void)xb_add(&bar[XB_XCNT(b.x)], 1u);
    return b;
}
DI void xcd_barrier_complete(unsigned* bar, unsigned x, unsigned G, unsigned& nloc, unsigned& nx) {
    unsigned sum, cnt, mine, sp = 0u;
    for (;;) {
        sum = 0u; cnt = 0u; mine = 0u;
#pragma unroll
        for (unsigned j = 0; j < 16; ++j) { const unsigned c = xb_ld(&bar[XB_XCNT(j)]); sum += c; cnt += (c > 0u) ? 1u : 0u; mine = (j == x) ? c : mine; }
        if (sum == G) break;
        __builtin_amdgcn_s_sleep(1);
        if ((++sp & 255u) == 0u) { if (xb_ld(&bar[XB_TMO])) break; if (sp > XB_SPIN_CAP) { atomicAdd(&bar[XB_TMO], 1u); break; } }
    }
    nloc = mine > 0u ? mine : 1u; nx = cnt > 0u ? cnt : 1u;
}
DI void xcd_barrier(const XcdBarrier& b) {
    asm volatile("s_waitcnt vmcnt(0)" ::: "memory");
    __syncthreads();
    if (threadIdx.x == 0) {
        unsigned* bar = b.bar;
        __builtin_amdgcn_s_waitcnt(0);
        unsigned nloc = b.st[0], nx = b.st[1];
        if (nloc == 0u) { xcd_barrier_complete(bar, b.x, b.n, nloc, nx); b.st[0] = nloc; b.st[1] = nx; }
        const unsigned old = xb_add(&bar[XB_XSUB(b.x)], 1u);
        const unsigned gen = old / nloc;
        if (old + 1u == (gen + 1u) * nloc) {
            __builtin_amdgcn_fence(__ATOMIC_RELEASE, "agent");
            asm volatile("s_waitcnt vmcnt(0)" ::: "memory");
            const unsigned og = xb_add(&bar[XB_TOP], 1u);
            const unsigned tg = og / nx;
            if (og + 1u == (tg + 1u) * nx) xb_add(&bar[XB_TOPGEN], 1u);
            else XB_SPIN(xb_ld(&bar[XB_TOPGEN]) == tg, bar);
            __builtin_amdgcn_fence(__ATOMIC_ACQUIRE, "agent");
            xb_add(&bar[XB_XGEN(b.x)], 1u);
            asm volatile("s_waitcnt vmcnt(0)" ::: "memory");
        } else {
            XB_SPIN(xb_ld(&bar[XB_XGEN(b.x)]) == gen, bar);
            __builtin_amdgcn_fence(__ATOMIC_ACQUIRE, "agent");
            asm volatile("s_waitcnt vmcnt(0)" ::: "memory");
        }
    }
    __syncthreads();
}

__global__ void __launch_bounds__(512, 2) mega_fwd(Params p) {
    extern __shared__ __attribute__((aligned(16))) unsigned char lds_raw[];
    LAS unsigned char* lds = (LAS unsigned char*)lds_raw;
    cg::grid_group grid = cg::this_grid();
    const int Gfull = gridDim.x, bfull = blockIdx.x;
    const int half = (bfull & 7) >> 2, bx = (bfull >> 3) * 4 + (bfull & 3), G = Gfull >> 1, NGW = G * 8;
#define TID_LOCAL() int tid_ = threadIdx.x; asm volatile("" : "+v"(tid_)); const int tid = tid_, lane = tid & 63, wid = __builtin_amdgcn_readfirstlane(tid >> 6), gw = bx * 8 + wid; (void)lane; (void)gw; (void)tid
    volatile LAS unsigned* xst = (volatile LAS unsigned*)(lds + 131072 + 512);
    if (threadIdx.x < 2) xst[threadIdx.x] = 0u;
    __syncthreads();
    unsigned* ctl = (unsigned*)(p.ws + WS_CTL);
    XcdBarrier xbar = xcd_barrier_post(ctl + half * 4096, xst, (unsigned)G);
    unsigned* wflag = ctl + 8192 + 64;
    { TID_LOCAL(); const int gwf = bfull * 8 + wid; prologue(p, lds, 0, 1, true, gwf, Gfull * 8, wid, lane); }
    grid.sync();
    if (half == 1) {
        TID_LOCAL(); prologue(p, lds, 1, DEPTH, false, gw, NGW, wid, lane);
        asm volatile("s_waitcnt vmcnt(0)" ::: "memory"); __syncthreads();
        if (tid == 0) { __builtin_amdgcn_fence(__ATOMIC_RELEASE, "agent"); asm volatile("s_waitcnt vmcnt(0)" ::: "memory"); __hip_atomic_fetch_add(wflag, 1u, __ATOMIC_RELAXED, __HIP_MEMORY_SCOPE_AGENT); }
    }
    bool first = true, wready = (half == 1);
#define STEP_SYNC() do { if (!first) xcd_barrier(xbar); first = false; } while (0)
    for (int cj = 0; cj < NCHUNK / 2; ++cj) {
        const int ck = half * (NCHUNK / 2) + cj;
        { STEP_SYNC(); TID_LOCAL(); int ckx = ck; unsigned char* ws = p.ws + (size_t)half * HALF_STRIDE; asm volatile("" : "+s"(ckx), "+s"(ws));
            rowpass(p.in[I_X] + (size_t)ckx * MC * D, nullptr, nullptr, p.in[I_NMIXPRE], p.out + (size_t)ckx * MC * D, (bf16_t*)(ws + WS_HB), gw, NGW, lane); }
        for (int l = 0; l < DEPTH; ++l) {
            if (!wready && l >= 1) {
                if (threadIdx.x == 0) { unsigned sp = 0; while (__hip_atomic_load(wflag, __ATOMIC_RELAXED, __HIP_MEMORY_SCOPE_AGENT) < (unsigned)G) { __builtin_amdgcn_s_sleep(2); if (++sp > (1u << 24)) break; }
                    __builtin_amdgcn_fence(__ATOMIC_ACQUIRE, "agent"); asm volatile("s_waitcnt vmcnt(0)" ::: "memory"); }
                __syncthreads(); wready = true;
            }
            for (int ph = 0; ph < 9; ++ph) {
                STEP_SYNC();
                if (ph == 1) {
                    TID_LOCAL(); int lx = l; unsigned char* ws = p.ws + (size_t)half * HALF_STRIDE; unsigned char* wg = p.ws; asm volatile("" : "+s"(lx), "+s"(ws), "+s"(wg));
                    bf16_t* proj = (bf16_t*)(ws + WS_PROJ);
                    for (int u = bx; u < BPC * 64 * 4; u += G) attn_unit(lds, proj, (const float*)(wg + WS_ROPE), p.in[I_SINKS] + lx * 16, u, tid, wid, lane);
                    for (int idx = bx * 512 + tid; idx < (MC / 8) * 128; idx += G * 512) pool_item(proj, (bf16_t*)(ws + WS_POOLED), idx);
                }
                if (ph == 1 || ph == 2) {
                    TID_LOCAL(); int lx = l; unsigned char* ws = p.ws + (size_t)half * HALF_STRIDE; unsigned char* wg = p.ws; asm volatile("" : "+s"(lx), "+s"(ws), "+s"(wg));
                    const bf16_t* Wl = (const bf16_t*)(wg + WS_W) + (size_t)lx * WO_LAYER;
                    rnn_phase(lds, (bf16_t*)(ws + WS_PROJ), Wl + WO_RA, Wl + WO_RI, p.in[I_CONVW] + (size_t)lx * 4 * D, p.in[I_CONVB] + lx * D, p.in[I_BRGA] + lx * D, p.in[I_BRGI] + lx * D, p.in[I_LAM] + lx * D,
                              (f32x2*)(ws + WS_SUMS), (unsigned*)(wg + WS_AU + (size_t)half * 64 * MiB), ph == 2, bx, G, tid, wid, lane);
                }
                if (ph == 5 || ph == 8) {
                    TID_LOCAL(); int lx = l, ckx = ck; unsigned char* ws = p.ws + (size_t)half * HALF_STRIDE; asm volatile("" : "+s"(lx), "+s"(ckx), "+s"(ws));
                    const float* gpost = (ph == 5 ? p.in[I_NMIXPOST] : p.in[I_NMLPPOST]) + lx * D;
                    const float* gnext = ph == 5 ? p.in[I_NMLPPRE] + lx * D : (lx + 1 < DEPTH ? p.in[I_NMIXPRE] + (lx + 1) * D : nullptr);
                    float* hck = p.out + (size_t)ckx * MC * D;
                    rowpass(lx == 0 && ph == 5 ? p.in[I_X] + (size_t)ckx * MC * D : hck, (const bf16_t*)(ws + WS_PROJ + PROJ_MIX_OFF), gpost, gnext, hck, (bf16_t*)(ws + WS_HB), gw, NGW, lane);
                }
                if (ph == 0 || ph == 2 || ph == 3 || ph == 4 || ph == 6 || ph == 7) {
                    int lx = l; unsigned char* ws = p.ws + (size_t)half * HALF_STRIDE; unsigned char* wg = p.ws; asm volatile("" : "+s"(lx), "+s"(ws), "+s"(wg));
                    pg8::gemm_phase(lds, ph, ws, wg, lx, p.in[I_PSCALE] + lx * D, G, bx, (Gfull & 7) == 0 ? 4 : 1);
                }
            }
        }
    }
}

#ifndef MK_MULTI
#define MK_MULTI 0
#endif
extern "C" void kernel_launch(void* const* d_in, const int* in_sizes, int n_in, void* d_out, int out_size, void* d_ws, size_t ws_size, hipStream_t stream) {
    static int grid = 0;
    if (grid == 0) {
        if (n_in != 22 || ws_size < WS_END) { fprintf(stderr, "kernel_launch: unexpected n_in %d / ws_size %zu (need %zu)\n", n_in, ws_size, (size_t)WS_END); grid = -1; return; }
        int dev = 0, cus = 0, per_cu = 0;
        hipGetDevice(&dev); hipDeviceGetAttribute(&cus, hipDeviceAttributeMultiprocessorCount, dev);
        if (hipFuncSetAttribute((const void*)mega_fwd, hipFuncAttributeMaxDynamicSharedMemorySize, LDS_BYTES) != hipSuccess) { fprintf(stderr, "kernel_launch: hipFuncSetAttribute failed\n"); grid = -1; return; }
        if (hipOccupancyMaxActiveBlocksPerMultiprocessor(&per_cu, (const void*)mega_fwd, 512, LDS_BYTES) != hipSuccess || per_cu < 1) { fprintf(stderr, "kernel_launch: occupancy query gave %d\n", per_cu); per_cu = 1; }
        (void)hipGetLastError();
        grid = (cus * per_cu) & ~7;
        fprintf(stderr, "kernel_launch: grid %d (cus %d x %d)\n", grid, cus, per_cu);
    }
    if (grid < 0) return;
    if (hipMemsetAsync((char*)d_ws + WS_CTL, 0, CTL_ZERO_BYTES, stream) != hipSuccess) { fprintf(stderr, "kernel_launch: memset failed\n"); return; }
    Params p{};
    for (int i = 0; i < 22; ++i) p.in[i] = (const float*)d_in[i];
    p.out = (float*)d_out; p.ws = (unsigned char*)d_ws;
    for (int j = 0; j < 8; ++j) p.inv_freq[j] = (float)pow(500000.0, -(double)j / 8.0);
    p.lo = 0; p.hi = 0; void* args[] = {&p};
    hipError_t e = hipLaunchCooperativeKernel((const void*)mega_fwd, dim3(grid), dim3(512), args, LDS_BYTES, stream);
    if (e != hipSuccess) fprintf(stderr, "cooperative launch failed: %s (grid %d)\n", hipGetErrorString(e), grid);
}
```

```cpp
#include <hip/hip_runtime.h>
#include <hip/hip_cooperative_groups.h>
#include <cstdio>
#include <cstdint>
#include <cmath>
namespace cg = cooperative_groups;

#define LAS __attribute__((address_space(3)))
#define DI __device__ __forceinline__
typedef unsigned short bf16_t;
typedef short bf16x8 __attribute__((ext_vector_type(8)));
typedef short s16x4 __attribute__((ext_vector_type(4)));
typedef float f32x2 __attribute__((ext_vector_type(2)));
typedef float f32x4 __attribute__((ext_vector_type(4)));
typedef float f32x16 __attribute__((ext_vector_type(16)));
typedef unsigned u32x2 __attribute__((ext_vector_type(2)));
typedef unsigned u32x4 __attribute__((ext_vector_type(4)));
typedef __bf16 bf16x2_t __attribute__((ext_vector_type(2)));

constexpr int D = 1024, SEQ = 8192, BATCH = 8, DEPTH = 4, DIN = 7680, DFF = 4096;
constexpr int NCHUNK = 4, BPC = BATCH / NCHUNK, MC = BPC * SEQ;
constexpr int PC_Q = 0, PC_Y = 1024, PC_P = 2048, PC_K = 3072, PC_V = 3328, PC_X = 3584, PC_G = 4608;
constexpr size_t WO_IN = 0, WO_BR = WO_IN + (size_t)DIN * D, WO_OUT = WO_BR + 3ull * D * D, WO_PG = WO_OUT + (size_t)D * D, WO_UP = WO_PG + 4ull * 256 * 256,
                 WO_DN = WO_UP + (size_t)DFF * D, WO_RA = WO_DN + (size_t)DFF * D, WO_RI = WO_RA + 16ull * 64 * 64, WO_LAYER = WO_RI + 16ull * 64 * 64;
constexpr size_t MiB = 1ull << 20;
constexpr size_t WS_ROPE = 0, WS_W = 3 * MiB, WS_SUMS = 163 * MiB, WS_HB = 164 * MiB, WS_POOLED = 196 * MiB, WS_MERGED = 228 * MiB, WS_PROJ = 260 * MiB, HALF_STRIDE = 337 * MiB,
                 WS_CTL = 838 * MiB, WS_AU = 840 * MiB  , WS_END = 968 * MiB;
constexpr size_t CTL_ZERO_BYTES = 65536;
static_assert(WO_LAYER * 2 * DEPTH <= 160 * MiB, "weights fit");
static_assert((size_t)MC * DIN * 2 == 240 * MiB && WS_PROJ + 240 * MiB <= WS_SUMS + HALF_STRIDE, "proj size");
constexpr size_t PROJ_MIX_OFF = 128 * MiB;
constexpr int LDS_BYTES = 147456;
constexpr float EPS = 1e-6f;
constexpr float LOG2E = 1.4426950408889634f;

DI unsigned pk2(float lo, float hi) { f32x2 v = {lo, hi}; bf16x2_t b = __builtin_convertvector(v, bf16x2_t); return __builtin_bit_cast(unsigned, b); }
DI float bflo(unsigned u) { return __uint_as_float(u << 16); }
DI float bfhi(unsigned u) { return __uint_as_float(u & 0xffff0000u); }
DI float bf1(bf16_t u) { return __uint_as_float(((unsigned)u) << 16); }
DI float wave_sum(float v) {
#pragma unroll
    for (int o = 1; o < 64; o <<= 1) v += __shfl_xor(v, o);
    return v;
}
DI float sigm(float x) { return __builtin_amdgcn_rcpf(1.0f + __builtin_amdgcn_exp2f(-x * LOG2E)); }
DI float gelu_tanh(float y) { const float z = 0.7978845608028654f * (y + 0.044715f * y * y * y); const float t = 1.0f - 2.0f * __builtin_amdgcn_rcpf(1.0f + __builtin_amdgcn_exp2f(2.0f * LOG2E * z)); return 0.5f * y * (1.0f + t); }
#define MFMA32(a, b, c) __builtin_amdgcn_mfma_f32_32x32x16_bf16((a), (b), (c), 0, 0, 0)

namespace pg8 {
constexpr int BM = 256, BK = 64, HALF = 128, HTB = HALF * BK * 2, STAGE_BYTES = 8 * HTB, NXCD = 8, WGM = 8;
__host__ __device__ __forceinline__ int lds_byte(int r, int c) { const int st = (r >> 4) * 2 + (c >> 5), rr = r & 15, cc = c & 31, ob = rr * 64 + cc * 2; return st * 1024 + (ob ^ (((ob >> 9) & 1) << 5)); }
__host__ __device__ __forceinline__ void stage_rc(int b, int& R, int& C) { const int st = b / 1024, sb = b % 1024, swz = sb ^ (((sb >> 9) & 1) << 5); R = (st >> 1) * 16 + swz / 64; C = (st & 1) * 32 + (swz % 64) / 2; }
__host__ __device__ __forceinline__ int perm32(int rho) { const int n = rho >> 4, i = rho & 15; return 8 * (i >> 2) + 4 * n + (i & 3); }

struct Unit { int pm, pn, z; };
enum { EP_BF16 = 0, EP_RELU2 = 1, EP_SCALE = 2, EP_MERGE = 4 };
struct Cfg { const bf16_t* A; const bf16_t* Bt; int lda, ldb, K, N, lz, zA, zB, pnA; };
DI Cfg gemm_cfg(int ph, unsigned char* ws, unsigned char* wg, int l) {
    const bf16_t* Wl = (const bf16_t*)(wg + WS_W) + (size_t)l * WO_LAYER; const bf16_t* proj = (const bf16_t*)(ws + WS_PROJ);
    Cfg c; c.zA = 0; c.zB = 0; c.pnA = 0; c.lda = D; c.ldb = D; c.K = D; c.N = D; c.lz = 4;
    if (ph == 0) { c.A = (const bf16_t*)(ws + WS_HB); c.Bt = Wl + WO_IN; c.N = DIN; }
    else if (ph == 2) { c.A = (const bf16_t*)(ws + WS_POOLED); c.pnA = 256; c.Bt = Wl + WO_PG; c.K = 256; c.ldb = 256; c.lz = 2; }
    else if (ph == 3) { c.A = proj + PC_Q; c.lda = DIN; c.zA = D; c.Bt = Wl + WO_BR; c.zB = D * D; c.K = 3 * D; }
    else if (ph == 4) { c.A = (const bf16_t*)(ws + WS_MERGED); c.Bt = Wl + WO_OUT; }
    else if (ph == 6) { c.A = (const bf16_t*)(ws + WS_HB); c.Bt = Wl + WO_UP; c.N = DFF; }
    else { c.A = proj; c.lda = DFF; c.Bt = Wl + WO_DN; c.K = DFF; c.ldb = DFF; c.lz = 6; }
    return c;
}
struct Sched {
    int nM, nN, nZ, nwg, G, c, nx;
    DI void init(int M, int N, int nZ_, int G_, int c_, int nx_) { nM = M / BM; nN = N / BM; nZ = nZ_; nwg = nM * nN; G = G_; c = c_; nx = nx_; }
    DI bool next(int i, Unit& u) const {
        const int t = i; u.z = 0;
        const long L = (long)t * G + c; if (L >= nwg) return false;
        int wgid = (int)L; { const int q = nwg / nx, r = nwg % nx, xcd = wgid % nx, off = wgid / nx; wgid = (xcd < r ? xcd * (q + 1) : r * (q + 1) + (xcd - r) * q) + off; }
        const int nig = WGM * nN, gid = wgid / nig, fm = gid * WGM, gsz = (nM - fm) < WGM ? (nM - fm) : WGM;
        u.pm = fm + ((wgid % nig) % gsz); u.pn = (wgid % nig) / gsz; return true;
    }
};

DI unsigned ror8(unsigned x) { return (unsigned)__builtin_amdgcn_mov_dpp((int)x, 0x128, 0xf, 0xf, true); }
DI void store_lines(bf16_t* Ob, size_t row, int ldc, int colw, int fr, int fq, const u32x4& w0, const u32x4& w1) {
    const bool lo = (fr & 8) == 0;
    const u32x4 snd = lo ? w1 : w0;
    u32x4 rcv; rcv.x = ror8(snd.x); rcv.y = ror8(snd.y); rcv.z = ror8(snd.z); rcv.w = ror8(snd.w);
    const u32x4 dA = lo ? w0 : rcv, dB = lo ? rcv : w1;
    const int col = colw + 8 * fq + (lo ? 0 : 32);
    __builtin_nontemporal_store(dA, (u32x4*)(Ob + (lo ? row : row - 8) * ldc + col));
    __builtin_nontemporal_store(dB, (u32x4*)(Ob + (lo ? row + 8 : row) * ldc + col));
}
DI void epilogue(const f32x4 (&acc)[2][2][4][2], int ph, unsigned char* ws, const float* pscale, const Unit& u, int wr, int wc, int fr, int fq) {
    const int row0 = u.pm * BM + wr * 64 + fr, colw = u.pn * BM + wc * 64, col0 = colw + 8 * fq;
    const int mode = (ph == 0 || ph == 4 || ph == 7) ? EP_BF16 : ph == 2 ? EP_SCALE : ph == 3 ? EP_MERGE : EP_RELU2;
    bf16_t* Ob = ph == 3 ? (bf16_t*)(ws + WS_MERGED) : (ph == 4 || ph == 7) ? (bf16_t*)(ws + WS_PROJ + PROJ_MIX_OFF) : (bf16_t*)(ws + WS_PROJ) + (ph == 2 ? PC_P : 0);
    const int ldc = (ph == 0 || ph == 2) ? DIN : (ph == 6 ? DFF : D);
    if (mode == EP_BF16 || mode == EP_RELU2) {
        const bool r2 = mode == EP_RELU2;
#pragma unroll
        for (int ai = 0; ai < 2; ++ai)
#pragma unroll
            for (int m = 0; m < 4; ++m) { u32x4 w[2];
#pragma unroll
                for (int bj = 0; bj < 2; ++bj) { f32x4 v0 = acc[ai][bj][m][0], v1 = acc[ai][bj][m][1];
                    if (r2) {
#pragma unroll
                        for (int j = 0; j < 4; ++j) { const float a = fmaxf(v0[j], 0.f), b = fmaxf(v1[j], 0.f); v0[j] = a * a; v1[j] = b * b; } }
                    w[bj].x = pk2(v0[0], v0[1]); w[bj].y = pk2(v0[2], v0[3]); w[bj].z = pk2(v1[0], v1[1]); w[bj].w = pk2(v1[2], v1[3]); }
                store_lines(Ob, (size_t)(row0 + ai * HALF + m * 16), ldc, colw, fr, fq, w[0], w[1]); }
    } else if (mode == EP_SCALE) {
        f32x4 sc[2][2];
#pragma unroll
        for (int bj = 0; bj < 2; ++bj)
#pragma unroll
            for (int n = 0; n < 2; ++n) sc[bj][n] = *(const f32x4*)(pscale + col0 + bj * 32 + 4 * n);
#pragma unroll
        for (int ai = 0; ai < 2; ++ai)
#pragma unroll
            for (int m = 0; m < 4; ++m) { u32x4 w[2];
#pragma unroll
                for (int bj = 0; bj < 2; ++bj) { const f32x4 v0 = acc[ai][bj][m][0] * sc[bj][0], v1 = acc[ai][bj][m][1] * sc[bj][1];
                    w[bj].x = pk2(v0[0], v0[1]); w[bj].y = pk2(v0[2], v0[3]); w[bj].z = pk2(v1[0], v1[1]); w[bj].w = pk2(v1[2], v1[3]); }
                store_lines(Ob, (size_t)(row0 + ai * HALF + m * 16), ldc, colw, fr, fq, w[0], w[1]); }
    } else {
        const bf16_t* gate = (const bf16_t*)(ws + WS_PROJ) + PC_G + 2 * D;
#pragma unroll
        for (int ai = 0; ai < 2; ++ai)
#pragma unroll
            for (int m = 0; m < 4; ++m) { const size_t row = (size_t)(row0 + ai * HALF + m * 16); u32x4 w[2];
#pragma unroll
                for (int bj = 0; bj < 2; ++bj) { const int col = col0 + bj * 32;
                    const u32x4 gw = *(const u32x4*)(gate + row * DIN + col);
                    const float ga[8] = {bflo(gw.x), bfhi(gw.x), bflo(gw.y), bfhi(gw.y), bflo(gw.z), bfhi(gw.z), bflo(gw.w), bfhi(gw.w)};
                    float f[8];
#pragma unroll
                    for (int j = 0; j < 8; ++j) f[j] = __builtin_amdgcn_rcpf(1.0f + __builtin_amdgcn_exp2f(-fmaxf(ga[j], -30.f) * LOG2E));
                    const f32x4 v0 = acc[ai][bj][m][0] * (f32x4){f[0], f[1], f[2], f[3]}, v1 = acc[ai][bj][m][1] * (f32x4){f[4], f[5], f[6], f[7]};
                    w[bj].x = pk2(v0[0], v0[1]); w[bj].y = pk2(v0[2], v0[3]); w[bj].z = pk2(v1[0], v1[1]); w[bj].w = pk2(v1[2], v1[3]); }
                store_lines(Ob, row, ldc, colw, fr, fq, w[0], w[1]);
                asm volatile("" ::: "memory"); }
    }
}
DI void merge_carry(f32x4 (&acc)[2][2][4][2], unsigned char* ws, const Unit& u, int z, int wr, int wc, int fr, int fq) {
    const int row0 = u.pm * BM + wr * 64 + fr, col0 = u.pn * BM + wc * 64 + 8 * fq;
    const bf16_t* gate = (const bf16_t*)(ws + WS_PROJ) + PC_G + (size_t)z * D;
#pragma unroll
    for (int ai = 0; ai < 2; ++ai)
#pragma unroll
        for (int m = 0; m < 4; ++m) { const size_t row = (size_t)(row0 + ai * HALF + m * 16);
#pragma unroll
            for (int bj = 0; bj < 2; ++bj) { const int col = col0 + bj * 32;
                const u32x4 gw = *(const u32x4*)(gate + row * DIN + col), hw = *(const u32x4*)(gate + row * DIN + D + col);
                const float ga[8] = {bflo(gw.x), bfhi(gw.x), bflo(gw.y), bfhi(gw.y), bflo(gw.z), bfhi(gw.z), bflo(gw.w), bfhi(gw.w)};
                const float gb[8] = {bflo(hw.x), bfhi(hw.x), bflo(hw.y), bfhi(hw.y), bflo(hw.z), bfhi(hw.z), bflo(hw.w), bfhi(hw.w)};
                float f[8];
#pragma unroll
                for (int j = 0; j < 8; ++j) { const float ea = __builtin_amdgcn_exp2f(-fmaxf(ga[j], -30.f) * LOG2E), eb = __builtin_amdgcn_exp2f(-fmaxf(gb[j], -30.f) * LOG2E);
                    f[j] = (1.0f + eb) * __builtin_amdgcn_rcpf(1.0f + ea); }
                acc[ai][bj][m][0] = acc[ai][bj][m][0] * (f32x4){f[0], f[1], f[2], f[3]}; acc[ai][bj][m][1] = acc[ai][bj][m][1] * (f32x4){f[4], f[5], f[6], f[7]};
                asm volatile("" ::: "memory"); } }
}

DI void gemm_phase(LAS unsigned char* lds, int ph, unsigned char* ws, unsigned char* wg, int l, const float* pscale, int G, int cidx, int nx) {
    int tid_ = threadIdx.x; asm volatile("" : "+v"(tid_));
    const int tid = tid_, wid = __builtin_amdgcn_readfirstlane(tid >> 6), lane = tid & 63, wr = wid >> 2, wc = wid & 3, fr = lane & 15, fq = lane >> 4;
    const Cfg g0 = gemm_cfg(ph, ws, wg, l);
    const int nt = g0.K / BK, lda = g0.lda, ldb = g0.ldb, lz = g0.lz, ntzm = (1 << g0.lz) - 1;
    const size_t zAb = (size_t)g0.zA * 2, zBb = (size_t)g0.zB * 2;
    Sched S; S.init(MC, g0.N, 1, G, cidx, nx);
    unsigned voffA[2], voffB[2];
#pragma unroll
    for (int i = 0; i < 2; ++i) { int R, C; stage_rc(tid * 16 + i * 8192, R, C); const int Rb = (R >> 5) * 64 + perm32(R & 31);
        voffA[i] = (unsigned)(R * lda + C) * 2u; voffB[i] = (unsigned)(Rb * ldb + C) * 2u; }
    const size_t kstep = (size_t)(BK * 2);
    const size_t hstepA = (size_t)HALF * lda * 2, hstepB = (size_t)32 * ldb * 2;
    const unsigned ldsw = (unsigned)wid * 1024u;
    const int aoff = lds_byte(wr * 64 + fr, fq * 8), boff = lds_byte(wc * 32 + fr, fq * 8);
#define PG8_SA(b, h) (((b) * 2 + (h)) * HTB)
#define PG8_SB(b, h) ((4 + (b) * 2 + (h)) * HTB)
#define PG8_STAGE(bufoff, gbase, voff) do { _Pragma("unroll") for (int _i = 0; _i < 2; ++_i) \
        __builtin_amdgcn_global_load_lds((const unsigned*)((const char*)(gbase) + (voff)[_i]), (LAS unsigned*)(lds + (bufoff) + ldsw + _i * 8192), 16, 0, 0); } while (0)
#define PG8_LDA(dst, b, h) do { _Pragma("unroll") for (int m = 0; m < 4; ++m) _Pragma("unroll") for (int k = 0; k < 2; ++k) dst[m][k] = *(const LAS bf16x8*)(lds + PG8_SA(b, h) + aoff + m * 2048 + k * 1024); } while (0)
#define PG8_LDB(dst, b, h) do { _Pragma("unroll") for (int n = 0; n < 2; ++n) _Pragma("unroll") for (int k = 0; k < 2; ++k) dst[n][k] = *(const LAS bf16x8*)(lds + PG8_SB(b, h) + boff + n * 2048 + k * 1024); } while (0)
#define PG8_MMA(ai, bj, At, Bt) do { __builtin_amdgcn_s_setprio(1); _Pragma("unroll") for (int m = 0; m < 4; ++m) _Pragma("unroll") for (int n = 0; n < 2; ++n) _Pragma("unroll") for (int k = 0; k < 2; ++k) \
        acc[ai][bj][m][n] = __builtin_amdgcn_mfma_f32_16x16x32_bf16(Bt[n][k], At[m][k], acc[ai][bj][m][n], 0, 0, 0); __builtin_amdgcn_s_setprio(0); } while (0)
#define PG8_WAIT_V(n) asm volatile("s_waitcnt vmcnt(" #n ")" ::: "memory")
#define PG8_WAIT_L(n) asm volatile("s_waitcnt lgkmcnt(" #n ")" ::: "memory")
#define PG8_BAR __builtin_amdgcn_s_barrier()
#define PG8_SCHED __builtin_amdgcn_sched_barrier(0)
#define PG8_ABASE(u) ((const char*)gx.A + (size_t)(u).pm * tstepA + (size_t)(u).pn * gx.pnA * 2)
#define PG8_BBASE(u) ((const char*)gx.Bt + (size_t)(u).pn * tstepB)
#define PG8_KA(t_) (cA + (size_t)((t_) >> lz) * zAb + (size_t)((t_) & ntzm) * kstep)
#define PG8_KB(t_) (cB + (size_t)((t_) >> lz) * zBb + (size_t)((t_) & ntzm) * kstep)
#define PG8_RECFG() int phx = ph; int lx = l; unsigned char* wsx = ws; unsigned char* wgx = wg; asm volatile("" : "+s"(phx), "+s"(lx), "+s"(wsx), "+s"(wgx)); const Cfg gx = gemm_cfg(phx, wsx, wgx, lx); \
        const size_t tstepA = (size_t)BM * gx.lda * 2, tstepB = (size_t)BM * gx.ldb * 2
    Unit cur, nxt; int ui = 0;
    if (!S.next(0, cur)) return;
    f32x4 acc[2][2][4][2];
#pragma unroll
    for (int a = 0; a < 2; ++a)
#pragma unroll
        for (int b = 0; b < 2; ++b)
#pragma unroll
            for (int m = 0; m < 4; ++m)
#pragma unroll
                for (int n = 0; n < 2; ++n) acc[a][b][m][n] = (f32x4){0.f, 0.f, 0.f, 0.f};
    bf16x8 At[4][2], B0[2][2], B1[2][2];
    const char* cA; const char* cB; { PG8_RECFG(); cA = PG8_ABASE(cur); cB = PG8_BBASE(cur); }
    PG8_STAGE(PG8_SB(0, 0), cB, voffB); PG8_STAGE(PG8_SB(0, 1), cB + hstepB, voffB); PG8_STAGE(PG8_SA(0, 0), cA, voffA); PG8_STAGE(PG8_SA(0, 1), cA + hstepA, voffA);
    if (wr == 1) PG8_BAR;
    PG8_WAIT_V(2); PG8_BAR;
    PG8_STAGE(PG8_SB(1, 0), cB + kstep, voffB); PG8_STAGE(PG8_SA(1, 0), cA + kstep, voffA); PG8_STAGE(PG8_SB(1, 1), cB + hstepB + kstep, voffB);
    PG8_WAIT_V(6); PG8_BAR;
    for (;;) {
        const bool has_next = S.next(ui + 1, nxt);
        const char* nA = cA; const char* nB = cB; if (has_next) { PG8_RECFG(); nA = PG8_ABASE(nxt); nB = PG8_BBASE(nxt); }
        for (int t = 0; t < nt; t += 2) {
            const bool last = (t == nt - 2);
            const char* a1 = PG8_KA(t + 1);
            const char* a2 = last ? nA : PG8_KA(t + 2); const char* b2 = last ? nB : PG8_KB(t + 2);
            const char* a3 = a2 + kstep; const char* b3 = b2 + kstep;
            if (zAb != 0 && t != 0 && (t & ntzm) == 0) { unsigned char* wsx = ws; asm volatile("" : "+s"(wsx)); int frx = fr; asm volatile("" : "+v"(frx)); merge_carry(acc, wsx, cur, (t >> lz) - 1, wr, wc, frx, fq); }
            PG8_LDB(B0, 0, 0); PG8_LDB(B1, 0, 1); PG8_SCHED; PG8_LDA(At, 0, 0); PG8_STAGE(PG8_SA(1, 1), a1 + hstepA, voffA);
            PG8_WAIT_V(8); PG8_WAIT_L(0); PG8_BAR; PG8_MMA(0, 0, At, B0); PG8_MMA(0, 1, At, B1); PG8_BAR; PG8_SCHED;
            PG8_LDA(At, 0, 1); PG8_STAGE(PG8_SB(0, 0), b2, voffB); PG8_STAGE(PG8_SB(0, 1), b2 + hstepB, voffB); PG8_STAGE(PG8_SA(0, 0), a2, voffA);
            PG8_WAIT_V(8); PG8_WAIT_L(0); PG8_BAR; PG8_MMA(1, 0, At, B0); PG8_MMA(1, 1, At, B1); PG8_BAR; PG8_SCHED;
            PG8_LDB(B0, 1, 0); PG8_LDB(B1, 1, 1); PG8_SCHED; PG8_LDA(At, 1, 0); PG8_STAGE(PG8_SA(0, 1), a2 + hstepA, voffA);
            PG8_WAIT_V(8); PG8_WAIT_L(0); PG8_BAR; PG8_MMA(0, 0, At, B0); PG8_MMA(0, 1, At, B1); PG8_BAR; PG8_SCHED;
            PG8_LDA(At, 1, 1); PG8_STAGE(PG8_SB(1, 0), b3, voffB); PG8_STAGE(PG8_SB(1, 1), b3 + hstepB, voffB); PG8_STAGE(PG8_SA(1, 0), a3, voffA);
            PG8_WAIT_V(8); PG8_WAIT_L(0); PG8_BAR; PG8_MMA(1, 0, At, B0); PG8_MMA(1, 1, At, B1); PG8_BAR; PG8_SCHED;
        }
        if (wr == 0) PG8_BAR;
        { int phx = ph; unsigned char* wsx = ws; asm volatile("" : "+s"(phx), "+s"(wsx)); int frx = fr; asm volatile("" : "+v"(frx)); epilogue(acc, phx, wsx, pscale, cur, wr, wc, frx, fq); }
        if (!has_next) break;
#pragma unroll
        for (int a = 0; a < 2; ++a)
#pragma unroll
            for (int b = 0; b < 2; ++b)
#pragma unroll
                for (int m = 0; m < 4; ++m)
#pragma unroll
                    for (int n = 0; n < 2; ++n) acc[a][b][m][n] = (f32x4){0.f, 0.f, 0.f, 0.f};
        cur = nxt; cA = nA; cB = nB; ++ui;
        if (wr == 1) PG8_BAR;
    }
    PG8_WAIT_V(0);
    PG8_BAR;
#undef PG8_SA
#undef PG8_SB
#undef PG8_STAGE
#undef PG8_LDA
#undef PG8_LDB
#undef PG8_MMA
#undef PG8_WAIT_V
#undef PG8_WAIT_L
#undef PG8_BAR
#undef PG8_SCHED
#undef PG8_ABASE
#undef PG8_BBASE
#undef PG8_RECFG
#undef PG8_KA
#undef PG8_KB
}
}

DI void transpose_item(const float* W, int K, int N, bf16_t* WT, int drow0, LAS float* scr, int k0, int n0, int lane) {
#pragma unroll 8
    for (int i = 0; i < 32; ++i) { const int kk = 2 * i + (lane >> 5); scr[kk * 33 + (lane & 31)] = W[(size_t)(k0 + kk) * N + n0 + (lane & 31)]; }
    asm volatile("s_waitcnt lgkmcnt(0)" ::: "memory");
    const int c = lane & 7;
#pragma unroll
    for (int j = 0; j < 4; ++j) { const int n = (lane >> 3) + 8 * j; const LAS float* s = scr + (8 * c) * 33 + n;
        u32x4 o; o.x = pk2(s[0 * 33], s[1 * 33]); o.y = pk2(s[2 * 33], s[3 * 33]); o.z = pk2(s[4 * 33], s[5 * 33]); o.w = pk2(s[6 * 33], s[7 * 33]);
        *(u32x4*)(WT + (size_t)(drow0 + n) * K + k0 + 8 * c) = o; }
    asm volatile("s_waitcnt lgkmcnt(0)" ::: "memory");
}
DI int win_perm(int n) {
    if (n < 1024) return PC_Q + n;
    if (n < 1280) return PC_K + (n - 1024);
    if (n < 1536) return PC_V + (n - 1280);
    if (n < 2560) return PC_X + (n - 1536);
    if (n < 3584) return PC_Y + (n - 2560);
    if (n < 4608) return PC_P + (n - 3584);
    return n;
}

struct Params {
    const float* in[22]; float* out; unsigned char* ws; float inv_freq[8]; int lo, hi;
};
enum { I_X = 0, I_NMIXPRE, I_NMIXPOST, I_WIN, I_SINKS, I_WATT, I_CONVW, I_CONVB, I_WRGA, I_BRGA, I_WRGI, I_BRGI, I_LAM, I_WRNN, I_WPG, I_PSCALE, I_WPOOL, I_WOUT, I_NMLPPRE, I_NMLPPOST, I_WUP, I_WDN };

DI void prologue(const Params& p, LAS unsigned char* lds, int l_lo, int l_hi, bool do_rope, int gw, int NGW, int wave, int lane) {
    LAS float* scr = (LAS float*)(lds + wave * 16384);
    bf16_t* Wall = (bf16_t*)(p.ws + WS_W);
    constexpr int IT_IN = 16 * 240, IT_SQ = 512, IT_PG = 128, IT_UP = 2048, IT_DN = 2048, IT_RG = 32;
    constexpr int IT_LAYER = IT_IN + 4 * IT_SQ + IT_PG + IT_UP + IT_DN + 2 * IT_RG;
    for (int it = l_lo * IT_LAYER + gw; it < IT_LAYER * l_hi; it += NGW) {
        const int l = it / IT_LAYER; int r = it - l * IT_LAYER; bf16_t* Wl = Wall + (size_t)l * WO_LAYER;
        if (r < IT_IN) { const int kb = r / 240, nb = r % 240; transpose_item(p.in[I_WIN] + (size_t)l * D * DIN, D, DIN, Wl + WO_IN, win_perm(nb * 32), scr, kb * 64, nb * 32, lane); continue; } r -= IT_IN;
        if (r < 4 * IT_SQ) { const int which = r / IT_SQ; r -= which * IT_SQ; const int kb = r / 32, nb = r % 32;
            const float* src = (which == 0 ? p.in[I_WATT] : which == 1 ? p.in[I_WRNN] : which == 2 ? p.in[I_WPOOL] : p.in[I_WOUT]) + (size_t)l * D * D;
            bf16_t* dst = which < 3 ? Wl + WO_BR + (size_t)which * D * D : Wl + WO_OUT;
            transpose_item(src, D, D, dst, nb * 32, scr, kb * 64, nb * 32, lane); continue; } r -= 4 * IT_SQ;
        if (r < IT_PG) { const int gq = r / 32; r -= gq * 32; const int kb = r / 8, nb = r % 8;
            transpose_item(p.in[I_WPG] + ((size_t)l * 4 + gq) * 65536, 256, 256, Wl + WO_PG, gq * 256 + nb * 32, scr, kb * 64, nb * 32, lane); continue; } r -= IT_PG;
        if (r < IT_UP) { const int kb = r / 128, nb = r % 128; transpose_item(p.in[I_WUP] + (size_t)l * D * DFF, D, DFF, Wl + WO_UP, nb * 32, scr, kb * 64, nb * 32, lane); continue; } r -= IT_UP;
        if (r < IT_DN) { const int kb = r / 32, nb = r % 32; transpose_item(p.in[I_WDN] + (size_t)l * DFF * D, DFF, D, Wl + WO_DN, nb * 32, scr, kb * 64, nb * 32, lane); continue; } r -= IT_DN;
        { const int which = r / IT_RG; r -= which * IT_RG; const int hb = r / 2, nb = r % 2;
          transpose_item((which ? p.in[I_WRGI] : p.in[I_WRGA]) + ((size_t)l * 16 + hb) * 4096, 64, 64, Wl + (which ? WO_RI : WO_RA), hb * 64 + nb * 32, scr, 0, nb * 32, lane); }
    }
    float* rope = (float*)(p.ws + WS_ROPE);
    if (do_rope) for (int i = gw * 64 + lane; i < SEQ * 8; i += NGW * 64) {
        const int pos = i >> 3, j = i & 7;
        const float ang = (float)pos * p.inv_freq[j];
        const double a = (double)ang * 0.15915494309189535; const double n = __builtin_rint(a); const float fr = (float)(a - n);
        rope[pos * 16 + j] = __builtin_amdgcn_cosf(fr); rope[pos * 16 + 8 + j] = __builtin_amdgcn_sinf(fr);
    }
}

DI void rowpass(const float* hsrc, const bf16_t* mix, const float* gpost, const float* gnext, float* hdst, bf16_t* hb, int gw, int NGW, int lane) {
    for (int m0 = gw * 2; m0 < MC; m0 += NGW * 2) {
        f32x4 hv[2][4], mv[2][4];
#pragma unroll
        for (int r = 0; r < 2; ++r)
#pragma unroll
            for (int j = 0; j < 4; ++j) hv[r][j] = __builtin_nontemporal_load((const f32x4*)(hsrc + (size_t)(m0 + r) * D + 256 * j + 4 * lane));
        if (mix) {
#pragma unroll
            for (int r = 0; r < 2; ++r)
#pragma unroll
                for (int j = 0; j < 4; ++j) { const u32x2 w = __builtin_nontemporal_load((const u32x2*)(mix + (size_t)(m0 + r) * D + 256 * j + 4 * lane)); mv[r][j] = (f32x4){bflo(w.x), bfhi(w.x), bflo(w.y), bfhi(w.y)}; }
            float ss[2] = {0.f, 0.f};
#pragma unroll
            for (int r = 0; r < 2; ++r)
#pragma unroll
                for (int j = 0; j < 4; ++j) ss[r] += (mv[r][j].x * mv[r][j].x + mv[r][j].y * mv[r][j].y) + (mv[r][j].z * mv[r][j].z + mv[r][j].w * mv[r][j].w);
#pragma unroll
            for (int o = 1; o < 64; o <<= 1) { ss[0] += __shfl_xor(ss[0], o); ss[1] += __shfl_xor(ss[1], o); }
#pragma unroll
            for (int r = 0; r < 2; ++r) { const float rs = __builtin_amdgcn_rsqf(ss[r] * (1.0f / D) + EPS);
#pragma unroll
                for (int j = 0; j < 4; ++j) { const f32x4 gp = *(const f32x4*)(gpost + 256 * j + 4 * lane); hv[r][j] += mv[r][j] * rs * gp; *(f32x4*)(hdst + (size_t)(m0 + r) * D + 256 * j + 4 * lane) = hv[r][j]; } }
        }
        if (gnext) {
            float ss[2] = {0.f, 0.f};
#pragma unroll
            for (int r = 0; r < 2; ++r)
#pragma unroll
                for (int j = 0; j < 4; ++j) ss[r] += (hv[r][j].x * hv[r][j].x + hv[r][j].y * hv[r][j].y) + (hv[r][j].z * hv[r][j].z + hv[r][j].w * hv[r][j].w);
#pragma unroll
            for (int o = 1; o < 64; o <<= 1) { ss[0] += __shfl_xor(ss[0], o); ss[1] += __shfl_xor(ss[1], o); }
#pragma unroll
            for (int r = 0; r < 2; ++r) { const float rs = __builtin_amdgcn_rsqf(ss[r] * (1.0f / D) + EPS);
#pragma unroll
                for (int j = 0; j < 4; ++j) { const f32x4 gn = *(const f32x4*)(gnext + 256 * j + 4 * lane); const f32x4 o = hv[r][j] * rs * gn;
                    u32x2 w; w.x = pk2(o.x, o.y); w.y = pk2(o.z, o.w); *(u32x2*)(hb + (size_t)(m0 + r) * D + 256 * j + 4 * lane) = w; } }
        }
    }
}

DI void rope8(u32x4& v, const u32x4& pr, const float* tab, bool second) {
    const f32x4 c0 = *(const f32x4*)tab, c1 = *(const f32x4*)(tab + 4), s0 = *(const f32x4*)(tab + 8), s1 = *(const f32x4*)(tab + 12);
    const float sg = second ? 1.f : -1.f;
    float x[8] = {bflo(v.x), bfhi(v.x), bflo(v.y), bfhi(v.y), bflo(v.z), bfhi(v.z), bflo(v.w), bfhi(v.w)};
    const float y[8] = {bflo(pr.x), bfhi(pr.x), bflo(pr.y), bfhi(pr.y), bflo(pr.z), bfhi(pr.z), bflo(pr.w), bfhi(pr.w)};
    const float cs[8] = {c0.x, c0.y, c0.z, c0.w, c1.x, c1.y, c1.z, c1.w}, sn[8] = {s0.x, s0.y, s0.z, s0.w, s1.x, s1.y, s1.z, s1.w};
#pragma unroll
    for (int j = 0; j < 8; ++j) x[j] = x[j] * cs[j] + sg * y[j] * sn[j];
    v.x = pk2(x[0], x[1]); v.y = pk2(x[2], x[3]); v.z = pk2(x[4], x[5]); v.w = pk2(x[6], x[7]);
}
constexpr int KS_LD = 72, VT_LD = 260, ATT_VT_OFF = 256 * KS_LD * 2;
DI void attn_unit(LAS unsigned char* lds, bf16_t* P, const float* rope, const float* sinks, int unit, int tid, int wid, int lane) {
    const int kvh = unit & 3, n = (unit >> 2) & 63, b = unit >> 8;
    const long rowblk = (long)b * SEQ + n * 128;
    LAS bf16_t* Ks = (LAS bf16_t*)lds; LAS bf16_t* Vt = (LAS bf16_t*)(lds + ATT_VT_OFF);
#pragma unroll
    for (int i = 0; i < 4; ++i) {
        const int pc = tid + 512 * i, key = pc >> 3, dg = pc & 7;
        const bool valid = (n > 0) || key >= 128;
        u32x4 kv = {0u, 0u, 0u, 0u}, vv = {0u, 0u, 0u, 0u};
        if (valid) { const bf16_t* src = P + (size_t)(rowblk - 128 + key) * DIN + kvh * 64 + dg * 8; kv = *(const u32x4*)(src + PC_K); vv = *(const u32x4*)(src + PC_V); }
        u32x4 pr; pr.x = __shfl_xor(kv.x, 1); pr.y = __shfl_xor(kv.y, 1); pr.z = __shfl_xor(kv.z, 1); pr.w = __shfl_xor(kv.w, 1);
        if (dg < 2) { const int pos = valid ? (n * 128 - 128 + key) : 0; rope8(kv, pr, rope + pos * 16, dg == 1); }
        *(LAS u32x4*)(Ks + key * KS_LD + dg * 8) = kv;
        const unsigned vw[4] = {vv.x, vv.y, vv.z, vv.w};
#pragma unroll
        for (int j = 0; j < 4; ++j) { Vt[(dg * 8 + 2 * j) * VT_LD + key] = (bf16_t)(vw[j] & 0xffffu); Vt[(dg * 8 + 2 * j + 1) * VT_LD + key] = (bf16_t)(vw[j] >> 16); }
    }
    __syncthreads();
    const int g = wid >> 1, head = kvh * 4 + g, q = lane & 31, hl = lane >> 5;
    const float sinkv = sinks[head] * LOG2E;
    const float cscale = 0.125f * LOG2E;
#pragma unroll 1
    for (int sb = 0; sb < 2; ++sb) {
        const int r0 = 64 * (wid & 1) + 32 * sb;
        bf16_t* qrow = P + (size_t)(rowblk + r0 + q) * DIN + PC_Q + head * 64;
        u32x4 qf[4];
#pragma unroll
        for (int s = 0; s < 4; ++s) qf[s] = *(const u32x4*)(qrow + 16 * s + 8 * hl);
        { u32x4 pr; pr.x = __shfl_xor(qf[0].x, 32); pr.y = __shfl_xor(qf[0].y, 32); pr.z = __shfl_xor(qf[0].z, 32); pr.w = __shfl_xor(qf[0].w, 32);
          rope8(qf[0], pr, rope + (n * 128 + r0 + q) * 16, hl == 1); }
        f32x16 S[5];
#pragma unroll
        for (int kt = 0; kt < 5; ++kt) {
#pragma unroll
            for (int i = 0; i < 16; ++i) S[kt][i] = 0.f;
#pragma unroll
            for (int s = 0; s < 4; ++s) { const bf16x8 kf = *(const LAS bf16x8*)(Ks + (r0 + 32 * kt + q) * KS_LD + 16 * s + 8 * hl);
                S[kt] = MFMA32(kf, __builtin_bit_cast(bf16x8, qf[s]), S[kt]); }
        }
#pragma unroll
        for (int i = 0; i < 16; ++i) { const int kl = 8 * (i >> 2) + 4 * hl + (i & 3);
            if (kl <= q) S[0][i] = -1e30f;
            if (kl > q) S[4][i] = -1e30f; }
        if (n == 0) {
#pragma unroll
            for (int kt = 0; kt < 4; ++kt) if (r0 + 32 * kt < 128) {
#pragma unroll
                for (int i = 0; i < 16; ++i) S[kt][i] = -1e30f; }
        }
        float mx = -1e30f;
#pragma unroll
        for (int kt = 0; kt < 5; ++kt)
#pragma unroll
            for (int i = 0; i < 16; ++i) mx = fmaxf(mx, S[kt][i]);
        mx = fmaxf(mx, __shfl_xor(mx, 32));
        const float M2 = fmaxf(mx * cscale, sinkv);
        float l = 0.f;
#pragma unroll
        for (int kt = 0; kt < 5; ++kt)
#pragma unroll
            for (int i = 0; i < 16; ++i) { const float pv = __builtin_amdgcn_exp2f(S[kt][i] * cscale - M2); l += pv; S[kt][i] = pv; }
        l += __shfl_xor(l, 32);
        l += __builtin_amdgcn_exp2f(sinkv - M2);
        const float inv = __builtin_amdgcn_rcpf(l);
        f32x16 O[2];
#pragma unroll
        for (int i = 0; i < 16; ++i) { O[0][i] = 0.f; O[1][i] = 0.f; }
#pragma unroll
        for (int kt = 0; kt < 5; ++kt)
#pragma unroll
            for (int s2 = 0; s2 < 2; ++s2) {
                u32x4 pw; pw.x = pk2(S[kt][8 * s2 + 0], S[kt][8 * s2 + 1]); pw.y = pk2(S[kt][8 * s2 + 2], S[kt][8 * s2 + 3]); pw.z = pk2(S[kt][8 * s2 + 4], S[kt][8 * s2 + 5]); pw.w = pk2(S[kt][8 * s2 + 6], S[kt][8 * s2 + 7]);
                const bf16x8 pf = __builtin_bit_cast(bf16x8, pw);
#pragma unroll
                for (int dt = 0; dt < 2; ++dt) {
                    const LAS bf16_t* vp = Vt + (32 * dt + q) * VT_LD + r0 + 32 * kt + 16 * s2 + 4 * hl;
                    const u32x2 v0 = *(const LAS u32x2*)vp, v1 = *(const LAS u32x2*)(vp + 8);
                    u32x4 vw; vw.x = v0.x; vw.y = v0.y; vw.z = v1.x; vw.w = v1.y;
                    O[dt] = MFMA32(__builtin_bit_cast(bf16x8, vw), pf, O[dt]);
                }
            }
        bf16_t* orow = qrow;
#pragma unroll
        for (int dt = 0; dt < 2; ++dt)
#pragma unroll
            for (int a = 0; a < 4; ++a) { u32x2 w; w.x = pk2(O[dt][4 * a] * inv, O[dt][4 * a + 1] * inv); w.y = pk2(O[dt][4 * a + 2] * inv, O[dt][4 * a + 3] * inv);
                *(u32x2*)(orow + 32 * dt + 8 * a + 4 * hl) = w; }
    }
    __syncthreads();
}

constexpr int NCH = SEQ / 128;
DI void rnn_phase(LAS unsigned char* lds, bf16_t* P, const bf16_t* WaT, const bf16_t* WiT, const float* convw, const float* convb, const float* ba, const float* bi, const float* lam,
                  f32x2* sums, unsigned* au, bool fin, int bx, int G, int tid, int wid, int lane) {
    constexpr int NU = BPC * NCH * 16;
    typedef _Float16 h2_t __attribute__((ext_vector_type(2)));
    LAS float* XC = (LAS float*)lds; LAS float* AA = (LAS float*)(lds + 32768); LAS bf16_t* XB = (LAS bf16_t*)(lds + 65536); LAS bf16_t* WL = (LAS bf16_t*)(lds + 83968);
    LAS float* SG = (LAS float*)(lds + 102400); LAS float* PF = (LAS float*)(lds + 106496); LAS float* CW = (LAS float*)(lds + 110592);
    const int t = tid >> 2, cq = tid & 3;
    const int tt = wid >> 1, nt = wid & 1, l32 = lane & 31, hl = lane >> 5;
    int cur_hbk = -1; float bac = 0.f, bic = 0.f, k8c = 0.f;
    u32x4 xr[4][2];
#define RNN_LOAD_XR(uu) do { const int hb_ = (uu) & 15, c_ = ((uu) >> 4) & 63, b_ = (uu) >> 10; const size_t rb_ = (size_t)b_ * SEQ + c_ * 128; \
        _Pragma("unroll") for (int tap = 0; tap < 4; ++tap) { const int tp_ = c_ * 128 + t + tap - 3; \
            if (tp_ >= 0) { const bf16_t* src_ = P + (rb_ + t + tap - 3) * DIN + PC_X + hb_ * 64 + 16 * cq; xr[tap][0] = *(const u32x4*)src_; xr[tap][1] = *(const u32x4*)(src_ + 8); } \
            else { xr[tap][0] = (u32x4){0u, 0u, 0u, 0u}; xr[tap][1] = (u32x4){0u, 0u, 0u, 0u}; } } } while (0)
    if (fin) {
        for (int u2 = bx; u2 < NU; u2 += G) {
            const int hbk = u2 & 15, c = (u2 >> 4) & 63, b = u2 >> 10;
            const size_t rowbase = (size_t)b * SEQ + c * 128; const int ch0 = hbk * 64, ch = lane, seg = wid;
            const unsigned* aup = au + (rowbase + 16 * seg) * D + ch0 + ch;
            bf16_t* yp = P + (rowbase + 16 * seg) * DIN + PC_Y + ch0 + ch;
            unsigned w[16]; unsigned short yv[16];
#pragma unroll
            for (int j = 0; j < 16; ++j) { w[j] = aup[(size_t)j * D]; yv[j] = yp[(size_t)j * DIN]; }
            float Ap = 1.f, Hp = 0.f;
#pragma unroll
            for (int k = 0; k < 8; ++k) { const int j = 8 * wid + k; if (j < c) { const f32x2 sv = sums[((size_t)b * NCH + j) * D + ch0 + lane]; Hp = sv.x * Hp + sv.y; Ap *= sv.x; } }
            float av[16], uv[16]; float A = 1.f, H = 0.f;
#pragma unroll
            for (int j = 0; j < 16; ++j) { const h2_t v = __builtin_bit_cast(h2_t, w[j]); av[j] = 1.0f - (float)v.x; uv[j] = (float)v.y; H = av[j] * H + uv[j]; A *= av[j]; }
            SG[seg * 64 + ch] = A; SG[512 + seg * 64 + ch] = H; PF[wid * 64 + lane] = Ap; PF[512 + wid * 64 + lane] = Hp;
            __syncthreads();
            float h = 0.f;
#pragma unroll
            for (int q8 = 0; q8 < 8; ++q8) h = PF[q8 * 64 + ch] * h + PF[512 + q8 * 64 + ch];
            for (int s2 = 0; s2 < seg; ++s2) h = SG[s2 * 64 + ch] * h + SG[512 + s2 * 64 + ch];
#pragma unroll
            for (int j = 0; j < 16; ++j) { h = av[j] * h + uv[j]; const float o = h * gelu_tanh(bf1(yv[j])); yp[(size_t)j * DIN] = (bf16_t)(pk2(o, 0.f) & 0xffffu); }
            __syncthreads();
        }
        return;
    }
    int u = bx; if (u >= NU) return;
    RNN_LOAD_XR(u);
    for (; u < NU; u += G) {
        const int hbk = u & 15, c = (u >> 4) & 63, b = u >> 10;
        const size_t rowbase = (size_t)b * SEQ + c * 128; const int ch0 = hbk * 64;
        if (hbk != cur_hbk) {
            const int nn = tid >> 3, k8 = tid & 7;
            *(LAS u32x4*)(WL + nn * 72 + 8 * k8) = *(const u32x4*)(WaT + (size_t)hbk * 4096 + nn * 64 + 8 * k8);
            *(LAS u32x4*)(WL + 64 * 72 + nn * 72 + 8 * k8) = *(const u32x4*)(WiT + (size_t)hbk * 4096 + nn * 64 + 8 * k8);
            if (tid < 320) CW[tid] = tid < 256 ? convw[(tid >> 6) * D + ch0 + (tid & 63)] : convb[ch0 + tid - 256];
            const int chg = ch0 + 32 * nt + l32;
            bac = ba[chg]; bic = bi[chg]; k8c = -8.0f * LOG2E * log1pf(expf(-lam[chg]));
            cur_hbk = hbk;
            __syncthreads();
        }
        unsigned short yv[16]; float Ap = 1.f, Hp = 0.f;
        bf16_t* yp = P + (rowbase + 16 * wid) * DIN + PC_Y + ch0 + lane;
        if (fin) {
#pragma unroll
            for (int j = 0; j < 16; ++j) yv[j] = yp[(size_t)j * DIN];
#pragma unroll
            for (int k = 0; k < 8; ++k) { const int j = 8 * wid + k; if (j < c) { const f32x2 sv = sums[((size_t)b * NCH + j) * D + ch0 + lane]; Hp = sv.x * Hp + sv.y; Ap *= sv.x; } }
        }
        {
            f32x4 acc[4];
#pragma unroll
            for (int j = 0; j < 4; ++j) acc[j] = *(const LAS f32x4*)(CW + 256 + 16 * cq + 4 * j);
#pragma unroll
            for (int tap = 0; tap < 4; ++tap) {
                const u32x4 x0 = xr[tap][0], x1 = xr[tap][1];
                const LAS float* wp = CW + tap * 64 + 16 * cq;
                const f32x4 w0 = *(const LAS f32x4*)wp, w1 = *(const LAS f32x4*)(wp + 4), w2 = *(const LAS f32x4*)(wp + 8), w3 = *(const LAS f32x4*)(wp + 12);
                acc[0] += (f32x4){bflo(x0.x), bfhi(x0.x), bflo(x0.y), bfhi(x0.y)} * w0; acc[1] += (f32x4){bflo(x0.z), bfhi(x0.z), bflo(x0.w), bfhi(x0.w)} * w1;
                acc[2] += (f32x4){bflo(x1.x), bfhi(x1.x), bflo(x1.y), bfhi(x1.y)} * w2; acc[3] += (f32x4){bflo(x1.z), bfhi(x1.z), bflo(x1.w), bfhi(x1.w)} * w3;
            }
#pragma unroll
            for (int j = 0; j < 4; ++j) *(LAS f32x4*)(XC + t * 64 + 16 * cq + 4 * j) = acc[j];
            u32x4 o0, o1; o0.x = pk2(acc[0].x, acc[0].y); o0.y = pk2(acc[0].z, acc[0].w); o0.z = pk2(acc[1].x, acc[1].y); o0.w = pk2(acc[1].z, acc[1].w);
            o1.x = pk2(acc[2].x, acc[2].y); o1.y = pk2(acc[2].z, acc[2].w); o1.z = pk2(acc[3].x, acc[3].y); o1.w = pk2(acc[3].z, acc[3].w);
            *(LAS u32x4*)(XB + t * 72 + 16 * cq) = o0; *(LAS u32x4*)(XB + t * 72 + 16 * cq + 8) = o1;
        }
        if (u + G < NU) RNN_LOAD_XR(u + G);
        if (fin) { PF[wid * 64 + lane] = Ap; PF[512 + wid * 64 + lane] = Hp; }
        __syncthreads();
        {
            f32x16 aR, aI;
#pragma unroll
            for (int i = 0; i < 16; ++i) { aR[i] = 0.f; aI[i] = 0.f; }
#pragma unroll
            for (int s = 0; s < 4; ++s) {
                const bf16x8 af = *(const LAS bf16x8*)(XB + (32 * tt + l32) * 72 + 16 * s + 8 * hl);
                const bf16x8 bR = *(const LAS bf16x8*)(WL + (32 * nt + l32) * 72 + 16 * s + 8 * hl);
                const bf16x8 bI = *(const LAS bf16x8*)(WL + 64 * 72 + (32 * nt + l32) * 72 + 16 * s + 8 * hl);
                aR = MFMA32(af, bR, aR); aI = MFMA32(af, bI, aI);
            }
            const int ch = 32 * nt + l32;
            float At = 1.f, Ht = 0.f;
#pragma unroll
            for (int g = 0; g < 4; ++g) {
                float A = 1.f, H = 0.f;
#pragma unroll
                for (int q4 = 0; q4 < 4; ++q4) { const int i = 4 * g + q4, tok = 32 * tt + 8 * g + 4 * hl + q4;
                    const float r = sigm(aR[i] + bac), ig = sigm(aI[i] + bic);
                    const float a = __builtin_amdgcn_exp2f(k8c * r);
                    const float uu_ = __builtin_amdgcn_sqrtf(fmaxf(1.0f - a * a, 0.f)) * ig * XC[tok * 64 + ch];
                    { const h2_t pv = {(_Float16)(1.0f - a), (_Float16)uu_}; au[(rowbase + tok) * D + ch0 + ch] = __builtin_bit_cast(unsigned, pv); }
                    H = a * H + uu_; A *= a; }
                const float pA = __shfl_xor(A, 32), pH = __shfl_xor(H, 32);
                const float fA = hl ? pA : A, fH = hl ? pH : H, sA = hl ? A : pA, sH = hl ? H : pH;
                Ht = fA * Ht + fH; At *= fA; Ht = sA * Ht + sH; At *= sA;
            }
            if (hl == 0) { SG[tt * 64 + ch] = At; SG[256 + tt * 64 + ch] = Ht; }
            __syncthreads();
            if (tt == 3 && hl == 0) { float Ac = 1.f, Hc = 0.f;
#pragma unroll
                for (int s = 0; s < 4; ++s) { const float sa = SG[s * 64 + ch]; Hc = sa * Hc + SG[256 + s * 64 + ch]; Ac *= sa; }
                sums[((size_t)b * NCH + c) * D + ch0 + ch] = (f32x2){Ac, Hc}; }
        }
        __syncthreads();
    }
#undef RNN_LOAD_XR
}

DI void pool_item(const bf16_t* P, bf16_t* pooled, int idx) {
    const int cg8 = idx & 127, run = idx >> 7; const size_t row0 = (size_t)run * 8; const int t0 = (int)(row0 & (SEQ - 1));
    const int ch = cg8 * 8, w = 2 << (ch >> 8);
    const bf16_t* src = P + PC_P + ch;
    float sum[8];
#pragma unroll
    for (int j = 0; j < 8; ++j) sum[j] = 0.f;
    for (int k = 1; k < w; ++k) if (t0 - k >= 0) { const u32x4 x = *(const u32x4*)(src + (row0 - k) * DIN);
        sum[0] += bflo(x.x); sum[1] += bfhi(x.x); sum[2] += bflo(x.y); sum[3] += bfhi(x.y); sum[4] += bflo(x.z); sum[5] += bfhi(x.z); sum[6] += bflo(x.w); sum[7] += bfhi(x.w); }
#pragma unroll
    for (int j = 0; j < 8; ++j) {
        const int t = t0 + j; const u32x4 x = *(const u32x4*)(src + (row0 + j) * DIN);
        const float cur[8] = {bflo(x.x), bfhi(x.x), bflo(x.y), bfhi(x.y), bflo(x.z), bfhi(x.z), bflo(x.w), bfhi(x.w)};
#pragma unroll
        for (int e = 0; e < 8; ++e) sum[e] += cur[e];
        const float ic = __builtin_amdgcn_rcpf((float)(t + 1 < w ? t + 1 : w));
        u32x4 o; o.x = pk2(sum[0] * ic - cur[0], sum[1] * ic - cur[1]); o.y = pk2(sum[2] * ic - cur[2], sum[3] * ic - cur[3]);
        o.z = pk2(sum[4] * ic - cur[4], sum[5] * ic - cur[5]); o.w = pk2(sum[6] * ic - cur[6], sum[7] * ic - cur[7]);
        *(u32x4*)(pooled + (row0 + j) * D + ch) = o;
        if (t - w + 1 >= 0) { const u32x4 y = *(const u32x4*)(src + (row0 + j - w + 1) * DIN);
            sum[0] -= bflo(y.x); sum[1] -= bfhi(y.x); sum[2] -= bflo(y.y); sum[3] -= bfhi(y.y); sum[4] -= bflo(y.z); sum[5] -= bfhi(y.z); sum[6] -= bflo(y.w); sum[7] -= bfhi(y.w); }
    }
}


#define XB_TMO      128
#define XB_XCNT(j)  (256  + 64 * (j))
#define XB_XSUB(j)  (1280 + 64 * (j))
#define XB_XGEN(j)  (2304 + 64 * (j))
#define XB_TOP      3328
#define XB_TOPGEN   3392
#define XCD_BAR_WORDS 3456
#define XB_SPIN_CAP (1u << 22)
DI unsigned xb_ld(unsigned* p)              { return __hip_atomic_load(p, __ATOMIC_RELAXED, __HIP_MEMORY_SCOPE_AGENT); }
DI unsigned xb_add(unsigned* p, unsigned v) { return __hip_atomic_fetch_add(p, v, __ATOMIC_RELAXED, __HIP_MEMORY_SCOPE_AGENT); }
DI unsigned xb_xcc_id() { return (unsigned)__builtin_amdgcn_s_getreg((3 << 11) | 20) & 0xFu; }
#define XB_SPIN(cond, bar) do { unsigned _sp = 0; while (cond) { __builtin_amdgcn_s_sleep(1); \
    if ((++_sp & 255u) == 0u) { if (xb_ld(&(bar)[XB_TMO])) break; if (_sp > XB_SPIN_CAP) { atomicAdd(&(bar)[XB_TMO], 1u); break; } } } } while (0)
struct XcdBarrier { unsigned* bar; unsigned x; volatile LAS unsigned* st; unsigned n; };
DI XcdBarrier xcd_barrier_post(unsigned* bar, volatile LAS unsigned* st, unsigned n) {
    XcdBarrier b; b.bar = bar; b.x = xb_xcc_id(); b.st = st; b.n = n;
    if (threadIdx.x == 0) (void)xb_add(&bar[XB_XCNT(b.x)], 1u);
    return b;
}
DI void xcd_barrier_complete(unsigned* bar, unsigned x, unsigned G, unsigned& nloc, unsigned& nx) {
    unsigned sum, cnt, mine, sp = 0u;
    for (;;) {
        sum = 0u; cnt = 0u; mine = 0u;
#pragma unroll
        for (unsigned j = 0; j < 16; ++j) { const unsigned c = xb_ld(&bar[XB_XCNT(j)]); sum += c; cnt += (c > 0u) ? 1u : 0u; mine = (j == x) ? c : mine; }
        if (sum == G) break;
        __builtin_amdgcn_s_sleep(1);
        if ((++sp & 255u) == 0u) { if (xb_ld(&bar[XB_TMO])) break; if (sp > XB_SPIN_CAP) { atomicAdd(&bar[XB_TMO], 1u); break; } }
    }
    nloc = mine > 0u ? mine : 1u; nx = cnt > 0u ? cnt : 1u;
}
DI void xcd_barrier(const XcdBarrier& b) {
    asm volatile("s_waitcnt vmcnt(0)" ::: "memory");
    __syncthreads();
    if (threadIdx.x == 0) {
        unsigned* bar = b.bar;
        __builtin_amdgcn_s_waitcnt(0);
        unsigned nloc = b.st[0], nx = b.st[1];
        if (nloc == 0u) { xcd_barrier_complete(bar, b.x, b.n, nloc, nx); b.st[0] = nloc; b.st[1] = nx; }
        const unsigned old = xb_add(&bar[XB_XSUB(b.x)], 1u);
        const unsigned gen = old / nloc;
        if (old + 1u == (gen + 1u) * nloc) {
            __builtin_amdgcn_fence(__ATOMIC_RELEASE, "agent");
            asm volatile("s_waitcnt vmcnt(0)" ::: "memory");
            const unsigned og = xb_add(&bar[XB_TOP], 1u);
            const unsigned tg = og / nx;
            if (og + 1u == (tg + 1u) * nx) xb_add(&bar[XB_TOPGEN], 1u);
            else XB_SPIN(xb_ld(&bar[XB_TOPGEN]) == tg, bar);
            __builtin_amdgcn_fence(__ATOMIC_ACQUIRE, "agent");
            xb_add(&bar[XB_XGEN(b.x)], 1u);
            asm volatile("s_waitcnt vmcnt(0)" ::: "memory");
        } else {
            XB_SPIN(xb_ld(&bar[XB_XGEN(b.x)]) == gen, bar);
            __builtin_amdgcn_fence(__ATOMIC_ACQUIRE, "agent");
            asm volatile("s_waitcnt vmcnt(0)" ::: "memory");
        }
    }
    __syncthreads();
}

__global__ void __launch_bounds__(512, 2) mega_fwd(Params p) {
    extern __shared__ __attribute__((aligned(16))) unsigned char lds_raw[];
    LAS unsigned char* lds = (LAS unsigned char*)lds_raw;
    cg::grid_group grid = cg::this_grid();
    const int Gfull = gridDim.x, bfull = blockIdx.x;
    const int half = (bfull & 7) >> 2, bx = (bfull >> 3) * 4 + (bfull & 3), G = Gfull >> 1, NGW = G * 8;
#define TID_LOCAL() int tid_ = threadIdx.x; asm volatile("" : "+v"(tid_)); const int tid = tid_, lane = tid & 63, wid = __builtin_amdgcn_readfirstlane(tid >> 6), gw = bx * 8 + wid; (void)lane; (void)gw; (void)tid
    volatile LAS unsigned* xst = (volatile LAS unsigned*)(lds + 131072 + 512);
    if (threadIdx.x < 2) xst[threadIdx.x] = 0u;
    __syncthreads();
    unsigned* ctl = (unsigned*)(p.ws + WS_CTL);
    XcdBarrier xbar = xcd_barrier_post(ctl + half * 4096, xst, (unsigned)G);
    unsigned* wflag = ctl + 8192 + 64;
    { TID_LOCAL(); const int gwf = bfull * 8 + wid; prologue(p, lds, 0, 1, true, gwf, Gfull * 8, wid, lane); }
    grid.sync();
    if (half == 1) {
        TID_LOCAL(); prologue(p, lds, 1, DEPTH, false, gw, NGW, wid, lane);
        asm volatile("s_waitcnt vmcnt(0)" ::: "memory"); __syncthreads();
        if (tid == 0) { __builtin_amdgcn_fence(__ATOMIC_RELEASE, "agent"); asm volatile("s_waitcnt vmcnt(0)" ::: "memory"); __hip_atomic_fetch_add(wflag, 1u, __ATOMIC_RELAXED, __HIP_MEMORY_SCOPE_AGENT); }
    }
    bool first = true, wready = (half == 1);
#define STEP_SYNC() do { if (!first) xcd_barrier(xbar); first = false; } while (0)
    for (int cj = 0; cj < NCHUNK / 2; ++cj) {
        const int ck = half * (NCHUNK / 2) + cj;
        { STEP_SYNC(); TID_LOCAL(); int ckx = ck; unsigned char* ws = p.ws + (size_t)half * HALF_STRIDE; asm volatile("" : "+s"(ckx), "+s"(ws));
            rowpass(p.in[I_X] + (size_t)ckx * MC * D, nullptr, nullptr, p.in[I_NMIXPRE], p.out + (size_t)ckx * MC * D, (bf16_t*)(ws + WS_HB), gw, NGW, lane); }
        for (int l = 0; l < DEPTH; ++l) {
            if (!wready && l >= 1) {
                if (threadIdx.x == 0) { unsigned sp = 0; while (__hip_atomic_load(wflag, __ATOMIC_RELAXED, __HIP_MEMORY_SCOPE_AGENT) < (unsigned)G) { __builtin_amdgcn_s_sleep(2); if (++sp > (1u << 24)) break; }
                    __builtin_amdgcn_fence(__ATOMIC_ACQUIRE, "agent"); asm volatile("s_waitcnt vmcnt(0)" ::: "memory"); }
                __syncthreads(); wready = true;
            }
            for (int ph = 0; ph < 9; ++ph) {
                STEP_SYNC();
                if (ph == 1) {
                    TID_LOCAL(); int lx = l; unsigned char* ws = p.ws + (size_t)half * HALF_STRIDE; unsigned char* wg = p.ws; asm volatile("" : "+s"(lx), "+s"(ws), "+s"(wg));
                    bf16_t* proj = (bf16_t*)(ws + WS_PROJ);
                    for (int u = bx; u < BPC * 64 * 4; u += G) attn_unit(lds, proj, (const float*)(wg + WS_ROPE), p.in[I_SINKS] + lx * 16, u, tid, wid, lane);
                    for (int idx = bx * 512 + tid; idx < (MC / 8) * 128; idx += G * 512) pool_item(proj, (bf16_t*)(ws + WS_POOLED), idx);
                }
                if (ph == 1 || ph == 2) {
                    TID_LOCAL(); int lx = l; unsigned char* ws = p.ws + (size_t)half * HALF_STRIDE; unsigned char* wg = p.ws; asm volatile("" : "+s"(lx), "+s"(ws), "+s"(wg));
                    const bf16_t* Wl = (const bf16_t*)(wg + WS_W) + (size_t)lx * WO_LAYER;
                    rnn_phase(lds, (bf16_t*)(ws + WS_PROJ), Wl + WO_RA, Wl + WO_RI, p.in[I_CONVW] + (size_t)lx * 4 * D, p.in[I_CONVB] + lx * D, p.in[I_BRGA] + lx * D, p.in[I_BRGI] + lx * D, p.in[I_LAM] + lx * D,
                              (f32x2*)(ws + WS_SUMS), (unsigned*)(wg + WS_AU + (size_t)half * 64 * MiB), ph == 2, bx, G, tid, wid, lane);
                }
                if (ph == 5 || ph == 8) {
                    TID_LOCAL(); int lx = l, ckx = ck; unsigned char* ws = p.ws + (size_t)half * HALF_STRIDE; asm volatile("" : "+s"(lx), "+s"(ckx), "+s"(ws));
                    const float* gpost = (ph == 5 ? p.in[I_NMIXPOST] : p.in[I_NMLPPOST]) + lx * D;
                    const float* gnext = ph == 5 ? p.in[I_NMLPPRE] + lx * D : (lx + 1 < DEPTH ? p.in[I_NMIXPRE] + (lx + 1) * D : nullptr);
                    float* hck = p.out + (size_t)ckx * MC * D;
                    rowpass(lx == 0 && ph == 5 ? p.in[I_X] + (size_t)ckx * MC * D : hck, (const bf16_t*)(ws + WS_PROJ + PROJ_MIX_OFF), gpost, gnext, hck, (bf16_t*)(ws + WS_HB), gw, NGW, lane);
                }
                if (ph == 0 || ph == 2 || ph == 3 || ph == 4 || ph == 6 || ph == 7) {
                    int lx = l; unsigned char* ws = p.ws + (size_t)half * HALF_STRIDE; unsigned char* wg = p.ws; asm volatile("" : "+s"(lx), "+s"(ws), "+s"(wg));
                    pg8::gemm_phase(lds, ph, ws, wg, lx, p.in[I_PSCALE] + lx * D, G, bx, (Gfull & 7) == 0 ? 4 : 1);
                }
            }
        }
    }
}

#ifndef MK_MULTI
#define MK_MULTI 0
#endif
extern "C" void kernel_launch(void* const* d_in, const int* in_sizes, int n_in, void* d_out, int out_size, void* d_ws, size_t ws_size, hipStream_t stream) {
    static int grid = 0;
    if (grid == 0) {
        if (n_in != 22 || ws_size < WS_END) { fprintf(stderr, "kernel_launch: unexpected n_in %d / ws_size %zu (need %zu)\n", n_in, ws_size, (size_t)WS_END); grid = -1; return; }
        int dev = 0, cus = 0, per_cu = 0;
        hipGetDevice(&dev); hipDeviceGetAttribute(&cus, hipDeviceAttributeMultiprocessorCount, dev);
        if (hipFuncSetAttribute((const void*)mega_fwd, hipFuncAttributeMaxDynamicSharedMemorySize, LDS_BYTES) != hipSuccess) { fprintf(stderr, "kernel_launch: hipFuncSetAttribute failed\n"); grid = -1; return; }
        if (hipOccupancyMaxActiveBlocksPerMultiprocessor(&per_cu, (const void*)mega_fwd, 512, LDS_BYTES) != hipSuccess || per_cu < 1) { fprintf(stderr, "kernel_launch: occupancy query gave %d\n", per_cu); per_cu = 1; }
        (void)hipGetLastError();
        grid = (cus * per_cu) & ~7;
        fprintf(stderr, "kernel_launch: grid %d (cus %d x %d)\n", grid, cus, per_cu);
    }
    if (grid < 0) return;
    if (hipMemsetAsync((char*)d_ws + WS_CTL, 0, CTL_ZERO_BYTES, stream) != hipSuccess) { fprintf(stderr, "kernel_launch: memset failed\n"); return; }
    Params p{};
    for (int i = 0; i < 22; ++i) p.in[i] = (const float*)d_in[i];
    p.out = (float*)d_out; p.ws = (unsigned char*)d_ws;
    for (int j = 0; j < 8; ++j) p.inv_freq[j] = (float)pow(500000.0, -(double)j / 8.0);
    p.lo = 0; p.hi = 0; void* args[] = {&p};
    hipError_t e = hipLaunchCooperativeKernel((const void*)mega_fwd, dim3(grid), dim3(512), args, LDS_BYTES, stream);
    if (e != hipSuccess) fprintf(stderr, "cooperative launch failed: %s (grid %d)\n", hipGetErrorString(e), grid);
}
```

```cpp
#include <hip/hip_runtime.h>
#include <hip/hip_cooperative_groups.h>
#include <cstdio>
#include <cstdint>
#include <cmath>
namespace cg = cooperative_groups;

#define LAS __attribute__((address_space(3)))
#define DI __device__ __forceinline__
typedef unsigned short bf16_t;
typedef short bf16x8 __attribute__((ext_vector_type(8)));
typedef short s16x4 __attribute__((ext_vector_type(4)));
typedef float f32x2 __attribute__((ext_vector_type(2)));
typedef float f32x4 __attribute__((ext_vector_type(4)));
typedef float f32x16 __attribute__((ext_vector_type(16)));
typedef unsigned u32x2 __attribute__((ext_vector_type(2)));
typedef unsigned u32x4 __attribute__((ext_vector_type(4)));
typedef __bf16 bf16x2_t __attribute__((ext_vector_type(2)));

constexpr int D = 1024, SEQ = 8192, BATCH = 8, DEPTH = 4, DIN = 7680, DFF = 4096;
constexpr int NCHUNK = 4, BPC = BATCH / NCHUNK, MC = BPC * SEQ;
constexpr int PC_Q = 0, PC_Y = 1024, PC_P = 2048, PC_K = 3072, PC_V = 3328, PC_X = 3584, PC_G = 4608;
constexpr size_t WO_IN = 0, WO_BR = WO_IN + (size_t)DIN * D, WO_OUT = WO_BR + 3ull * D * D, WO_PG = WO_OUT + (size_t)D * D, WO_UP = WO_PG + 4ull * 256 * 256,
                 WO_DN = WO_UP + (size_t)DFF * D, WO_RA = WO_DN + (size_t)DFF * D, WO_RI = WO_RA + 16ull * 64 * 64, WO_LAYER = WO_RI + 16ull * 64 * 64;
constexpr size_t MiB = 1ull << 20;
constexpr size_t WS_ROPE = 0, WS_W = 3 * MiB, WS_SUMS = 163 * MiB, WS_HB = 164 * MiB, WS_POOLED = 196 * MiB, WS_MERGED = 228 * MiB, WS_PROJ = 260 * MiB, HALF_STRIDE = 337 * MiB,
                 WS_CTL = 838 * MiB, WS_AU = 840 * MiB  , WS_END = 968 * MiB;
constexpr size_t CTL_ZERO_BYTES = 65536;
static_assert(WO_LAYER * 2 * DEPTH <= 160 * MiB, "weights fit");
static_assert((size_t)MC * DIN * 2 == 240 * MiB && WS_PROJ + 240 * MiB <= WS_SUMS + HALF_STRIDE, "proj size");
constexpr size_t PROJ_MIX_OFF = 128 * MiB;
constexpr int LDS_BYTES = 147456;
constexpr float EPS = 1e-6f;
constexpr float LOG2E = 1.4426950408889634f;

DI unsigned pk2(float lo, float hi) { f32x2 v = {lo, hi}; bf16x2_t b = __builtin_convertvector(v, bf16x2_t); return __builtin_bit_cast(unsigned, b); }
DI float bflo(unsigned u) { return __uint_as_float(u << 16); }
DI float bfhi(unsigned u) { return __uint_as_float(u & 0xffff0000u); }
DI float bf1(bf16_t u) { return __uint_as_float(((unsigned)u) << 16); }
DI float wave_sum(float v) {
#pragma unroll
    for (int o = 1; o < 64; o <<= 1) v += __shfl_xor(v, o);
    return v;
}
DI float sigm(float x) { return __builtin_amdgcn_rcpf(1.0f + __builtin_amdgcn_exp2f(-x * LOG2E)); }
DI float gelu_tanh(float y) { const float z = 0.7978845608028654f * (y + 0.044715f * y * y * y); const float t = 1.0f - 2.0f * __builtin_amdgcn_rcpf(1.0f + __builtin_amdgcn_exp2f(2.0f * LOG2E * z)); return 0.5f * y * (1.0f + t); }
#define MFMA32(a, b, c) __builtin_amdgcn_mfma_f32_32x32x16_bf16((a), (b), (c), 0, 0, 0)

namespace pg8 {
constexpr int BM = 256, BK = 64, HALF = 128, HTB = HALF * BK * 2, STAGE_BYTES = 8 * HTB, NXCD = 8, WGM = 8;
__host__ __device__ __forceinline__ int lds_byte(int r, int c) { const int st = (r >> 4) * 2 + (c >> 5), rr = r & 15, cc = c & 31, ob = rr * 64 + cc * 2; return st * 1024 + (ob ^ (((ob >> 9) & 1) << 5)); }
__host__ __device__ __forceinline__ void stage_rc(int b, int& R, int& C) { const int st = b / 1024, sb = b % 1024, swz = sb ^ (((sb >> 9) & 1) << 5); R = (st >> 1) * 16 + swz / 64; C = (st & 1) * 32 + (swz % 64) / 2; }
__host__ __device__ __forceinline__ int perm32(int rho) { const int n = rho >> 4, i = rho & 15; return 8 * (i >> 2) + 4 * n + (i & 3); }

struct Unit { int pm, pn, z; };
enum { EP_BF16 = 0, EP_RELU2 = 1, EP_SCALE = 2, EP_MERGE = 4 };
struct Cfg { const bf16_t* A; const bf16_t* Bt; int lda, ldb, K, N, lz, zA, zB, pnA; };
DI Cfg gemm_cfg(int ph, unsigned char* ws, unsigned char* wg, int l) {
    const bf16_t* Wl = (const bf16_t*)(wg + WS_W) + (size_t)l * WO_LAYER; const bf16_t* proj = (const bf16_t*)(ws + WS_PROJ);
    Cfg c; c.zA = 0; c.zB = 0; c.pnA = 0; c.lda = D; c.ldb = D; c.K = D; c.N = D; c.lz = 4;
    if (ph == 0) { c.A = (const bf16_t*)(ws + WS_HB); c.Bt = Wl + WO_IN; c.N = DIN; }
    else if (ph == 2) { c.A = (const bf16_t*)(ws + WS_POOLED); c.pnA = 256; c.Bt = Wl + WO_PG; c.K = 256; c.ldb = 256; c.lz = 2; }
    else if (ph == 3) { c.A = proj + PC_Q; c.lda = DIN; c.zA = D; c.Bt = Wl + WO_BR; c.zB = D * D; c.K = 3 * D; }
    else if (ph == 4) { c.A = (const bf16_t*)(ws + WS_MERGED); c.Bt = Wl + WO_OUT; }
    else if (ph == 6) { c.A = (const bf16_t*)(ws + WS_HB); c.Bt = Wl + WO_UP; c.N = DFF; }
    else { c.A = proj; c.lda = DFF; c.Bt = Wl + WO_DN; c.K = DFF; c.ldb = DFF; c.lz = 6; }
    return c;
}
struct Sched {
    int nM, nN, nZ, nwg, G, c, nx;
    DI void init(int M, int N, int nZ_, int G_, int c_, int nx_) { nM = M / BM; nN = N / BM; nZ = nZ_; nwg = nM * nN; G = G_; c = c_; nx = nx_; }
    DI bool next(int i, Unit& u) const {
        const int t = i; u.z = 0;
        const long L = (long)t * G + c; if (L >= nwg) return false;
        int wgid = (int)L; { const int q = nwg / nx, r = nwg % nx, xcd = wgid % nx, off = wgid / nx; wgid = (xcd < r ? xcd * (q + 1) : r * (q + 1) + (xcd - r) * q) + off; }
        const int nig = WGM * nN, gid = wgid / nig, fm = gid * WGM, gsz = (nM - fm) < WGM ? (nM - fm) : WGM;
        u.pm = fm + ((wgid % nig) % gsz); u.pn = (wgid % nig) / gsz; return true;
    }
};

DI unsigned ror8(unsigned x) { return (unsigned)__builtin_amdgcn_mov_dpp((int)x, 0x128, 0xf, 0xf, true); }
DI void store_lines(bf16_t* Ob, size_t row, int ldc, int colw, int fr, int fq, const u32x4& w0, const u32x4& w1) {
    const bool lo = (fr & 8) == 0;
    const u32x4 snd = lo ? w1 : w0;
    u32x4 rcv; rcv.x = ror8(snd.x); rcv.y = ror8(snd.y); rcv.z = ror8(snd.z); rcv.w = ror8(snd.w);
    const u32x4 dA = lo ? w0 : rcv, dB = lo ? rcv : w1;
    const int col = colw + 8 * fq + (lo ? 0 : 32);
    __builtin_nontemporal_store(dA, (u32x4*)(Ob + (lo ? row : row - 8) * ldc + col));
    __builtin_nontemporal_store(dB, (u32x4*)(Ob + (lo ? row + 8 : row) * ldc + col));
}
DI void epilogue(const f32x4 (&acc)[2][2][4][2], int ph, unsigned char* ws, const float* pscale, const Unit& u, int wr, int wc, int fr, int fq) {
    const int row0 = u.pm * BM + wr * 64 + fr, colw = u.pn * BM + wc * 64, col0 = colw + 8 * fq;
    const int mode = (ph == 0 || ph == 4 || ph == 7) ? EP_BF16 : ph == 2 ? EP_SCALE : ph == 3 ? EP_MERGE : EP_RELU2;
    bf16_t* Ob = ph == 3 ? (bf16_t*)(ws + WS_MERGED) : (ph == 4 || ph == 7) ? (bf16_t*)(ws + WS_PROJ + PROJ_MIX_OFF) : (bf16_t*)(ws + WS_PROJ) + (ph == 2 ? PC_P : 0);
    const int ldc = (ph == 0 || ph == 2) ? DIN : (ph == 6 ? DFF : D);
    if (mode == EP_BF16 || mode == EP_RELU2) {
        const bool r2 = mode == EP_RELU2;
#pragma unroll
        for (int ai = 0; ai < 2; ++ai)
#pragma unroll
            for (int m = 0; m < 4; ++m) { u32x4 w[2];
#pragma unroll
                for (int bj = 0; bj < 2; ++bj) { f32x4 v0 = acc[ai][bj][m][0], v1 = acc[ai][bj][m][1];
                    if (r2) {
#pragma unroll
                        for (int j = 0; j < 4; ++j) { const float a = fmaxf(v0[j], 0.f), b = fmaxf(v1[j], 0.f); v0[j] = a * a; v1[j] = b * b; } }
                    w[bj].x = pk2(v0[0], v0[1]); w[bj].y = pk2(v0[2], v0[3]); w[bj].z = pk2(v1[0], v1[1]); w[bj].w = pk2(v1[2], v1[3]); }
                store_lines(Ob, (size_t)(row0 + ai * HALF + m * 16), ldc, colw, fr, fq, w[0], w[1]); }
    } else if (mode == EP_SCALE) {
        f32x4 sc[2][2];
#pragma unroll
        for (int bj = 0; bj < 2; ++bj)
#pragma unroll
            for (int n = 0; n < 2; ++n) sc[bj][n] = *(const f32x4*)(pscale + col0 + bj * 32 + 4 * n);
#pragma unroll
        for (int ai = 0; ai < 2; ++ai)
#pragma unroll
            for (int m = 0; m < 4; ++m) { u32x4 w[2];
#pragma unroll
                for (int bj = 0; bj < 2; ++bj) { const f32x4 v0 = acc[ai][bj][m][0] * sc[bj][0], v1 = acc[ai][bj][m][1] * sc[bj][1];
                    w[bj].x = pk2(v0[0], v0[1]); w[bj].y = pk2(v0[2], v0[3]); w[bj].z = pk2(v1[0], v1[1]); w[bj].w = pk2(v1[2], v1[3]); }
                store_lines(Ob, (size_t)(row0 + ai * HALF + m * 16), ldc, colw, fr, fq, w[0], w[1]); }
    } else {
        const bf16_t* gate = (const bf16_t*)(ws + WS_PROJ) + PC_G + 2 * D;
#pragma unroll
        for (int ai = 0; ai < 2; ++ai)
#pragma unroll
            for (int m = 0; m < 4; ++m) { const size_t row = (size_t)(row0 + ai * HALF + m * 16); u32x4 w[2];
#pragma unroll
                for (int bj = 0; bj < 2; ++bj) { const int col = col0 + bj * 32;
                    const u32x4 gw = *(const u32x4*)(gate + row * DIN + col);
                    const float ga[8] = {bflo(gw.x), bfhi(gw.x), bflo(gw.y), bfhi(gw.y), bflo(gw.z), bfhi(gw.z), bflo(gw.w), bfhi(gw.w)};
                    float f[8];
#pragma unroll
                    for (int j = 0; j < 8; ++j) f[j] = __builtin_amdgcn_rcpf(1.0f + __builtin_amdgcn_exp2f(-fmaxf(ga[j], -30.f) * LOG2E));
                    const f32x4 v0 = acc[ai][bj][m][0] * (f32x4){f[0], f[1], f[2], f[3]}, v1 = acc[ai][bj][m][1] * (f32x4){f[4], f[5], f[6], f[7]};
                    w[bj].x = pk2(v0[0], v0[1]); w[bj].y = pk2(v0[2], v0[3]); w[bj].z = pk2(v1[0], v1[1]); w[bj].w = pk2(v1[2], v1[3]); }
                store_lines(Ob, row, ldc, colw, fr, fq, w[0], w[1]);
                asm volatile("" ::: "memory"); }
    }
}
DI void merge_carry(f32x4 (&acc)[2][2][4][2], unsigned char* ws, const Unit& u, int z, int wr, int wc, int fr, int fq) {
    const int row0 = u.pm * BM + wr * 64 + fr, col0 = u.pn * BM + wc * 64 + 8 * fq;
    const bf16_t* gate = (const bf16_t*)(ws + WS_PROJ) + PC_G + (size_t)z * D;
#pragma unroll
    for (int ai = 0; ai < 2; ++ai)
#pragma unroll
        for (int m = 0; m < 4; ++m) { const size_t row = (size_t)(row0 + ai * HALF + m * 16);
#pragma unroll
            for (int bj = 0; bj < 2; ++bj) { const int col = col0 + bj * 32;
                const u32x4 gw = *(const u32x4*)(gate + row * DIN + col), hw = *(const u32x4*)(gate + row * DIN + D + col);
                const float ga[8] = {bflo(gw.x), bfhi(gw.x), bflo(gw.y), bfhi(gw.y), bflo(gw.z), bfhi(gw.z), bflo(gw.w), bfhi(gw.w)};
                const float gb[8] = {bflo(hw.x), bfhi(hw.x), bflo(hw.y), bfhi(hw.y), bflo(hw.z), bfhi(hw.z), bflo(hw.w), bfhi(hw.w)};
                float f[8];
#pragma unroll
                for (int j = 0; j < 8; ++j) { const float ea = __builtin_amdgcn_exp2f(-fmaxf(ga[j], -30.f) * LOG2E), eb = __builtin_amdgcn_exp2f(-fmaxf(gb[j], -30.f) * LOG2E);
                    f[j] = (1.0f + eb) * __builtin_amdgcn_rcpf(1.0f + ea); }
                acc[ai][bj][m][0] = acc[ai][bj][m][0] * (f32x4){f[0], f[1], f[2], f[3]}; acc[ai][bj][m][1] = acc[ai][bj][m][1] * (f32x4){f[4], f[5], f[6], f[7]};
                asm volatile("" ::: "memory"); } }
}

DI void gemm_phase(LAS unsigned char* lds, int ph, unsigned char* ws, unsigned char* wg, int l, const float* pscale, int G, int cidx, int nx) {
    int tid_ = threadIdx.x; asm volatile("" : "+v"(tid_));
    const int tid = tid_, wid = __builtin_amdgcn_readfirstlane(tid >> 6), lane = tid & 63, wr = wid >> 2, wc = wid & 3, fr = lane & 15, fq = lane >> 4;
    const Cfg g0 = gemm_cfg(ph, ws, wg, l);
    const int nt = g0.K / BK, lda = g0.lda, ldb = g0.ldb, lz = g0.lz, ntzm = (1 << g0.lz) - 1;
    const size_t zAb = (size_t)g0.zA * 2, zBb = (size_t)g0.zB * 2;
    Sched S; S.init(MC, g0.N, 1, G, cidx, nx);
    unsigned voffA[2], voffB[2];
#pragma unroll
    for (int i = 0; i < 2; ++i) { int R, C; stage_rc(tid * 16 + i * 8192, R, C); const int Rb = (R >> 5) * 64 + perm32(R & 31);
        voffA[i] = (unsigned)(R * lda + C) * 2u; voffB[i] = (unsigned)(Rb * ldb + C) * 2u; }
    const size_t kstep = (size_t)(BK * 2);
    const size_t hstepA = (size_t)HALF * lda * 2, hstepB = (size_t)32 * ldb * 2;
    const unsigned ldsw = (unsigned)wid * 1024u;
    const int aoff = lds_byte(wr * 64 + fr, fq * 8), boff = lds_byte(wc * 32 + fr, fq * 8);
#define PG8_SA(b, h) (((b) * 2 + (h)) * HTB)
#define PG8_SB(b, h) ((4 + (b) * 2 + (h)) * HTB)
#define PG8_STAGE(bufoff, gbase, voff) do { _Pragma("unroll") for (int _i = 0; _i < 2; ++_i) \
        __builtin_amdgcn_global_load_lds((const unsigned*)((const char*)(gbase) + (voff)[_i]), (LAS unsigned*)(lds + (bufoff) + ldsw + _i * 8192), 16, 0, 0); } while (0)
#define PG8_LDA(dst, b, h) do { _Pragma("unroll") for (int m = 0; m < 4; ++m) _Pragma("unroll") for (int k = 0; k < 2; ++k) dst[m][k] = *(const LAS bf16x8*)(lds + PG8_SA(b, h) + aoff + m * 2048 + k * 1024); } while (0)
#define PG8_LDB(dst, b, h) do { _Pragma("unroll") for (int n = 0; n < 2; ++n) _Pragma("unroll") for (int k = 0; k < 2; ++k) dst[n][k] = *(const LAS bf16x8*)(lds + PG8_SB(b, h) + boff + n * 2048 + k * 1024); } while (0)
#define PG8_MMA(ai, bj, At, Bt) do { __builtin_amdgcn_s_setprio(1); _Pragma("unroll") for (int m = 0; m < 4; ++m) _Pragma("unroll") for (int n = 0; n < 2; ++n) _Pragma("unroll") for (int k = 0; k < 2; ++k) \
        acc[ai][bj][m][n] = __builtin_amdgcn_mfma_f32_16x16x32_bf16(Bt[n][k], At[m][k], acc[ai][bj][m][n], 0, 0, 0); __builtin_amdgcn_s_setprio(0); } while (0)
#define PG8_WAIT_V(n) asm volatile("s_waitcnt vmcnt(" #n ")" ::: "memory")
#define PG8_WAIT_L(n) asm volatile("s_waitcnt lgkmcnt(" #n ")" ::: "memory")
#define PG8_BAR __builtin_amdgcn_s_barrier()
#define PG8_SCHED __builtin_amdgcn_sched_barrier(0)
#define PG8_ABASE(u) ((const char*)gx.A + (size_t)(u).pm * tstepA + (size_t)(u).pn * gx.pnA * 2)
#define PG8_BBASE(u) ((const char*)gx.Bt + (size_t)(u).pn * tstepB)
#define PG8_KA(t_) (cA + (size_t)((t_) >> lz) * zAb + (size_t)((t_) & ntzm) * kstep)
#define PG8_KB(t_) (cB + (size_t)((t_) >> lz) * zBb + (size_t)((t_) & ntzm) * kstep)
#define PG8_RECFG() int phx = ph; int lx = l; unsigned char* wsx = ws; unsigned char* wgx = wg; asm volatile("" : "+s"(phx), "+s"(lx), "+s"(wsx), "+s"(wgx)); const Cfg gx = gemm_cfg(phx, wsx, wgx, lx); \
        const size_t tstepA = (size_t)BM * gx.lda * 2, tstepB = (size_t)BM * gx.ldb * 2
    Unit cur, nxt; int ui = 0;
    if (!S.next(0, cur)) return;
    f32x4 acc[2][2][4][2];
#pragma unroll
    for (int a = 0; a < 2; ++a)
#pragma unroll
        for (int b = 0; b < 2; ++b)
#pragma unroll
            for (int m = 0; m < 4; ++m)
#pragma unroll
                for (int n = 0; n < 2; ++n) acc[a][b][m][n] = (f32x4){0.f, 0.f, 0.f, 0.f};
    bf16x8 At[4][2], B0[2][2], B1[2][2];
    const char* cA; const char* cB; { PG8_RECFG(); cA = PG8_ABASE(cur); cB = PG8_BBASE(cur); }
    PG8_STAGE(PG8_SB(0, 0), cB, voffB); PG8_STAGE(PG8_SB(0, 1), cB + hstepB, voffB); PG8_STAGE(PG8_SA(0, 0), cA, voffA); PG8_STAGE(PG8_SA(0, 1), cA + hstepA, voffA);
    if (wr == 1) PG8_BAR;
    PG8_WAIT_V(2); PG8_BAR;
    PG8_STAGE(PG8_SB(1, 0), cB + kstep, voffB); PG8_STAGE(PG8_SA(1, 0), cA + kstep, voffA); PG8_STAGE(PG8_SB(1, 1), cB + hstepB + kstep, voffB);
    PG8_WAIT_V(6); PG8_BAR;
    for (;;) {
        const bool has_next = S.next(ui + 1, nxt);
        const char* nA = cA; const char* nB = cB; if (has_next) { PG8_RECFG(); nA = PG8_ABASE(nxt); nB = PG8_BBASE(nxt); }
        for (int t = 0; t < nt; t += 2) {
            const bool last = (t == nt - 2);
            const char* a1 = PG8_KA(t + 1);
            const char* a2 = last ? nA : PG8_KA(t + 2); const char* b2 = last ? nB : PG8_KB(t + 2);
            const char* a3 = a2 + kstep; const char* b3 = b2 + kstep;
            if (zAb != 0 && t != 0 && (t & ntzm) == 0) { unsigned char* wsx = ws; asm volatile("" : "+s"(wsx)); int frx = fr; asm volatile("" : "+v"(frx)); merge_carry(acc, wsx, cur, (t >> lz) - 1, wr, wc, frx, fq); }
            PG8_LDB(B0, 0, 0); PG8_LDB(B1, 0, 1); PG8_SCHED; PG8_LDA(At, 0, 0); PG8_STAGE(PG8_SA(1, 1), a1 + hstepA, voffA);
            PG8_WAIT_V(8); PG8_WAIT_L(0); PG8_BAR; PG8_MMA(0, 0, At, B0); PG8_MMA(0, 1, At, B1); PG8_BAR; PG8_SCHED;
            PG8_LDA(At, 0, 1); PG8_STAGE(PG8_SB(0, 0), b2, voffB); PG8_STAGE(PG8_SB(0, 1), b2 + hstepB, voffB); PG8_STAGE(PG8_SA(0, 0), a2, voffA);
            PG8_WAIT_V(8); PG8_WAIT_L(0); PG8_BAR; PG8_MMA(1, 0, At, B0); PG8_MMA(1, 1, At, B1); PG8_BAR; PG8_SCHED;
            PG8_LDB(B0, 1, 0); PG8_LDB(B1, 1, 1); PG8_SCHED; PG8_LDA(At, 1, 0); PG8_STAGE(PG8_SA(0, 1), a2 + hstepA, voffA);
            PG8_WAIT_V(8); PG8_WAIT_L(0); PG8_BAR; PG8_MMA(0, 0, At, B0); PG8_MMA(0, 1, At, B1); PG8_BAR; PG8_SCHED;
            PG8_LDA(At, 1, 1); PG8_STAGE(PG8_SB(1, 0), b3, voffB); PG8_STAGE(PG8_SB(1, 1), b3 + hstepB, voffB); PG8_STAGE(PG8_SA(1, 0), a3, voffA);
            PG8_WAIT_V(8); PG8_WAIT_L(0); PG8_BAR; PG8_MMA(1, 0, At, B0); PG8_MMA(1, 1, At, B1); PG8_BAR; PG8_SCHED;
        }
        if (wr == 0) PG8_BAR;
        { int phx = ph; unsigned char* wsx = ws; asm volatile("" : "+s"(phx), "+s"(wsx)); int frx = fr; asm volatile("" : "+v"(frx)); epilogue(acc, phx, wsx, pscale, cur, wr, wc, frx, fq); }
        if (!has_next) break;
#pragma unroll
        for (int a = 0; a < 2; ++a)
#pragma unroll
            for (int b = 0; b < 2; ++b)
#pragma unroll
                for (int m = 0; m < 4; ++m)
#pragma unroll
                    for (int n = 0; n < 2; ++n) acc[a][b][m][n] = (f32x4){0.f, 0.f, 0.f, 0.f};
        cur = nxt; cA = nA; cB = nB; ++ui;
        if (wr == 1) PG8_BAR;
    }
    PG8_WAIT_V(0);
    PG8_BAR;
#undef PG8_SA
#undef PG8_SB
#undef PG8_STAGE
#undef PG8_LDA
#undef PG8_LDB
#undef PG8_MMA
#undef PG8_WAIT_V
#undef PG8_WAIT_L
#undef PG8_BAR
#undef PG8_SCHED
#undef PG8_ABASE
#undef PG8_BBASE
#undef PG8_RECFG
#undef PG8_KA
#undef PG8_KB
}
}

DI void transpose_item(const float* W, int K, int N, bf16_t* WT, int drow0, LAS float* scr, int k0, int n0, int lane) {
#pragma unroll 8
    for (int i = 0; i < 32; ++i) { const int kk = 2 * i + (lane >> 5); scr[kk * 33 + (lane & 31)] = W[(size_t)(k0 + kk) * N + n0 + (lane & 31)]; }
    asm volatile("s_waitcnt lgkmcnt(0)" ::: "memory");
    const int c = lane & 7;
#pragma unroll
    for (int j = 0; j < 4; ++j) { const int n = (lane >> 3) + 8 * j; const LAS float* s = scr + (8 * c) * 33 + n;
        u32x4 o; o.x = pk2(s[0 * 33], s[1 * 33]); o.y = pk2(s[2 * 33], s[3 * 33]); o.z = pk2(s[4 * 33], s[5 * 33]); o.w = pk2(s[6 * 33], s[7 * 33]);
        *(u32x4*)(WT + (size_t)(drow0 + n) * K + k0 + 8 * c) = o; }
    asm volatile("s_waitcnt lgkmcnt(0)" ::: "memory");
}
DI int win_perm(int n) {
    if (n < 1024) return PC_Q + n;
    if (n < 1280) return PC_K + (n - 1024);
    if (n < 1536) return PC_V + (n - 1280);
    if (n < 2560) return PC_X + (n - 1536);
    if (n < 3584) return PC_Y + (n - 2560);
    if (n < 4608) return PC_P + (n - 3584);
    return n;
}

struct Params {
    const float* in[22]; float* out; unsigned char* ws; float inv_freq[8]; int lo, hi;
};
enum { I_X = 0, I_NMIXPRE, I_NMIXPOST, I_WIN, I_SINKS, I_WATT, I_CONVW, I_CONVB, I_WRGA, I_BRGA, I_WRGI, I_BRGI, I_LAM, I_WRNN, I_WPG, I_PSCALE, I_WPOOL, I_WOUT, I_NMLPPRE, I_NMLPPOST, I_WUP, I_WDN };

DI void prologue(const Params& p, LAS unsigned char* lds, int l_lo, int l_hi, bool do_rope, int gw, int NGW, int wave, int lane) {
    LAS float* scr = (LAS float*)(lds + wave * 16384);
    bf16_t* Wall = (bf16_t*)(p.ws + WS_W);
    constexpr int IT_IN = 16 * 240, IT_SQ = 512, IT_PG = 128, IT_UP = 2048, IT_DN = 2048, IT_RG = 32;
    constexpr int IT_LAYER = IT_IN + 4 * IT_SQ + IT_PG + IT_UP + IT_DN + 2 * IT_RG;
    for (int it = l_lo * IT_LAYER + gw; it < IT_LAYER * l_hi; it += NGW) {
        const int l = it / IT_LAYER; int r = it - l * IT_LAYER; bf16_t* Wl = Wall + (size_t)l * WO_LAYER;
        if (r < IT_IN) { const int kb = r / 240, nb = r % 240; transpose_item(p.in[I_WIN] + (size_t)l * D * DIN, D, DIN, Wl + WO_IN, win_perm(nb * 32), scr, kb * 64, nb * 32, lane); continue; } r -= IT_IN;
        if (r < 4 * IT_SQ) { const int which = r / IT_SQ; r -= which * IT_SQ; const int kb = r / 32, nb = r % 32;
            const float* src = (which == 0 ? p.in[I_WATT] : which == 1 ? p.in[I_WRNN] : which == 2 ? p.in[I_WPOOL] : p.in[I_WOUT]) + (size_t)l * D * D;
            bf16_t* dst = which < 3 ? Wl + WO_BR + (size_t)which * D * D : Wl + WO_OUT;
            transpose_item(src, D, D, dst, nb * 32, scr, kb * 64, nb * 32, lane); continue; } r -= 4 * IT_SQ;
        if (r < IT_PG) { const int gq = r / 32; r -= gq * 32; const int kb = r / 8, nb = r % 8;
            transpose_item(p.in[I_WPG] + ((size_t)l * 4 + gq) * 65536, 256, 256, Wl + WO_PG, gq * 256 + nb * 32, scr, kb * 64, nb * 32, lane); continue; } r -= IT_PG;
        if (r < IT_UP) { const int kb = r / 128, nb = r % 128; transpose_item(p.in[I_WUP] + (size_t)l * D * DFF, D, DFF, Wl + WO_UP, nb * 32, scr, kb * 64, nb * 32, lane); continue; } r -= IT_UP;
        if (r < IT_DN) { const int kb = r / 32, nb = r % 32; transpose_item(p.in[I_WDN] + (size_t)l * DFF * D, DFF, D, Wl + WO_DN, nb * 32, scr, kb * 64, nb * 32, lane); continue; } r -= IT_DN;
        { const int which = r / IT_RG; r -= which * IT_RG; const int hb = r / 2, nb = r % 2;
          transpose_item((which ? p.in[I_WRGI] : p.in[I_WRGA]) + ((size_t)l * 16 + hb) * 4096, 64, 64, Wl + (which ? WO_RI : WO_RA), hb * 64 + nb * 32, scr, 0, nb * 32, lane); }
    }
    float* rope = (float*)(p.ws + WS_ROPE);
    if (do_rope) for (int i = gw * 64 + lane; i < SEQ * 8; i += NGW * 64) {
        const int pos = i >> 3, j = i & 7;
        const float ang = (float)pos * p.inv_freq[j];
        const double a = (double)ang * 0.15915494309189535; const double n = __builtin_rint(a); const float fr = (float)(a - n);
        rope[pos * 16 + j] = __builtin_amdgcn_cosf(fr); rope[pos * 16 + 8 + j] = __builtin_amdgcn_sinf(fr);
    }
}

DI void rowpass(const float* hsrc, const bf16_t* mix, const float* gpost, const float* gnext, float* hdst, bf16_t* hb, int gw, int NGW, int lane) {
    for (int m0 = gw * 2; m0 < MC; m0 += NGW * 2) {
        f32x4 hv[2][4], mv[2][4];
#pragma unroll
        for (int r = 0; r < 2; ++r)
#pragma unroll
            for (int j = 0; j < 4; ++j) hv[r][j] = __builtin_nontemporal_load((const f32x4*)(hsrc + (size_t)(m0 + r) * D + 256 * j + 4 * lane));
        if (mix) {
#pragma unroll
            for (int r = 0; r < 2; ++r)
#pragma unroll
                for (int j = 0; j < 4; ++j) { const u32x2 w = __builtin_nontemporal_load((const u32x2*)(mix + (size_t)(m0 + r) * D + 256 * j + 4 * lane)); mv[r][j] = (f32x4){bflo(w.x), bfhi(w.x), bflo(w.y), bfhi(w.y)}; }
            float ss[2] = {0.f, 0.f};
#pragma unroll
            for (int r = 0; r < 2; ++r)
#pragma unroll
                for (int j = 0; j < 4; ++j) ss[r] += (mv[r][j].x * mv[r][j].x + mv[r][j].y * mv[r][j].y) + (mv[r][j].z * mv[r][j].z + mv[r][j].w * mv[r][j].w);
#pragma unroll
            for (int o = 1; o < 64; o <<= 1) { ss[0] += __shfl_xor(ss[0], o); ss[1] += __shfl_xor(ss[1], o); }
#pragma unroll
            for (int r = 0; r < 2; ++r) { const float rs = __builtin_amdgcn_rsqf(ss[r] * (1.0f / D) + EPS);
#pragma unroll
                for (int j = 0; j < 4; ++j) { const f32x4 gp = *(const f32x4*)(gpost + 256 * j + 4 * lane); hv[r][j] += mv[r][j] * rs * gp; *(f32x4*)(hdst + (size_t)(m0 + r) * D + 256 * j + 4 * lane) = hv[r][j]; } }
        }
        if (gnext) {
            float ss[2] = {0.f, 0.f};
#pragma unroll
            for (int r = 0; r < 2; ++r)
#pragma unroll
                for (int j = 0; j < 4; ++j) ss[r] += (hv[r][j].x * hv[r][j].x + hv[r][j].y * hv[r][j].y) + (hv[r][j].z * hv[r][j].z + hv[r][j].w * hv[r][j].w);
#pragma unroll
            for (int o = 1; o < 64; o <<= 1) { ss[0] += __shfl_xor(ss[0], o); ss[1] += __shfl_xor(ss[1], o); }
#pragma unroll
            for (int r = 0; r < 2; ++r) { const float rs = __builtin_amdgcn_rsqf(ss[r] * (1.0f / D) + EPS);
#pragma unroll
                for (int j = 0; j < 4; ++j) { const f32x4 gn = *(const f32x4*)(gnext + 256 * j + 4 * lane); const f32x4 o = hv[r][j] * rs * gn;
                    u32x2 w; w.x = pk2(o.x, o.y); w.y = pk2(o.z, o.w); *(u32x2*)(hb + (size_t)(m0 + r) * D + 256 * j + 4 * lane) = w; } }
        }
    }
}

DI void rope8(u32x4& v, const u32x4& pr, const float* tab, bool second) {
    const f32x4 c0 = *(const f32x4*)tab, c1 = *(const f32x4*)(tab + 4), s0 = *(const f32x4*)(tab + 8), s1 = *(const f32x4*)(tab + 12);
    const float sg = second ? 1.f : -1.f;
    float x[8] = {bflo(v.x), bfhi(v.x), bflo(v.y), bfhi(v.y), bflo(v.z), bfhi(v.z), bflo(v.w), bfhi(v.w)};
    const float y[8] = {bflo(pr.x), bfhi(pr.x), bflo(pr.y), bfhi(pr.y), bflo(pr.z), bfhi(pr.z), bflo(pr.w), bfhi(pr.w)};
    const float cs[8] = {c0.x, c0.y, c0.z, c0.w, c1.x, c1.y, c1.z, c1.w}, sn[8] = {s0.x, s0.y, s0.z, s0.w, s1.x, s1.y, s1.z, s1.w};
#pragma unroll
    for (int j = 0; j < 8; ++j) x[j] = x[j] * cs[j] + sg * y[j] * sn[j];
    v.x = pk2(x[0], x[1]); v.y = pk2(x[2], x[3]); v.z = pk2(x[4], x[5]); v.w = pk2(x[6], x[7]);
}
constexpr int KS_LD = 72, VT_LD = 260, ATT_VT_OFF = 256 * KS_LD * 2;
DI void attn_unit(LAS unsigned char* lds, bf16_t* P, const float* rope, const float* sinks, int unit, int tid, int wid, int lane) {
    const int kvh = unit & 3, n = (unit >> 2) & 63, b = unit >> 8;
    const long rowblk = (long)b * SEQ + n * 128;
    LAS bf16_t* Ks = (LAS bf16_t*)lds; LAS bf16_t* Vt = (LAS bf16_t*)(lds + ATT_VT_OFF);
#pragma unroll
    for (int i = 0; i < 4; ++i) {
        const int pc = tid + 512 * i, key = pc >> 3, dg = pc & 7;
        const bool valid = (n > 0) || key >= 128;
        u32x4 kv = {0u, 0u, 0u, 0u}, vv = {0u, 0u, 0u, 0u};
        if (valid) { const bf16_t* src = P + (size_t)(rowblk - 128 + key) * DIN + kvh * 64 + dg * 8; kv = *(const u32x4*)(src + PC_K); vv = *(const u32x4*)(src + PC_V); }
        u32x4 pr; pr.x = __shfl_xor(kv.x, 1); pr.y = __shfl_xor(kv.y, 1); pr.z = __shfl_xor(kv.z, 1); pr.w = __shfl_xor(kv.w, 1);
        if (dg < 2) { const int pos = valid ? (n * 128 - 128 + key) : 0; rope8(kv, pr, rope + pos * 16, dg == 1); }
        *(LAS u32x4*)(Ks + key * KS_LD + dg * 8) = kv;
        const unsigned vw[4] = {vv.x, vv.y, vv.z, vv.w};
#pragma unroll
        for (int j = 0; j < 4; ++j) { Vt[(dg * 8 + 2 * j) * VT_LD + key] = (bf16_t)(vw[j] & 0xffffu); Vt[(dg * 8 + 2 * j + 1) * VT_LD + key] = (bf16_t)(vw[j] >> 16); }
    }
    __syncthreads();
    const int g = wid >> 1, head = kvh * 4 + g, q = lane & 31, hl = lane >> 5;
    const float sinkv = sinks[head] * LOG2E;
    const float cscale = 0.125f * LOG2E;
#pragma unroll 1
    for (int sb = 0; sb < 2; ++sb) {
        const int r0 = 64 * (wid & 1) + 32 * sb;
        bf16_t* qrow = P + (size_t)(rowblk + r0 + q) * DIN + PC_Q + head * 64;
        u32x4 qf[4];
#pragma unroll
        for (int s = 0; s < 4; ++s) qf[s] = *(const u32x4*)(qrow + 16 * s + 8 * hl);
        { u32x4 pr; pr.x = __shfl_xor(qf[0].x, 32); pr.y = __shfl_xor(qf[0].y, 32); pr.z = __shfl_xor(qf[0].z, 32); pr.w = __shfl_xor(qf[0].w, 32);
          rope8(qf[0], pr, rope + (n * 128 + r0 + q) * 16, hl == 1); }
        f32x16 S[5];
#pragma unroll
        for (int kt = 0; kt < 5; ++kt) {
#pragma unroll
            for (int i = 0; i < 16; ++i) S[kt][i] = 0.f;
#pragma unroll
            for (int s = 0; s < 4; ++s) { const bf16x8 kf = *(const LAS bf16x8*)(Ks + (r0 + 32 * kt + q) * KS_LD + 16 * s + 8 * hl);
                S[kt] = MFMA32(kf, __builtin_bit_cast(bf16x8, qf[s]), S[kt]); }
        }
#pragma unroll
        for (int i = 0; i < 16; ++i) { const int kl = 8 * (i >> 2) + 4 * hl + (i & 3);
            if (kl <= q) S[0][i] = -1e30f;
            if (kl > q) S[4][i] = -1e30f; }
        if (n == 0) {
#pragma unroll
            for (int kt = 0; kt < 4; ++kt) if (r0 + 32 * kt < 128) {
#pragma unroll
                for (int i = 0; i < 16; ++i) S[kt][i] = -1e30f; }
        }
        float mx = -1e30f;
#pragma unroll
        for (int kt = 0; kt < 5; ++kt)
#pragma unroll
            for (int i = 0; i < 16; ++i) mx = fmaxf(mx, S[kt][i]);
        mx = fmaxf(mx, __shfl_xor(mx, 32));
        const float M2 = fmaxf(mx * cscale, sinkv);
        float l = 0.f;
#pragma unroll
        for (int kt = 0; kt < 5; ++kt)
#pragma unroll
            for (int i = 0; i < 16; ++i) { const float pv = __builtin_amdgcn_exp2f(S[kt][i] * cscale - M2); l += pv; S[kt][i] = pv; }
        l += __shfl_xor(l, 32);
        l += __builtin_amdgcn_exp2f(sinkv - M2);
        const float inv = __builtin_amdgcn_rcpf(l);
        f32x16 O[2];
#pragma unroll
        for (int i = 0; i < 16; ++i) { O[0][i] = 0.f; O[1][i] = 0.f; }
#pragma unroll
        for (int kt = 0; kt < 5; ++kt)
#pragma unroll
            for (int s2 = 0; s2 < 2; ++s2) {
                u32x4 pw; pw.x = pk2(S[kt][8 * s2 + 0], S[kt][8 * s2 + 1]); pw.y = pk2(S[kt][8 * s2 + 2], S[kt][8 * s2 + 3]); pw.z = pk2(S[kt][8 * s2 + 4], S[kt][8 * s2 + 5]); pw.w = pk2(S[kt][8 * s2 + 6], S[kt][8 * s2 + 7]);
                const bf16x8 pf = __builtin_bit_cast(bf16x8, pw);
#pragma unroll
                for (int dt = 0; dt < 2; ++dt) {
                    const LAS bf16_t* vp = Vt + (32 * dt + q) * VT_LD + r0 + 32 * kt + 16 * s2 + 4 * hl;
                    const u32x2 v0 = *(const LAS u32x2*)vp, v1 = *(const LAS u32x2*)(vp + 8);
                    u32x4 vw; vw.x = v0.x; vw.y = v0.y; vw.z = v1.x; vw.w = v1.y;
                    O[dt] = MFMA32(__builtin_bit_cast(bf16x8, vw), pf, O[dt]);
                }
            }
        bf16_t* orow = qrow;
#pragma unroll
        for (int dt = 0; dt < 2; ++dt)
#pragma unroll
            for (int a = 0; a < 4; ++a) { u32x2 w; w.x = pk2(O[dt][4 * a] * inv, O[dt][4 * a + 1] * inv); w.y = pk2(O[dt][4 * a + 2] * inv, O[dt][4 * a + 3] * inv);
                *(u32x2*)(orow + 32 * dt + 8 * a + 4 * hl) = w; }
    }
    __syncthreads();
}

constexpr int NCH = SEQ / 128;
DI void rnn_phase(LAS unsigned char* lds, bf16_t* P, const bf16_t* WaT, const bf16_t* WiT, const float* convw, const float* convb, const float* ba, const float* bi, const float* lam,
                  f32x2* sums, unsigned* au, bool fin, int bx, int G, int tid, int wid, int lane) {
    constexpr int NU = BPC * NCH * 16;
    typedef _Float16 h2_t __attribute__((ext_vector_type(2)));
    LAS float* XC = (LAS float*)lds; LAS float* AA = (LAS float*)(lds + 32768); LAS bf16_t* XB = (LAS bf16_t*)(lds + 65536); LAS bf16_t* WL = (LAS bf16_t*)(lds + 83968);
    LAS float* SG = (LAS float*)(lds + 102400); LAS float* PF = (LAS float*)(lds + 106496); LAS float* CW = (LAS float*)(lds + 110592);
    const int t = tid >> 2, cq = tid & 3;
    const int tt = wid >> 1, nt = wid & 1, l32 = lane & 31, hl = lane >> 5;
    int cur_hbk = -1; float bac = 0.f, bic = 0.f, k8c = 0.f;
    u32x4 xr[4][2];
#define RNN_LOAD_XR(uu) do { const int hb_ = (uu) & 15, c_ = ((uu) >> 4) & 63, b_ = (uu) >> 10; const size_t rb_ = (size_t)b_ * SEQ + c_ * 128; \
        _Pragma("unroll") for (int tap = 0; tap < 4; ++tap) { const int tp_ = c_ * 128 + t + tap - 3; \
            if (tp_ >= 0) { const bf16_t* src_ = P + (rb_ + t + tap - 3) * DIN + PC_X + hb_ * 64 + 16 * cq; xr[tap][0] = *(const u32x4*)src_; xr[tap][1] = *(const u32x4*)(src_ + 8); } \
            else { xr[tap][0] = (u32x4){0u, 0u, 0u, 0u}; xr[tap][1] = (u32x4){0u, 0u, 0u, 0u}; } } } while (0)
    if (fin) {
        int par = 0;
        for (int u2 = bx; u2 < NU; u2 += G) {
            const int hbk = u2 & 15, c = (u2 >> 4) & 63, b = u2 >> 10;
            const size_t rowbase = (size_t)b * SEQ + c * 128; const int ch0 = hbk * 64, ch = lane, seg = wid;
            const unsigned* aup = au + (rowbase + 16 * seg) * D + ch0 + ch;
            bf16_t* yp = P + (rowbase + 16 * seg) * DIN + PC_Y + ch0 + ch;
            unsigned w[16]; unsigned short yv[16];
#pragma unroll
            for (int j = 0; j < 16; ++j) { w[j] = aup[(size_t)j * D]; yv[j] = yp[(size_t)j * DIN]; }
            float Ap = 1.f, Hp = 0.f;
#pragma unroll
            for (int k = 0; k < 8; ++k) { const int j = 8 * wid + k; if (j < c) { const f32x2 sv = sums[((size_t)b * NCH + j) * D + ch0 + lane]; Hp = sv.x * Hp + sv.y; Ap *= sv.x; } }
            float av[16], uv[16]; float A = 1.f, H = 0.f;
#pragma unroll
            for (int j = 0; j < 16; ++j) { const h2_t v = __builtin_bit_cast(h2_t, w[j]); av[j] = 1.0f - (float)v.x; uv[j] = (float)v.y; H = av[j] * H + uv[j]; A *= av[j]; }
            LAS float* SGp = SG + (par ? 2048 : 0);
            SGp[seg * 64 + ch] = A; SGp[512 + seg * 64 + ch] = H; SGp[1024 + wid * 64 + lane] = Ap; SGp[1536 + wid * 64 + lane] = Hp;
            __syncthreads();
            float h = 0.f;
#pragma unroll
            for (int q8 = 0; q8 < 8; ++q8) h = SGp[1024 + q8 * 64 + ch] * h + SGp[1536 + q8 * 64 + ch];
            for (int s2 = 0; s2 < seg; ++s2) h = SGp[s2 * 64 + ch] * h + SGp[512 + s2 * 64 + ch];
#pragma unroll
            for (int j = 0; j < 16; ++j) { h = av[j] * h + uv[j]; const float o = h * gelu_tanh(bf1(yv[j])); yp[(size_t)j * DIN] = (bf16_t)(pk2(o, 0.f) & 0xffffu); }
            par ^= 1;
        }
        __syncthreads();
        return;
    }
    int u = bx; if (u >= NU) return;
    RNN_LOAD_XR(u);
    for (; u < NU; u += G) {
        const int hbk = u & 15, c = (u >> 4) & 63, b = u >> 10;
        const size_t rowbase = (size_t)b * SEQ + c * 128; const int ch0 = hbk * 64;
        if (hbk != cur_hbk) {
            const int nn = tid >> 3, k8 = tid & 7;
            *(LAS u32x4*)(WL + nn * 72 + 8 * k8) = *(const u32x4*)(WaT + (size_t)hbk * 4096 + nn * 64 + 8 * k8);
            *(LAS u32x4*)(WL + 64 * 72 + nn * 72 + 8 * k8) = *(const u32x4*)(WiT + (size_t)hbk * 4096 + nn * 64 + 8 * k8);
            if (tid < 320) CW[tid] = tid < 256 ? convw[(tid >> 6) * D + ch0 + (tid & 63)] : convb[ch0 + tid - 256];
            const int chg = ch0 + 32 * nt + l32;
            bac = ba[chg]; bic = bi[chg]; k8c = -8.0f * LOG2E * log1pf(expf(-lam[chg]));
            cur_hbk = hbk;
            __syncthreads();
        }
        unsigned short yv[16]; float Ap = 1.f, Hp = 0.f;
        bf16_t* yp = P + (rowbase + 16 * wid) * DIN + PC_Y + ch0 + lane;
        if (fin) {
#pragma unroll
            for (int j = 0; j < 16; ++j) yv[j] = yp[(size_t)j * DIN];
#pragma unroll
            for (int k = 0; k < 8; ++k) { const int j = 8 * wid + k; if (j < c) { const f32x2 sv = sums[((size_t)b * NCH + j) * D + ch0 + lane]; Hp = sv.x * Hp + sv.y; Ap *= sv.x; } }
        }
        {
            f32x4 acc[4];
#pragma unroll
            for (int j = 0; j < 4; ++j) acc[j] = *(const LAS f32x4*)(CW + 256 + 16 * cq + 4 * j);
#pragma unroll
            for (int tap = 0; tap < 4; ++tap) {
                const u32x4 x0 = xr[tap][0], x1 = xr[tap][1];
                const LAS float* wp = CW + tap * 64 + 16 * cq;
                const f32x4 w0 = *(const LAS f32x4*)wp, w1 = *(const LAS f32x4*)(wp + 4), w2 = *(const LAS f32x4*)(wp + 8), w3 = *(const LAS f32x4*)(wp + 12);
                acc[0] += (f32x4){bflo(x0.x), bfhi(x0.x), bflo(x0.y), bfhi(x0.y)} * w0; acc[1] += (f32x4){bflo(x0.z), bfhi(x0.z), bflo(x0.w), bfhi(x0.w)} * w1;
                acc[2] += (f32x4){bflo(x1.x), bfhi(x1.x), bflo(x1.y), bfhi(x1.y)} * w2; acc[3] += (f32x4){bflo(x1.z), bfhi(x1.z), bflo(x1.w), bfhi(x1.w)} * w3;
            }
#pragma unroll
            for (int j = 0; j < 4; ++j) *(LAS f32x4*)(XC + t * 64 + 16 * cq + 4 * j) = acc[j];
            u32x4 o0, o1; o0.x = pk2(acc[0].x, acc[0].y); o0.y = pk2(acc[0].z, acc[0].w); o0.z = pk2(acc[1].x, acc[1].y); o0.w = pk2(acc[1].z, acc[1].w);
            o1.x = pk2(acc[2].x, acc[2].y); o1.y = pk2(acc[2].z, acc[2].w); o1.z = pk2(acc[3].x, acc[3].y); o1.w = pk2(acc[3].z, acc[3].w);
            *(LAS u32x4*)(XB + t * 72 + 16 * cq) = o0; *(LAS u32x4*)(XB + t * 72 + 16 * cq + 8) = o1;
        }
        if (u + G < NU) RNN_LOAD_XR(u + G);
        if (fin) { PF[wid * 64 + lane] = Ap; PF[512 + wid * 64 + lane] = Hp; }
        __syncthreads();
        {
            f32x16 aR, aI;
#pragma unroll
            for (int i = 0; i < 16; ++i) { aR[i] = 0.f; aI[i] = 0.f; }
#pragma unroll
            for (int s = 0; s < 4; ++s) {
                const bf16x8 af = *(const LAS bf16x8*)(XB + (32 * tt + l32) * 72 + 16 * s + 8 * hl);
                const bf16x8 bR = *(const LAS bf16x8*)(WL + (32 * nt + l32) * 72 + 16 * s + 8 * hl);
                const bf16x8 bI = *(const LAS bf16x8*)(WL + 64 * 72 + (32 * nt + l32) * 72 + 16 * s + 8 * hl);
                aR = MFMA32(af, bR, aR); aI = MFMA32(af, bI, aI);
            }
            const int ch = 32 * nt + l32;
            float At = 1.f, Ht = 0.f;
#pragma unroll
            for (int g = 0; g < 4; ++g) {
                float A = 1.f, H = 0.f;
#pragma unroll
                for (int q4 = 0; q4 < 4; ++q4) { const int i = 4 * g + q4, tok = 32 * tt + 8 * g + 4 * hl + q4;
                    const float r = sigm(aR[i] + bac), ig = sigm(aI[i] + bic);
                    const float a = __builtin_amdgcn_exp2f(k8c * r);
                    const float uu_ = __builtin_amdgcn_sqrtf(fmaxf(1.0f - a * a, 0.f)) * ig * XC[tok * 64 + ch];
                    { const h2_t pv = {(_Float16)(1.0f - a), (_Float16)uu_}; au[(rowbase + tok) * D + ch0 + ch] = __builtin_bit_cast(unsigned, pv); }
                    H = a * H + uu_; A *= a; }
                const float pA = __shfl_xor(A, 32), pH = __shfl_xor(H, 32);
                const float fA = hl ? pA : A, fH = hl ? pH : H, sA = hl ? A : pA, sH = hl ? H : pH;
                Ht = fA * Ht + fH; At *= fA; Ht = sA * Ht + sH; At *= sA;
            }
            if (hl == 0) { SG[tt * 64 + ch] = At; SG[256 + tt * 64 + ch] = Ht; }
            __syncthreads();
            if (tt == 3 && hl == 0) { float Ac = 1.f, Hc = 0.f;
#pragma unroll
                for (int s = 0; s < 4; ++s) { const float sa = SG[s * 64 + ch]; Hc = sa * Hc + SG[256 + s * 64 + ch]; Ac *= sa; }
                sums[((size_t)b * NCH + c) * D + ch0 + ch] = (f32x2){Ac, Hc}; }
        }
    }
#undef RNN_LOAD_XR
}

DI void pool_item(const bf16_t* P, bf16_t* pooled, int idx) {
    const int cg8 = idx & 127, run = idx >> 7; const size_t row0 = (size_t)run * 8; const int t0 = (int)(row0 & (SEQ - 1));
    const int ch = cg8 * 8, w = 2 << (ch >> 8);
    const bf16_t* src = P + PC_P + ch;
    float sum[8];
#pragma unroll
    for (int j = 0; j < 8; ++j) sum[j] = 0.f;
    for (int k = 1; k < w; ++k) if (t0 - k >= 0) { const u32x4 x = *(const u32x4*)(src + (row0 - k) * DIN);
        sum[0] += bflo(x.x); sum[1] += bfhi(x.x); sum[2] += bflo(x.y); sum[3] += bfhi(x.y); sum[4] += bflo(x.z); sum[5] += bfhi(x.z); sum[6] += bflo(x.w); sum[7] += bfhi(x.w); }
#pragma unroll
    for (int j = 0; j < 8; ++j) {
        const int t = t0 + j; const u32x4 x = *(const u32x4*)(src + (row0 + j) * DIN);
        const float cur[8] = {bflo(x.x), bfhi(x.x), bflo(x.y), bfhi(x.y), bflo(x.z), bfhi(x.z), bflo(x.w), bfhi(x.w)};
#pragma unroll
        for (int e = 0; e < 8; ++e) sum[e] += cur[e];
        const float ic = __builtin_amdgcn_rcpf((float)(t + 1 < w ? t + 1 : w));
        u32x4 o; o.x = pk2(sum[0] * ic - cur[0], sum[1] * ic - cur[1]); o.y = pk2(sum[2] * ic - cur[2], sum[3] * ic - cur[3]);
        o.z = pk2(sum[4] * ic - cur[4], sum[5] * ic - cur[5]); o.w = pk2(sum[6] * ic - cur[6], sum[7] * ic - cur[7]);
        *(u32x4*)(pooled + (row0 + j) * D + ch) = o;
        if (t - w + 1 >= 0) { const u32x4 y = *(const u32x4*)(src + (row0 + j - w + 1) * DIN);
            sum[0] -= bflo(y.x); sum[1] -= bfhi(y.x); sum[2] -= bflo(y.y); sum[3] -= bfhi(y.y); sum[4] -= bflo(y.z); sum[5] -= bfhi(y.z); sum[6] -= bflo(y.w); sum[7] -= bfhi(y.w); }
    }
}


#define XB_TMO      128
#define XB_XCNT(j)  (256  + 64 * (j))
#define XB_XSUB(j)  (1280 + 64 * (j))
#define XB_XGEN(j)  (2304 + 64 * (j))
#define XB_TOP      3328
#define XB_TOPGEN   3392
#define XCD_BAR_WORDS 3456
#define XB_SPIN_CAP (1u << 22)
DI unsigned xb_ld(unsigned* p)              { return __hip_atomic_load(p, __ATOMIC_RELAXED, __HIP_MEMORY_SCOPE_AGENT); }
DI unsigned xb_add(unsigned* p, unsigned v) { return __hip_atomic_fetch_add(p, v, __ATOMIC_RELAXED, __HIP_MEMORY_SCOPE_AGENT); }
DI unsigned xb_xcc_id() { return (unsigned)__builtin_amdgcn_s_getreg((3 << 11) | 20) & 0xFu; }
#define XB_SPIN(cond, bar) do { unsigned _sp = 0; while (cond) { __builtin_amdgcn_s_sleep(1); \
    if ((++_sp & 255u) == 0u) { if (xb_ld(&(bar)[XB_TMO])) break; if (_sp > XB_SPIN_CAP) { atomicAdd(&(bar)[XB_TMO], 1u); break; } } } } while (0)
struct XcdBarrier { unsigned* bar; unsigned x; volatile LAS unsigned* st; unsigned n; };
DI XcdBarrier xcd_barrier_post(unsigned* bar, volatile LAS unsigned* st, unsigned n) {
    XcdBarrier b; b.bar = bar; b.x = xb_xcc_id(); b.st = st; b.n = n;
    if (threadIdx.x == 0) (void)xb_add(&bar[XB_XCNT(b.x)], 1u);
    return b;
}
DI void xcd_barrier_complete(unsigned* bar, unsigned x, unsigned G, unsigned& nloc, unsigned& nx) {
    unsigned sum, cnt, mine, sp = 0u;
    for (;;) {
        sum = 0u; cnt = 0u; mine = 0u;
#pragma unroll
        for (unsigned j = 0; j < 16; ++j) { const unsigned c = xb_ld(&bar[XB_XCNT(j)]); sum += c; cnt += (c > 0u) ? 1u : 0u; mine = (j == x) ? c : mine; }
        if (sum == G) break;
        __builtin_amdgcn_s_sleep(1);
        if ((++sp & 255u) == 0u) { if (xb_ld(&bar[XB_TMO])) break; if (sp > XB_SPIN_CAP) { atomicAdd(&bar[XB_TMO], 1u); break; } }
    }
    nloc = mine > 0u ? mine : 1u; nx = cnt > 0u ? cnt : 1u;
}
DI void xcd_barrier(const XcdBarrier& b) {
    asm volatile("s_waitcnt vmcnt(0)" ::: "memory");
    __syncthreads();
    if (threadIdx.x == 0) {
        unsigned* bar = b.bar;
        __builtin_amdgcn_s_waitcnt(0);
        unsigned nloc = b.st[0], nx = b.st[1];
        if (nloc == 0u) { xcd_barrier_complete(bar, b.x, b.n, nloc, nx); b.st[0] = nloc; b.st[1] = nx; }
        const unsigned old = xb_add(&bar[XB_XSUB(b.x)], 1u);
        const unsigned gen = old / nloc;
        if (old + 1u == (gen + 1u) * nloc) {
            __builtin_amdgcn_fence(__ATOMIC_RELEASE, "agent");
            asm volatile("s_waitcnt vmcnt(0)" ::: "memory");
            const unsigned og = xb_add(&bar[XB_TOP], 1u);
            const unsigned tg = og / nx;
            if (og + 1u == (tg + 1u) * nx) xb_add(&bar[XB_TOPGEN], 1u);
            else XB_SPIN(xb_ld(&bar[XB_TOPGEN]) == tg, bar);
            __builtin_amdgcn_fence(__ATOMIC_ACQUIRE, "agent");
            xb_add(&bar[XB_XGEN(b.x)], 1u);
            asm volatile("s_waitcnt vmcnt(0)" ::: "memory");
        } else {
            XB_SPIN(xb_ld(&bar[XB_XGEN(b.x)]) == gen, bar);
            __builtin_amdgcn_fence(__ATOMIC_ACQUIRE, "agent");
            asm volatile("s_waitcnt vmcnt(0)" ::: "memory");
        }
    }
    __syncthreads();
}

__global__ void __launch_bounds__(512, 2) mega_fwd(Params p) {
    extern __shared__ __attribute__((aligned(16))) unsigned char lds_raw[];
    LAS unsigned char* lds = (LAS unsigned char*)lds_raw;
    cg::grid_group grid = cg::this_grid();
    const int Gfull = gridDim.x, bfull = blockIdx.x;
    const int half = (bfull & 7) >> 2, bx = (bfull >> 3) * 4 + (bfull & 3), G = Gfull >> 1, NGW = G * 8;
#define TID_LOCAL() int tid_ = threadIdx.x; asm volatile("" : "+v"(tid_)); const int tid = tid_, lane = tid & 63, wid = __builtin_amdgcn_readfirstlane(tid >> 6), gw = bx * 8 + wid; (void)lane; (void)gw; (void)tid
    volatile LAS unsigned* xst = (volatile LAS unsigned*)(lds + 131072 + 512);
    if (threadIdx.x < 2) xst[threadIdx.x] = 0u;
    __syncthreads();
    unsigned* ctl = (unsigned*)(p.ws + WS_CTL);
    XcdBarrier xbar = xcd_barrier_post(ctl + half * 4096, xst, (unsigned)G);
    unsigned* wflag = ctl + 8192 + 64;
    { TID_LOCAL(); const int gwf = bfull * 8 + wid; prologue(p, lds, 0, 1, true, gwf, Gfull * 8, wid, lane); }
    grid.sync();
    if (half == 1) {
        TID_LOCAL(); prologue(p, lds, 1, DEPTH, false, gw, NGW, wid, lane);
        asm volatile("s_waitcnt vmcnt(0)" ::: "memory"); __syncthreads();
        if (tid == 0) { __builtin_amdgcn_fence(__ATOMIC_RELEASE, "agent"); asm volatile("s_waitcnt vmcnt(0)" ::: "memory"); __hip_atomic_fetch_add(wflag, 1u, __ATOMIC_RELAXED, __HIP_MEMORY_SCOPE_AGENT); }
    }
    bool first = true, wready = (half == 1);
#define STEP_SYNC() do { if (!first) xcd_barrier(xbar); first = false; } while (0)
    for (int cj = 0; cj < NCHUNK / 2; ++cj) {
        const int ck = half * (NCHUNK / 2) + cj;
        { STEP_SYNC(); TID_LOCAL(); int ckx = ck; unsigned char* ws = p.ws + (size_t)half * HALF_STRIDE; asm volatile("" : "+s"(ckx), "+s"(ws));
            rowpass(p.in[I_X] + (size_t)ckx * MC * D, nullptr, nullptr, p.in[I_NMIXPRE], p.out + (size_t)ckx * MC * D, (bf16_t*)(ws + WS_HB), gw, NGW, lane); }
        for (int l = 0; l < DEPTH; ++l) {
            if (!wready && l >= 1) {
                if (threadIdx.x == 0) { unsigned sp = 0; while (__hip_atomic_load(wflag, __ATOMIC_RELAXED, __HIP_MEMORY_SCOPE_AGENT) < (unsigned)G) { __builtin_amdgcn_s_sleep(2); if (++sp > (1u << 24)) break; }
                    __builtin_amdgcn_fence(__ATOMIC_ACQUIRE, "agent"); asm volatile("s_waitcnt vmcnt(0)" ::: "memory"); }
                __syncthreads(); wready = true;
            }
            for (int ph = 0; ph < 9; ++ph) {
                STEP_SYNC();
                if (ph == 1) {
                    TID_LOCAL(); int lx = l; unsigned char* ws = p.ws + (size_t)half * HALF_STRIDE; unsigned char* wg = p.ws; asm volatile("" : "+s"(lx), "+s"(ws), "+s"(wg));
                    bf16_t* proj = (bf16_t*)(ws + WS_PROJ);
                    for (int u = bx; u < BPC * 64 * 4; u += G) attn_unit(lds, proj, (const float*)(wg + WS_ROPE), p.in[I_SINKS] + lx * 16, u, tid, wid, lane);
                    for (int idx = bx * 512 + tid; idx < (MC / 8) * 128; idx += G * 512) pool_item(proj, (bf16_t*)(ws + WS_POOLED), idx);
                }
                if (ph == 1 || ph == 2) {
                    TID_LOCAL(); int lx = l; unsigned char* ws = p.ws + (size_t)half * HALF_STRIDE; unsigned char* wg = p.ws; asm volatile("" : "+s"(lx), "+s"(ws), "+s"(wg));
                    const bf16_t* Wl = (const bf16_t*)(wg + WS_W) + (size_t)lx * WO_LAYER;
                    rnn_phase(lds, (bf16_t*)(ws + WS_PROJ), Wl + WO_RA, Wl + WO_RI, p.in[I_CONVW] + (size_t)lx * 4 * D, p.in[I_CONVB] + lx * D, p.in[I_BRGA] + lx * D, p.in[I_BRGI] + lx * D, p.in[I_LAM] + lx * D,
                              (f32x2*)(ws + WS_SUMS), (unsigned*)(wg + WS_AU + (size_t)half * 64 * MiB), ph == 2, bx, G, tid, wid, lane);
                }
                if (ph == 5 || ph == 8) {
                    TID_LOCAL(); int lx = l, ckx = ck; unsigned char* ws = p.ws + (size_t)half * HALF_STRIDE; asm volatile("" : "+s"(lx), "+s"(ckx), "+s"(ws));
                    const float* gpost = (ph == 5 ? p.in[I_NMIXPOST] : p.in[I_NMLPPOST]) + lx * D;
                    const float* gnext = ph == 5 ? p.in[I_NMLPPRE] + lx * D : (lx + 1 < DEPTH ? p.in[I_NMIXPRE] + (lx + 1) * D : nullptr);
                    float* hck = p.out + (size_t)ckx * MC * D;
                    rowpass(lx == 0 && ph == 5 ? p.in[I_X] + (size_t)ckx * MC * D : hck, (const bf16_t*)(ws + WS_PROJ + PROJ_MIX_OFF), gpost, gnext, hck, (bf16_t*)(ws + WS_HB), gw, NGW, lane);
                }
                if (ph == 0 || ph == 2 || ph == 3 || ph == 4 || ph == 6 || ph == 7) {
                    int lx = l; unsigned char* ws = p.ws + (size_t)half * HALF_STRIDE; unsigned char* wg = p.ws; asm volatile("" : "+s"(lx), "+s"(ws), "+s"(wg));
                    pg8::gemm_phase(lds, ph, ws, wg, lx, p.in[I_PSCALE] + lx * D, G, bx, (Gfull & 7) == 0 ? 4 : 1);
                }
            }
        }
    }
}

#ifndef MK_MULTI
#define MK_MULTI 0
#endif
extern "C" void kernel_launch(void* const* d_in, const int* in_sizes, int n_in, void* d_out, int out_size, void* d_ws, size_t ws_size, hipStream_t stream) {
    static int grid = 0;
    if (grid == 0) {
        if (n_in != 22 || ws_size < WS_END) { fprintf(stderr, "kernel_launch: unexpected n_in %d / ws_size %zu (need %zu)\n", n_in, ws_size, (size_t)WS_END); grid = -1; return; }
        int dev = 0, cus = 0, per_cu = 0;
        hipGetDevice(&dev); hipDeviceGetAttribute(&cus, hipDeviceAttributeMultiprocessorCount, dev);
        if (hipFuncSetAttribute((const void*)mega_fwd, hipFuncAttributeMaxDynamicSharedMemorySize, LDS_BYTES) != hipSuccess) { fprintf(stderr, "kernel_launch: hipFuncSetAttribute failed\n"); grid = -1; return; }
        if (hipOccupancyMaxActiveBlocksPerMultiprocessor(&per_cu, (const void*)mega_fwd, 512, LDS_BYTES) != hipSuccess || per_cu < 1) { fprintf(stderr, "kernel_launch: occupancy query gave %d\n", per_cu); per_cu = 1; }
        (void)hipGetLastError();
        grid = (cus * per_cu) & ~7;
        fprintf(stderr, "kernel_launch: grid %d (cus %d x %d)\n", grid, cus, per_cu);
    }
    if (grid < 0) return;
    if (hipMemsetAsync((char*)d_ws + WS_CTL, 0, CTL_ZERO_BYTES, stream) != hipSuccess) { fprintf(stderr, "kernel_launch: memset failed\n"); return; }
    Params p{};
    for (int i = 0; i < 22; ++i) p.in[i] = (const float*)d_in[i];
    p.out = (float*)d_out; p.ws = (unsigned char*)d_ws;
    for (int j = 0; j < 8; ++j) p.inv_freq[j] = (float)pow(500000.0, -(double)j / 8.0);
    p.lo = 0; p.hi = 0; void* args[] = {&p};
    hipError_t e = hipLaunchCooperativeKernel((const void*)mega_fwd, dim3(grid), dim3(512), args, LDS_BYTES, stream);
    if (e != hipSuccess) fprintf(stderr, "cooperative launch failed: %s (grid %d)\n", hipGetErrorString(e), grid);
}
```

```cpp
#include <hip/hip_runtime.h>
#include <hip/hip_cooperative_groups.h>
#include <cstdio>
#include <cstdint>
#include <cmath>
namespace cg = cooperative_groups;

#define LAS __attribute__((address_space(3)))
#define DI __device__ __forceinline__
typedef unsigned short bf16_t;
typedef short bf16x8 __attribute__((ext_vector_type(8)));
typedef short s16x4 __attribute__((ext_vector_type(4)));
typedef float f32x2 __attribute__((ext_vector_type(2)));
typedef float f32x4 __attribute__((ext_vector_type(4)));
typedef float f32x16 __attribute__((ext_vector_type(16)));
typedef unsigned u32x2 __attribute__((ext_vector_type(2)));
typedef unsigned u32x4 __attribute__((ext_vector_type(4)));
typedef __bf16 bf16x2_t __attribute__((ext_vector_type(2)));

constexpr int D = 1024, SEQ = 8192, BATCH = 8, DEPTH = 4, DIN = 7680, DFF = 4096;
constexpr int NCHUNK = 4, BPC = BATCH / NCHUNK, MC = BPC * SEQ;
constexpr int PC_Q = 0, PC_Y = 1024, PC_P = 2048, PC_K = 3072, PC_V = 3328, PC_X = 3584, PC_G = 4608;
constexpr size_t WO_IN = 0, WO_BR = WO_IN + (size_t)DIN * D, WO_OUT = WO_BR + 3ull * D * D, WO_PG = WO_OUT + (size_t)D * D, WO_UP = WO_PG + 4ull * 256 * 256,
                 WO_DN = WO_UP + (size_t)DFF * D, WO_RA = WO_DN + (size_t)DFF * D, WO_RI = WO_RA + 16ull * 64 * 64, WO_LAYER = WO_RI + 16ull * 64 * 64;
constexpr size_t MiB = 1ull << 20;
constexpr size_t WS_ROPE = 0, WS_W = 3 * MiB, WS_SUMS = 163 * MiB, WS_HB = 164 * MiB, WS_POOLED = 196 * MiB, WS_MERGED = 228 * MiB, WS_PROJ = 260 * MiB, HALF_STRIDE = 337 * MiB,
                 WS_CTL = 838 * MiB, WS_AU = 840 * MiB  , WS_END = 968 * MiB;
constexpr size_t CTL_ZERO_BYTES = 65536;
static_assert(WO_LAYER * 2 * DEPTH <= 160 * MiB, "weights fit");
static_assert((size_t)MC * DIN * 2 == 240 * MiB && WS_PROJ + 240 * MiB <= WS_SUMS + HALF_STRIDE, "proj size");
constexpr size_t PROJ_MIX_OFF = 128 * MiB;
constexpr int LDS_BYTES = 147456;
constexpr float EPS = 1e-6f;
constexpr float LOG2E = 1.4426950408889634f;

DI unsigned pk2(float lo, float hi) { f32x2 v = {lo, hi}; bf16x2_t b = __builtin_convertvector(v, bf16x2_t); return __builtin_bit_cast(unsigned, b); }
DI float bflo(unsigned u) { return __uint_as_float(u << 16); }
DI float bfhi(unsigned u) { return __uint_as_float(u & 0xffff0000u); }
DI float bf1(bf16_t u) { return __uint_as_float(((unsigned)u) << 16); }
DI float wave_sum(float v) {
#pragma unroll
    for (int o = 1; o < 64; o <<= 1) v += __shfl_xor(v, o);
    return v;
}
DI float sigm(float x) { return __builtin_amdgcn_rcpf(1.0f + __builtin_amdgcn_exp2f(-x * LOG2E)); }
DI float gelu_tanh(float y) { const float z = 0.7978845608028654f * (y + 0.044715f * y * y * y); const float t = 1.0f - 2.0f * __builtin_amdgcn_rcpf(1.0f + __builtin_amdgcn_exp2f(2.0f * LOG2E * z)); return 0.5f * y * (1.0f + t); }
#define MFMA32(a, b, c) __builtin_amdgcn_mfma_f32_32x32x16_bf16((a), (b), (c), 0, 0, 0)

namespace pg8 {
constexpr int BM = 256, BK = 64, HALF = 128, HTB = HALF * BK * 2, STAGE_BYTES = 8 * HTB, NXCD = 8, WGM = 8;
__host__ __device__ __forceinline__ int lds_byte(int r, int c) { const int st = (r >> 4) * 2 + (c >> 5), rr = r & 15, cc = c & 31, ob = rr * 64 + cc * 2; return st * 1024 + (ob ^ (((ob >> 9) & 1) << 5)); }
__host__ __device__ __forceinline__ void stage_rc(int b, int& R, int& C) { const int st = b / 1024, sb = b % 1024, swz = sb ^ (((sb >> 9) & 1) << 5); R = (st >> 1) * 16 + swz / 64; C = (st & 1) * 32 + (swz % 64) / 2; }
__host__ __device__ __forceinline__ int perm32(int rho) { const int n = rho >> 4, i = rho & 15; return 8 * (i >> 2) + 4 * n + (i & 3); }

struct Unit { int pm, pn, z; };
enum { EP_BF16 = 0, EP_RELU2 = 1, EP_SCALE = 2, EP_MERGE = 4 };
struct Cfg { const bf16_t* A; const bf16_t* Bt; int lda, ldb, K, N, lz, zA, zB, pnA; };
DI Cfg gemm_cfg(int ph, unsigned char* ws, unsigned char* wg, int l) {
    const bf16_t* Wl = (const bf16_t*)(wg + WS_W) + (size_t)l * WO_LAYER; const bf16_t* proj = (const bf16_t*)(ws + WS_PROJ);
    Cfg c; c.zA = 0; c.zB = 0; c.pnA = 0; c.lda = D; c.ldb = D; c.K = D; c.N = D; c.lz = 4;
    if (ph == 0) { c.A = (const bf16_t*)(ws + WS_HB); c.Bt = Wl + WO_IN; c.N = DIN; }
    else if (ph == 2) { c.A = (const bf16_t*)(ws + WS_POOLED); c.pnA = 256; c.Bt = Wl + WO_PG; c.K = 256; c.ldb = 256; c.lz = 2; }
    else if (ph == 3) { c.A = proj + PC_Q; c.lda = DIN; c.zA = D; c.Bt = Wl + WO_BR; c.zB = D * D; c.K = 3 * D; }
    else if (ph == 4) { c.A = (const bf16_t*)(ws + WS_MERGED); c.Bt = Wl + WO_OUT; }
    else if (ph == 6) { c.A = (const bf16_t*)(ws + WS_HB); c.Bt = Wl + WO_UP; c.N = DFF; }
    else { c.A = proj; c.lda = DFF; c.Bt = Wl + WO_DN; c.K = DFF; c.ldb = DFF; c.lz = 6; }
    return c;
}
struct Sched {
    int nM, nN, nZ, nwg, G, c, nx;
    DI void init(int M, int N, int nZ_, int G_, int c_, int nx_) { nM = M / BM; nN = N / BM; nZ = nZ_; nwg = nM * nN; G = G_; c = c_; nx = nx_; }
    DI bool next(int i, Unit& u) const {
        const int t = i; u.z = 0;
        const long L = (long)t * G + c; if (L >= nwg) return false;
        int wgid = (int)L; { const int q = nwg / nx, r = nwg % nx, xcd = wgid % nx, off = wgid / nx; wgid = (xcd < r ? xcd * (q + 1) : r * (q + 1) + (xcd - r) * q) + off; }
        const int nig = WGM * nN, gid = wgid / nig, fm = gid * WGM, gsz = (nM - fm) < WGM ? (nM - fm) : WGM;
        u.pm = fm + ((wgid % nig) % gsz); u.pn = (wgid % nig) / gsz; return true;
    }
};

DI unsigned ror8(unsigned x) { return (unsigned)__builtin_amdgcn_mov_dpp((int)x, 0x128, 0xf, 0xf, true); }
DI void store_lines(bf16_t* Ob, size_t row, int ldc, int colw, int fr, int fq, const u32x4& w0, const u32x4& w1) {
    const bool lo = (fr & 8) == 0;
    const u32x4 snd = lo ? w1 : w0;
    u32x4 rcv; rcv.x = ror8(snd.x); rcv.y = ror8(snd.y); rcv.z = ror8(snd.z); rcv.w = ror8(snd.w);
    const u32x4 dA = lo ? w0 : rcv, dB = lo ? rcv : w1;
    const int col = colw + 8 * fq + (lo ? 0 : 32);
    __builtin_nontemporal_store(dA, (u32x4*)(Ob + (lo ? row : row - 8) * ldc + col));
    __builtin_nontemporal_store(dB, (u32x4*)(Ob + (lo ? row + 8 : row) * ldc + col));
}
DI void epilogue(const f32x4 (&acc)[2][2][4][2], int ph, unsigned char* ws, const float* pscale, const Unit& u, int wr, int wc, int fr, int fq) {
    const int row0 = u.pm * BM + wr * 64 + fr, colw = u.pn * BM + wc * 64, col0 = colw + 8 * fq;
    const int mode = (ph == 0 || ph == 4 || ph == 7) ? EP_BF16 : ph == 2 ? EP_SCALE : ph == 3 ? EP_MERGE : EP_RELU2;
    bf16_t* Ob = ph == 3 ? (bf16_t*)(ws + WS_MERGED) : (ph == 4 || ph == 7) ? (bf16_t*)(ws + WS_PROJ + PROJ_MIX_OFF) : (bf16_t*)(ws + WS_PROJ) + (ph == 2 ? PC_P : 0);
    const int ldc = (ph == 0 || ph == 2) ? DIN : (ph == 6 ? DFF : D);
    if (mode == EP_BF16 || mode == EP_RELU2) {
        const bool r2 = mode == EP_RELU2; const bool gateD = (ph == 0) && (u.pn * BM >= PC_G);
#pragma unroll
        for (int ai = 0; ai < 2; ++ai)
#pragma unroll
            for (int m = 0; m < 4; ++m) { u32x4 w[2];
#pragma unroll
                for (int bj = 0; bj < 2; ++bj) { f32x4 v0 = acc[ai][bj][m][0], v1 = acc[ai][bj][m][1];
                    if (gateD) {
#pragma unroll
                        for (int j = 0; j < 4; ++j) { v0[j] = 1.0f + __builtin_amdgcn_exp2f(-fmaxf(v0[j], -30.f) * LOG2E); v1[j] = 1.0f + __builtin_amdgcn_exp2f(-fmaxf(v1[j], -30.f) * LOG2E); } }
                    if (r2) {
#pragma unroll
                        for (int j = 0; j < 4; ++j) { const float a = fmaxf(v0[j], 0.f), b = fmaxf(v1[j], 0.f); v0[j] = a * a; v1[j] = b * b; } }
                    w[bj].x = pk2(v0[0], v0[1]); w[bj].y = pk2(v0[2], v0[3]); w[bj].z = pk2(v1[0], v1[1]); w[bj].w = pk2(v1[2], v1[3]); }
                store_lines(Ob, (size_t)(row0 + ai * HALF + m * 16), ldc, colw, fr, fq, w[0], w[1]); }
    } else if (mode == EP_SCALE) {
        f32x4 sc[2][2];
#pragma unroll
        for (int bj = 0; bj < 2; ++bj)
#pragma unroll
            for (int n = 0; n < 2; ++n) sc[bj][n] = *(const f32x4*)(pscale + col0 + bj * 32 + 4 * n);
#pragma unroll
        for (int ai = 0; ai < 2; ++ai)
#pragma unroll
            for (int m = 0; m < 4; ++m) { u32x4 w[2];
#pragma unroll
                for (int bj = 0; bj < 2; ++bj) { const f32x4 v0 = acc[ai][bj][m][0] * sc[bj][0], v1 = acc[ai][bj][m][1] * sc[bj][1];
                    w[bj].x = pk2(v0[0], v0[1]); w[bj].y = pk2(v0[2], v0[3]); w[bj].z = pk2(v1[0], v1[1]); w[bj].w = pk2(v1[2], v1[3]); }
                store_lines(Ob, (size_t)(row0 + ai * HALF + m * 16), ldc, colw, fr, fq, w[0], w[1]); }
    } else {
        const bf16_t* gate = (const bf16_t*)(ws + WS_PROJ) + PC_G + 2 * D;
#pragma unroll
        for (int ai = 0; ai < 2; ++ai)
#pragma unroll
            for (int m = 0; m < 4; ++m) { const size_t row = (size_t)(row0 + ai * HALF + m * 16); u32x4 w[2];
#pragma unroll
                for (int bj = 0; bj < 2; ++bj) { const int col = col0 + bj * 32;
                    const u32x4 gw = *(const u32x4*)(gate + row * DIN + col);
                    const float ga[8] = {bflo(gw.x), bfhi(gw.x), bflo(gw.y), bfhi(gw.y), bflo(gw.z), bfhi(gw.z), bflo(gw.w), bfhi(gw.w)};
                    float f[8];
#pragma unroll
                    for (int j = 0; j < 8; ++j) f[j] = __builtin_amdgcn_rcpf(ga[j]);
                    const f32x4 v0 = acc[ai][bj][m][0] * (f32x4){f[0], f[1], f[2], f[3]}, v1 = acc[ai][bj][m][1] * (f32x4){f[4], f[5], f[6], f[7]};
                    w[bj].x = pk2(v0[0], v0[1]); w[bj].y = pk2(v0[2], v0[3]); w[bj].z = pk2(v1[0], v1[1]); w[bj].w = pk2(v1[2], v1[3]); }
                store_lines(Ob, row, ldc, colw, fr, fq, w[0], w[1]);
                asm volatile("" ::: "memory"); }
    }
}
DI void merge_carry(f32x4 (&acc)[2][2][4][2], unsigned char* ws, const Unit& u, int z, int wr, int wc, int fr, int fq) {
    const int row0 = u.pm * BM + wr * 64 + fr, col0 = u.pn * BM + wc * 64 + 8 * fq;
    const bf16_t* gate = (const bf16_t*)(ws + WS_PROJ) + PC_G + (size_t)z * D;
#pragma unroll
    for (int ai = 0; ai < 2; ++ai)
#pragma unroll
        for (int m = 0; m < 4; ++m) { const size_t row = (size_t)(row0 + ai * HALF + m * 16);
#pragma unroll
            for (int bj = 0; bj < 2; ++bj) { const int col = col0 + bj * 32;
                const u32x4 gw = *(const u32x4*)(gate + row * DIN + col), hw = *(const u32x4*)(gate + row * DIN + D + col);
                const float ga[8] = {bflo(gw.x), bfhi(gw.x), bflo(gw.y), bfhi(gw.y), bflo(gw.z), bfhi(gw.z), bflo(gw.w), bfhi(gw.w)};
                const float gb[8] = {bflo(hw.x), bfhi(hw.x), bflo(hw.y), bfhi(hw.y), bflo(hw.z), bfhi(hw.z), bflo(hw.w), bfhi(hw.w)};
                float f[8];
#pragma unroll
                for (int j = 0; j < 8; ++j) f[j] = gb[j] * __builtin_amdgcn_rcpf(ga[j]);
                acc[ai][bj][m][0] = acc[ai][bj][m][0] * (f32x4){f[0], f[1], f[2], f[3]}; acc[ai][bj][m][1] = acc[ai][bj][m][1] * (f32x4){f[4], f[5], f[6], f[7]};
                asm volatile("" ::: "memory"); } }
}

DI void gemm_phase(LAS unsigned char* lds, int ph, unsigned char* ws, unsigned char* wg, int l, const float* pscale, int G, int cidx, int nx) {
    int tid_ = threadIdx.x; asm volatile("" : "+v"(tid_));
    const int tid = tid_, wid = __builtin_amdgcn_readfirstlane(tid >> 6), lane = tid & 63, wr = wid >> 2, wc = wid & 3, fr = lane & 15, fq = lane >> 4;
    const Cfg g0 = gemm_cfg(ph, ws, wg, l);
    const int nt = g0.K / BK, lda = g0.lda, ldb = g0.ldb, lz = g0.lz, ntzm = (1 << g0.lz) - 1;
    const size_t zAb = (size_t)g0.zA * 2, zBb = (size_t)g0.zB * 2;
    Sched S; S.init(MC, g0.N, 1, G, cidx, nx);
    unsigned voffA[2], voffB[2];
#pragma unroll
    for (int i = 0; i < 2; ++i) { int R, C; stage_rc(tid * 16 + i * 8192, R, C); const int Rb = (R >> 5) * 64 + perm32(R & 31);
        voffA[i] = (unsigned)(R * lda + C) * 2u; voffB[i] = (unsigned)(Rb * ldb + C) * 2u; }
    const size_t kstep = (size_t)(BK * 2);
    const size_t hstepA = (size_t)HALF * lda * 2, hstepB = (size_t)32 * ldb * 2;
    const unsigned ldsw = (unsigned)wid * 1024u;
    const int aoff = lds_byte(wr * 64 + fr, fq * 8), boff = lds_byte(wc * 32 + fr, fq * 8);
#define PG8_SA(b, h) (((b) * 2 + (h)) * HTB)
#define PG8_SB(b, h) ((4 + (b) * 2 + (h)) * HTB)
#define PG8_STAGE(bufoff, gbase, voff) do { _Pragma("unroll") for (int _i = 0; _i < 2; ++_i) \
        __builtin_amdgcn_global_load_lds((const unsigned*)((const char*)(gbase) + (voff)[_i]), (LAS unsigned*)(lds + (bufoff) + ldsw + _i * 8192), 16, 0, 0); } while (0)
#define PG8_LDA(dst, b, h) do { _Pragma("unroll") for (int m = 0; m < 4; ++m) _Pragma("unroll") for (int k = 0; k < 2; ++k) dst[m][k] = *(const LAS bf16x8*)(lds + PG8_SA(b, h) + aoff + m * 2048 + k * 1024); } while (0)
#define PG8_LDB(dst, b, h) do { _Pragma("unroll") for (int n = 0; n < 2; ++n) _Pragma("unroll") for (int k = 0; k < 2; ++k) dst[n][k] = *(const LAS bf16x8*)(lds + PG8_SB(b, h) + boff + n * 2048 + k * 1024); } while (0)
#define PG8_MMA(ai, bj, At, Bt) do { __builtin_amdgcn_s_setprio(1); _Pragma("unroll") for (int m = 0; m < 4; ++m) _Pragma("unroll") for (int n = 0; n < 2; ++n) _Pragma("unroll") for (int k = 0; k < 2; ++k) \
        acc[ai][bj][m][n] = __builtin_amdgcn_mfma_f32_16x16x32_bf16(Bt[n][k], At[m][k], acc[ai][bj][m][n], 0, 0, 0); __builtin_amdgcn_s_setprio(0); } while (0)
#define PG8_WAIT_V(n) asm volatile("s_waitcnt vmcnt(" #n ")" ::: "memory")
#define PG8_WAIT_L(n) asm volatile("s_waitcnt lgkmcnt(" #n ")" ::: "memory")
#define PG8_BAR __builtin_amdgcn_s_barrier()
#define PG8_SCHED __builtin_amdgcn_sched_barrier(0)
#define PG8_ABASE(u) ((const char*)gx.A + (size_t)(u).pm * tstepA + (size_t)(u).pn * gx.pnA * 2)
#define PG8_BBASE(u) ((const char*)gx.Bt + (size_t)(u).pn * tstepB)
#define PG8_KA(t_) (cA + (size_t)((t_) >> lz) * zAb + (size_t)((t_) & ntzm) * kstep)
#define PG8_KB(t_) (cB + (size_t)((t_) >> lz) * zBb + (size_t)((t_) & ntzm) * kstep)
#define PG8_RECFG() int phx = ph; int lx = l; unsigned char* wsx = ws; unsigned char* wgx = wg; asm volatile("" : "+s"(phx), "+s"(lx), "+s"(wsx), "+s"(wgx)); const Cfg gx = gemm_cfg(phx, wsx, wgx, lx); \
        const size_t tstepA = (size_t)BM * gx.lda * 2, tstepB = (size_t)BM * gx.ldb * 2
    Unit cur, nxt; int ui = 0;
    if (!S.next(0, cur)) return;
    f32x4 acc[2][2][4][2];
#pragma unroll
    for (int a = 0; a < 2; ++a)
#pragma unroll
        for (int b = 0; b < 2; ++b)
#pragma unroll
            for (int m = 0; m < 4; ++m)
#pragma unroll
                for (int n = 0; n < 2; ++n) acc[a][b][m][n] = (f32x4){0.f, 0.f, 0.f, 0.f};
    bf16x8 At[4][2], B0[2][2], B1[2][2];
    const char* cA; const char* cB; { PG8_RECFG(); cA = PG8_ABASE(cur); cB = PG8_BBASE(cur); }
    PG8_STAGE(PG8_SB(0, 0), cB, voffB); PG8_STAGE(PG8_SB(0, 1), cB + hstepB, voffB); PG8_STAGE(PG8_SA(0, 0), cA, voffA); PG8_STAGE(PG8_SA(0, 1), cA + hstepA, voffA);
    if (wr == 1) PG8_BAR;
    PG8_WAIT_V(2); PG8_BAR;
    PG8_STAGE(PG8_SB(1, 0), cB + kstep, voffB); PG8_STAGE(PG8_SA(1, 0), cA + kstep, voffA); PG8_STAGE(PG8_SB(1, 1), cB + hstepB + kstep, voffB);
    PG8_WAIT_V(6); PG8_BAR;
    for (;;) {
        const bool has_next = S.next(ui + 1, nxt);
        const char* nA = cA; const char* nB = cB; if (has_next) { PG8_RECFG(); nA = PG8_ABASE(nxt); nB = PG8_BBASE(nxt); }
        for (int t = 0; t < nt; t += 2) {
            const bool last = (t == nt - 2);
            const char* a1 = PG8_KA(t + 1);
            const char* a2 = last ? nA : PG8_KA(t + 2); const char* b2 = last ? nB : PG8_KB(t + 2);
            const char* a3 = a2 + kstep; const char* b3 = b2 + kstep;
            if (zAb != 0 && t != 0 && (t & ntzm) == 0) { unsigned char* wsx = ws; asm volatile("" : "+s"(wsx)); int frx = fr; asm volatile("" : "+v"(frx)); merge_carry(acc, wsx, cur, (t >> lz) - 1, wr, wc, frx, fq); }
            PG8_LDB(B0, 0, 0); PG8_LDB(B1, 0, 1); PG8_SCHED; PG8_LDA(At, 0, 0); PG8_STAGE(PG8_SA(1, 1), a1 + hstepA, voffA);
            PG8_WAIT_V(8); PG8_WAIT_L(0); PG8_BAR; PG8_MMA(0, 0, At, B0); PG8_MMA(0, 1, At, B1); PG8_BAR; PG8_SCHED;
            PG8_LDA(At, 0, 1); PG8_STAGE(PG8_SB(0, 0), b2, voffB); PG8_STAGE(PG8_SB(0, 1), b2 + hstepB, voffB); PG8_STAGE(PG8_SA(0, 0), a2, voffA);
            PG8_WAIT_V(8); PG8_WAIT_L(0); PG8_BAR; PG8_MMA(1, 0, At, B0); PG8_MMA(1, 1, At, B1); PG8_BAR; PG8_SCHED;
            PG8_LDB(B0, 1, 0); PG8_LDB(B1, 1, 1); PG8_SCHED; PG8_LDA(At, 1, 0); PG8_STAGE(PG8_SA(0, 1), a2 + hstepA, voffA);
            PG8_WAIT_V(8); PG8_WAIT_L(0); PG8_BAR; PG8_MMA(0, 0, At, B0); PG8_MMA(0, 1, At, B1); PG8_BAR; PG8_SCHED;
            PG8_LDA(At, 1, 1); PG8_STAGE(PG8_SB(1, 0), b3, voffB); PG8_STAGE(PG8_SB(1, 1), b3 + hstepB, voffB); PG8_STAGE(PG8_SA(1, 0), a3, voffA);
            PG8_WAIT_V(8); PG8_WAIT_L(0); PG8_BAR; PG8_MMA(1, 0, At, B0); PG8_MMA(1, 1, At, B1); PG8_BAR; PG8_SCHED;
        }
        if (wr == 0) PG8_BAR;
        { int phx = ph; unsigned char* wsx = ws; asm volatile("" : "+s"(phx), "+s"(wsx)); int frx = fr; asm volatile("" : "+v"(frx)); epilogue(acc, phx, wsx, pscale, cur, wr, wc, frx, fq); }
        if (!has_next) break;
#pragma unroll
        for (int a = 0; a < 2; ++a)
#pragma unroll
            for (int b = 0; b < 2; ++b)
#pragma unroll
                for (int m = 0; m < 4; ++m)
#pragma unroll
                    for (int n = 0; n < 2; ++n) acc[a][b][m][n] = (f32x4){0.f, 0.f, 0.f, 0.f};
        cur = nxt; cA = nA; cB = nB; ++ui;
        if (wr == 1) PG8_BAR;
    }
    PG8_WAIT_V(0);
    PG8_BAR;
#undef PG8_SA
#undef PG8_SB
#undef PG8_STAGE
#undef PG8_LDA
#undef PG8_LDB
#undef PG8_MMA
#undef PG8_WAIT_V
#undef PG8_WAIT_L
#undef PG8_BAR
#undef PG8_SCHED
#undef PG8_ABASE
#undef PG8_BBASE
#undef PG8_RECFG
#undef PG8_KA
#undef PG8_KB
}
}

DI void transpose_item(const float* W, int K, int N, bf16_t* WT, int drow0, LAS float* scr, int k0, int n0, int lane) {
#pragma unroll 8
    for (int i = 0; i < 32; ++i) { const int kk = 2 * i + (lane >> 5); scr[kk * 33 + (lane & 31)] = W[(size_t)(k0 + kk) * N + n0 + (lane & 31)]; }
    asm volatile("s_waitcnt lgkmcnt(0)" ::: "memory");
    const int c = lane & 7;
#pragma unroll
    for (int j = 0; j < 4; ++j) { const int n = (lane >> 3) + 8 * j; const LAS float* s = scr + (8 * c) * 33 + n;
        u32x4 o; o.x = pk2(s[0 * 33], s[1 * 33]); o.y = pk2(s[2 * 33], s[3 * 33]); o.z = pk2(s[4 * 33], s[5 * 33]); o.w = pk2(s[6 * 33], s[7 * 33]);
        *(u32x4*)(WT + (size_t)(drow0 + n) * K + k0 + 8 * c) = o; }
    asm volatile("s_waitcnt lgkmcnt(0)" ::: "memory");
}
DI int win_perm(int n) {
    if (n < 1024) return PC_Q + n;
    if (n < 1280) return PC_K + (n - 1024);
    if (n < 1536) return PC_V + (n - 1280);
    if (n < 2560) return PC_X + (n - 1536);
    if (n < 3584) return PC_Y + (n - 2560);
    if (n < 4608) return PC_P + (n - 3584);
    return n;
}

struct Params {
    const float* in[22]; float* out; unsigned char* ws; float inv_freq[8]; int lo, hi;
};
enum { I_X = 0, I_NMIXPRE, I_NMIXPOST, I_WIN, I_SINKS, I_WATT, I_CONVW, I_CONVB, I_WRGA, I_BRGA, I_WRGI, I_BRGI, I_LAM, I_WRNN, I_WPG, I_PSCALE, I_WPOOL, I_WOUT, I_NMLPPRE, I_NMLPPOST, I_WUP, I_WDN };

DI void prologue(const Params& p, LAS unsigned char* lds, int l_lo, int l_hi, bool do_rope, int gw, int NGW, int wave, int lane) {
    LAS float* scr = (LAS float*)(lds + wave * 16384);
    bf16_t* Wall = (bf16_t*)(p.ws + WS_W);
    constexpr int IT_IN = 16 * 240, IT_SQ = 512, IT_PG = 128, IT_UP = 2048, IT_DN = 2048, IT_RG = 32;
    constexpr int IT_LAYER = IT_IN + 4 * IT_SQ + IT_PG + IT_UP + IT_DN + 2 * IT_RG;
    for (int it = l_lo * IT_LAYER + gw; it < IT_LAYER * l_hi; it += NGW) {
        const int l = it / IT_LAYER; int r = it - l * IT_LAYER; bf16_t* Wl = Wall + (size_t)l * WO_LAYER;
        if (r < IT_IN) { const int kb = r / 240, nb = r % 240; transpose_item(p.in[I_WIN] + (size_t)l * D * DIN, D, DIN, Wl + WO_IN, win_perm(nb * 32), scr, kb * 64, nb * 32, lane); continue; } r -= IT_IN;
        if (r < 4 * IT_SQ) { const int which = r / IT_SQ; r -= which * IT_SQ; const int kb = r / 32, nb = r % 32;
            const float* src = (which == 0 ? p.in[I_WATT] : which == 1 ? p.in[I_WRNN] : which == 2 ? p.in[I_WPOOL] : p.in[I_WOUT]) + (size_t)l * D * D;
            bf16_t* dst = which < 3 ? Wl + WO_BR + (size_t)which * D * D : Wl + WO_OUT;
            transpose_item(src, D, D, dst, nb * 32, scr, kb * 64, nb * 32, lane); continue; } r -= 4 * IT_SQ;
        if (r < IT_PG) { const int gq = r / 32; r -= gq * 32; const int kb = r / 8, nb = r % 8;
            transpose_item(p.in[I_WPG] + ((size_t)l * 4 + gq) * 65536, 256, 256, Wl + WO_PG, gq * 256 + nb * 32, scr, kb * 64, nb * 32, lane); continue; } r -= IT_PG;
        if (r < IT_UP) { const int kb = r / 128, nb = r % 128; transpose_item(p.in[I_WUP] + (size_t)l * D * DFF, D, DFF, Wl + WO_UP, nb * 32, scr, kb * 64, nb * 32, lane); continue; } r -= IT_UP;
        if (r < IT_DN) { const int kb = r / 32, nb = r % 32; transpose_item(p.in[I_WDN] + (size_t)l * DFF * D, DFF, D, Wl + WO_DN, nb * 32, scr, kb * 64, nb * 32, lane); continue; } r -= IT_DN;
        { const int which = r / IT_RG; r -= which * IT_RG; const int hb = r / 2, nb = r % 2;
          transpose_item((which ? p.in[I_WRGI] : p.in[I_WRGA]) + ((size_t)l * 16 + hb) * 4096, 64, 64, Wl + (which ? WO_RI : WO_RA), hb * 64 + nb * 32, scr, 0, nb * 32, lane); }
    }
    float* rope = (float*)(p.ws + WS_ROPE);
    if (do_rope) for (int i = gw * 64 + lane; i < SEQ * 8; i += NGW * 64) {
        const int pos = i >> 3, j = i & 7;
        const float ang = (float)pos * p.inv_freq[j];
        const double a = (double)ang * 0.15915494309189535; const double n = __builtin_rint(a); const float fr = (float)(a - n);
        rope[pos * 16 + j] = __builtin_amdgcn_cosf(fr); rope[pos * 16 + 8 + j] = __builtin_amdgcn_sinf(fr);
    }
}

DI void rowpass(const float* hsrc, const bf16_t* mix, const float* gpost, const float* gnext, float* hdst, bf16_t* hb, int gw, int NGW, int lane) {
    for (int m0 = gw * 2; m0 < MC; m0 += NGW * 2) {
        f32x4 hv[2][4], mv[2][4];
#pragma unroll
        for (int r = 0; r < 2; ++r)
#pragma unroll
            for (int j = 0; j < 4; ++j) hv[r][j] = __builtin_nontemporal_load((const f32x4*)(hsrc + (size_t)(m0 + r) * D + 256 * j + 4 * lane));
        if (mix) {
#pragma unroll
            for (int r = 0; r < 2; ++r)
#pragma unroll
                for (int j = 0; j < 4; ++j) { const u32x2 w = __builtin_nontemporal_load((const u32x2*)(mix + (size_t)(m0 + r) * D + 256 * j + 4 * lane)); mv[r][j] = (f32x4){bflo(w.x), bfhi(w.x), bflo(w.y), bfhi(w.y)}; }
            float ss[2] = {0.f, 0.f};
#pragma unroll
            for (int r = 0; r < 2; ++r)
#pragma unroll
                for (int j = 0; j < 4; ++j) ss[r] += (mv[r][j].x * mv[r][j].x + mv[r][j].y * mv[r][j].y) + (mv[r][j].z * mv[r][j].z + mv[r][j].w * mv[r][j].w);
#pragma unroll
            for (int o = 1; o < 64; o <<= 1) { ss[0] += __shfl_xor(ss[0], o); ss[1] += __shfl_xor(ss[1], o); }
#pragma unroll
            for (int r = 0; r < 2; ++r) { const float rs = __builtin_amdgcn_rsqf(ss[r] * (1.0f / D) + EPS);
#pragma unroll
                for (int j = 0; j < 4; ++j) { const f32x4 gp = *(const f32x4*)(gpost + 256 * j + 4 * lane); hv[r][j] += mv[r][j] * rs * gp; *(f32x4*)(hdst + (size_t)(m0 + r) * D + 256 * j + 4 * lane) = hv[r][j]; } }
        }
        if (gnext) {
            float ss[2] = {0.f, 0.f};
#pragma unroll
            for (int r = 0; r < 2; ++r)
#pragma unroll
                for (int j = 0; j < 4; ++j) ss[r] += (hv[r][j].x * hv[r][j].x + hv[r][j].y * hv[r][j].y) + (hv[r][j].z * hv[r][j].z + hv[r][j].w * hv[r][j].w);
#pragma unroll
            for (int o = 1; o < 64; o <<= 1) { ss[0] += __shfl_xor(ss[0], o); ss[1] += __shfl_xor(ss[1], o); }
#pragma unroll
            for (int r = 0; r < 2; ++r) { const float rs = __builtin_amdgcn_rsqf(ss[r] * (1.0f / D) + EPS);
#pragma unroll
                for (int j = 0; j < 4; ++j) { const f32x4 gn = *(const f32x4*)(gnext + 256 * j + 4 * lane); const f32x4 o = hv[r][j] * rs * gn;
                    u32x2 w; w.x = pk2(o.x, o.y); w.y = pk2(o.z, o.w); *(u32x2*)(hb + (size_t)(m0 + r) * D + 256 * j + 4 * lane) = w; } }
        }
    }
}

DI void rope8(u32x4& v, const u32x4& pr, const float* tab, bool second) {
    const f32x4 c0 = *(const f32x4*)tab, c1 = *(const f32x4*)(tab + 4), s0 = *(const f32x4*)(tab + 8), s1 = *(const f32x4*)(tab + 12);
    const float sg = second ? 1.f : -1.f;
    float x[8] = {bflo(v.x), bfhi(v.x), bflo(v.y), bfhi(v.y), bflo(v.z), bfhi(v.z), bflo(v.w), bfhi(v.w)};
    const float y[8] = {bflo(pr.x), bfhi(pr.x), bflo(pr.y), bfhi(pr.y), bflo(pr.z), bfhi(pr.z), bflo(pr.w), bfhi(pr.w)};
    const float cs[8] = {c0.x, c0.y, c0.z, c0.w, c1.x, c1.y, c1.z, c1.w}, sn[8] = {s0.x, s0.y, s0.z, s0.w, s1.x, s1.y, s1.z, s1.w};
#pragma unroll
    for (int j = 0; j < 8; ++j) x[j] = x[j] * cs[j] + sg * y[j] * sn[j];
    v.x = pk2(x[0], x[1]); v.y = pk2(x[2], x[3]); v.z = pk2(x[4], x[5]); v.w = pk2(x[6], x[7]);
}
constexpr int KS_LD = 72, VT_LD = 260, ATT_VT_OFF = 256 * KS_LD * 2;
DI void attn_unit(LAS unsigned char* lds, bf16_t* P, const float* rope, const float* sinks, int unit, int tid, int wid, int lane) {
    const int kvh = unit & 3, n = (unit >> 2) & 63, b = unit >> 8;
    const long rowblk = (long)b * SEQ + n * 128;
    LAS bf16_t* Ks = (LAS bf16_t*)lds; LAS bf16_t* Vt = (LAS bf16_t*)(lds + ATT_VT_OFF);
#pragma unroll
    for (int i = 0; i < 4; ++i) {
        const int pc = tid + 512 * i, key = pc >> 3, dg = pc & 7;
        const bool valid = (n > 0) || key >= 128;
        u32x4 kv = {0u, 0u, 0u, 0u}, vv = {0u, 0u, 0u, 0u};
        if (valid) { const bf16_t* src = P + (size_t)(rowblk - 128 + key) * DIN + kvh * 64 + dg * 8; kv = *(const u32x4*)(src + PC_K); vv = *(const u32x4*)(src + PC_V); }
        u32x4 pr; pr.x = __shfl_xor(kv.x, 1); pr.y = __shfl_xor(kv.y, 1); pr.z = __shfl_xor(kv.z, 1); pr.w = __shfl_xor(kv.w, 1);
        if (dg < 2) { const int pos = valid ? (n * 128 - 128 + key) : 0; rope8(kv, pr, rope + pos * 16, dg == 1); }
        *(LAS u32x4*)(Ks + key * KS_LD + dg * 8) = kv;
        const unsigned vw[4] = {vv.x, vv.y, vv.z, vv.w};
#pragma unroll
        for (int j = 0; j < 4; ++j) { Vt[(dg * 8 + 2 * j) * VT_LD + key] = (bf16_t)(vw[j] & 0xffffu); Vt[(dg * 8 + 2 * j + 1) * VT_LD + key] = (bf16_t)(vw[j] >> 16); }
    }
    __syncthreads();
    const int g = wid >> 1, head = kvh * 4 + g, q = lane & 31, hl = lane >> 5;
    const float sinkv = sinks[head] * LOG2E;
    const float cscale = 0.125f * LOG2E;
#pragma unroll 1
    for (int sb = 0; sb < 2; ++sb) {
        const int r0 = 64 * (wid & 1) + 32 * sb;
        bf16_t* qrow = P + (size_t)(rowblk + r0 + q) * DIN + PC_Q + head * 64;
        u32x4 qf[4];
#pragma unroll
        for (int s = 0; s < 4; ++s) qf[s] = *(const u32x4*)(qrow + 16 * s + 8 * hl);
        { u32x4 pr; pr.x = __shfl_xor(qf[0].x, 32); pr.y = __shfl_xor(qf[0].y, 32); pr.z = __shfl_xor(qf[0].z, 32); pr.w = __shfl_xor(qf[0].w, 32);
          rope8(qf[0], pr, rope + (n * 128 + r0 + q) * 16, hl == 1); }
        f32x16 S[5];
#pragma unroll
        for (int kt = 0; kt < 5; ++kt) {
#pragma unroll
            for (int i = 0; i < 16; ++i) S[kt][i] = 0.f;
#pragma unroll
            for (int s = 0; s < 4; ++s) { const bf16x8 kf = *(const LAS bf16x8*)(Ks + (r0 + 32 * kt + q) * KS_LD + 16 * s + 8 * hl);
                S[kt] = MFMA32(kf, __builtin_bit_cast(bf16x8, qf[s]), S[kt]); }
        }
#pragma unroll
        for (int i = 0; i < 16; ++i) { const int kl = 8 * (i >> 2) + 4 * hl + (i & 3);
            if (kl <= q) S[0][i] = -1e30f;
            if (kl > q) S[4][i] = -1e30f; }
        if (n == 0) {
#pragma unroll
            for (int kt = 0; kt < 4; ++kt) if (r0 + 32 * kt < 128) {
#pragma unroll
                for (int i = 0; i < 16; ++i) S[kt][i] = -1e30f; }
        }
        float mx = -1e30f;
#pragma unroll
        for (int kt = 0; kt < 5; ++kt)
#pragma unroll
            for (int i = 0; i < 16; ++i) mx = fmaxf(mx, S[kt][i]);
        mx = fmaxf(mx, __shfl_xor(mx, 32));
        const float M2 = fmaxf(mx * cscale, sinkv);
        float l = 0.f;
#pragma unroll
        for (int kt = 0; kt < 5; ++kt)
#pragma unroll
            for (int i = 0; i < 16; ++i) { const float pv = __builtin_amdgcn_exp2f(S[kt][i] * cscale - M2); l += pv; S[kt][i] = pv; }
        l += __shfl_xor(l, 32);
        l += __builtin_amdgcn_exp2f(sinkv - M2);
        const float inv = __builtin_amdgcn_rcpf(l);
        f32x16 O[2];
#pragma unroll
        for (int i = 0; i < 16; ++i) { O[0][i] = 0.f; O[1][i] = 0.f; }
#pragma unroll
        for (int kt = 0; kt < 5; ++kt)
#pragma unroll
            for (int s2 = 0; s2 < 2; ++s2) {
                u32x4 pw; pw.x = pk2(S[kt][8 * s2 + 0], S[kt][8 * s2 + 1]); pw.y = pk2(S[kt][8 * s2 + 2], S[kt][8 * s2 + 3]); pw.z = pk2(S[kt][8 * s2 + 4], S[kt][8 * s2 + 5]); pw.w = pk2(S[kt][8 * s2 + 6], S[kt][8 * s2 + 7]);
                const bf16x8 pf = __builtin_bit_cast(bf16x8, pw);
#pragma unroll
                for (int dt = 0; dt < 2; ++dt) {
                    const LAS bf16_t* vp = Vt + (32 * dt + q) * VT_LD + r0 + 32 * kt + 16 * s2 + 4 * hl;
                    const u32x2 v0 = *(const LAS u32x2*)vp, v1 = *(const LAS u32x2*)(vp + 8);
                    u32x4 vw; vw.x = v0.x; vw.y = v0.y; vw.z = v1.x; vw.w = v1.y;
                    O[dt] = MFMA32(__builtin_bit_cast(bf16x8, vw), pf, O[dt]);
                }
            }
        bf16_t* orow = qrow;
#pragma unroll
        for (int dt = 0; dt < 2; ++dt)
#pragma unroll
            for (int a = 0; a < 4; ++a) { u32x2 w; w.x = pk2(O[dt][4 * a] * inv, O[dt][4 * a + 1] * inv); w.y = pk2(O[dt][4 * a + 2] * inv, O[dt][4 * a + 3] * inv);
                *(u32x2*)(orow + 32 * dt + 8 * a + 4 * hl) = w; }
    }
    __syncthreads();
}

constexpr int NCH = SEQ / 128;
DI void rnn_phase(LAS unsigned char* lds, bf16_t* P, const bf16_t* WaT, const bf16_t* WiT, const float* convw, const float* convb, const float* ba, const float* bi, const float* lam,
                  f32x2* sums, unsigned* au, bool fin, int bx, int G, int tid, int wid, int lane) {
    constexpr int NU = BPC * NCH * 16;
    typedef _Float16 h2_t __attribute__((ext_vector_type(2)));
    LAS float* XC = (LAS float*)lds; LAS float* AA = (LAS float*)(lds + 32768); LAS bf16_t* XB = (LAS bf16_t*)(lds + 65536); LAS bf16_t* WL = (LAS bf16_t*)(lds + 83968);
    LAS float* SG = (LAS float*)(lds + 102400); LAS float* PF = (LAS float*)(lds + 106496); LAS float* CW = (LAS float*)(lds + 110592);
    const int t = tid >> 2, cq = tid & 3;
    const int tt = wid >> 1, nt = wid & 1, l32 = lane & 31, hl = lane >> 5;
    int cur_hbk = -1; float bac = 0.f, bic = 0.f, k8c = 0.f;
    u32x4 xr[4][2];
#define RNN_LOAD_XR(uu) do { const int hb_ = (uu) & 15, c_ = ((uu) >> 4) & 63, b_ = (uu) >> 10; const size_t rb_ = (size_t)b_ * SEQ + c_ * 128; \
        _Pragma("unroll") for (int tap = 0; tap < 4; ++tap) { const int tp_ = c_ * 128 + t + tap - 3; \
            if (tp_ >= 0) { const bf16_t* src_ = P + (rb_ + t + tap - 3) * DIN + PC_X + hb_ * 64 + 16 * cq; xr[tap][0] = *(const u32x4*)src_; xr[tap][1] = *(const u32x4*)(src_ + 8); } \
            else { xr[tap][0] = (u32x4){0u, 0u, 0u, 0u}; xr[tap][1] = (u32x4){0u, 0u, 0u, 0u}; } } } while (0)
    if (fin) {
        int par = 0;
        for (int u2 = bx; u2 < NU; u2 += G) {
            const int hbk = u2 & 15, c = (u2 >> 4) & 63, b = u2 >> 10;
            const size_t rowbase = (size_t)b * SEQ + c * 128; const int ch0 = hbk * 64, ch = lane, seg = wid;
            const unsigned* aup = au + (rowbase + 16 * seg) * D + ch0 + ch;
            bf16_t* yp = P + (rowbase + 16 * seg) * DIN + PC_Y + ch0 + ch;
            unsigned w[16]; unsigned short yv[16];
#pragma unroll
            for (int j = 0; j < 16; ++j) { w[j] = aup[(size_t)j * D]; yv[j] = yp[(size_t)j * DIN]; }
            float Ap = 1.f, Hp = 0.f;
#pragma unroll
            for (int k = 0; k < 8; ++k) { const int j = 8 * wid + k; if (j < c) { const f32x2 sv = sums[((size_t)b * NCH + j) * D + ch0 + lane]; Hp = sv.x * Hp + sv.y; Ap *= sv.x; } }
            float av[16], uv[16]; float A = 1.f, H = 0.f;
#pragma unroll
            for (int j = 0; j < 16; ++j) { const h2_t v = __builtin_bit_cast(h2_t, w[j]); av[j] = 1.0f - (float)v.x; uv[j] = (float)v.y; H = av[j] * H + uv[j]; A *= av[j]; }
            LAS float* SGp = SG + (par ? 2048 : 0);
            SGp[seg * 64 + ch] = A; SGp[512 + seg * 64 + ch] = H; SGp[1024 + wid * 64 + lane] = Ap; SGp[1536 + wid * 64 + lane] = Hp;
            __syncthreads();
            float h = 0.f;
#pragma unroll
            for (int q8 = 0; q8 < 8; ++q8) h = SGp[1024 + q8 * 64 + ch] * h + SGp[1536 + q8 * 64 + ch];
            for (int s2 = 0; s2 < seg; ++s2) h = SGp[s2 * 64 + ch] * h + SGp[512 + s2 * 64 + ch];
#pragma unroll
            for (int j = 0; j < 16; ++j) { h = av[j] * h + uv[j]; const float o = h * gelu_tanh(bf1(yv[j])); yp[(size_t)j * DIN] = (bf16_t)(pk2(o, 0.f) & 0xffffu); }
            par ^= 1;
        }
        __syncthreads();
        return;
    }
    int u = bx; if (u >= NU) return;
    RNN_LOAD_XR(u);
    for (; u < NU; u += G) {
        const int hbk = u & 15, c = (u >> 4) & 63, b = u >> 10;
        const size_t rowbase = (size_t)b * SEQ + c * 128; const int ch0 = hbk * 64;
        if (hbk != cur_hbk) {
            const int nn = tid >> 3, k8 = tid & 7;
            *(LAS u32x4*)(WL + nn * 72 + 8 * k8) = *(const u32x4*)(WaT + (size_t)hbk * 4096 + nn * 64 + 8 * k8);
            *(LAS u32x4*)(WL + 64 * 72 + nn * 72 + 8 * k8) = *(const u32x4*)(WiT + (size_t)hbk * 4096 + nn * 64 + 8 * k8);
            if (tid < 320) CW[tid] = tid < 256 ? convw[(tid >> 6) * D + ch0 + (tid & 63)] : convb[ch0 + tid - 256];
            const int chg = ch0 + 32 * nt + l32;
            bac = ba[chg]; bic = bi[chg]; k8c = -8.0f * LOG2E * log1pf(expf(-lam[chg]));
            cur_hbk = hbk;
            __syncthreads();
        }
        unsigned short yv[16]; float Ap = 1.f, Hp = 0.f;
        bf16_t* yp = P + (rowbase + 16 * wid) * DIN + PC_Y + ch0 + lane;
        if (fin) {
#pragma unroll
            for (int j = 0; j < 16; ++j) yv[j] = yp[(size_t)j * DIN];
#pragma unroll
            for (int k = 0; k < 8; ++k) { const int j = 8 * wid + k; if (j < c) { const f32x2 sv = sums[((size_t)b * NCH + j) * D + ch0 + lane]; Hp = sv.x * Hp + sv.y; Ap *= sv.x; } }
        }
        {
            f32x4 acc[4];
#pragma unroll
            for (int j = 0; j < 4; ++j) acc[j] = *(const LAS f32x4*)(CW + 256 + 16 * cq + 4 * j);
#pragma unroll
            for (int tap = 0; tap < 4; ++tap) {
                const u32x4 x0 = xr[tap][0], x1 = xr[tap][1];
                const LAS float* wp = CW + tap * 64 + 16 * cq;
                const f32x4 w0 = *(const LAS f32x4*)wp, w1 = *(const LAS f32x4*)(wp + 4), w2 = *(const LAS f32x4*)(wp + 8), w3 = *(const LAS f32x4*)(wp + 12);
                acc[0] += (f32x4){bflo(x0.x), bfhi(x0.x), bflo(x0.y), bfhi(x0.y)} * w0; acc[1] += (f32x4){bflo(x0.z), bfhi(x0.z), bflo(x0.w), bfhi(x0.w)} * w1;
                acc[2] += (f32x4){bflo(x1.x), bfhi(x1.x), bflo(x1.y), bfhi(x1.y)} * w2; acc[3] += (f32x4){bflo(x1.z), bfhi(x1.z), bflo(x1.w), bfhi(x1.w)} * w3;
            }
#pragma unroll
            for (int j = 0; j < 4; ++j) *(LAS f32x4*)(XC + t * 64 + 16 * cq + 4 * j) = acc[j];
            u32x4 o0, o1; o0.x = pk2(acc[0].x, acc[0].y); o0.y = pk2(acc[0].z, acc[0].w); o0.z = pk2(acc[1].x, acc[1].y); o0.w = pk2(acc[1].z, acc[1].w);
            o1.x = pk2(acc[2].x, acc[2].y); o1.y = pk2(acc[2].z, acc[2].w); o1.z = pk2(acc[3].x, acc[3].y); o1.w = pk2(acc[3].z, acc[3].w);
            *(LAS u32x4*)(XB + t * 72 + 16 * cq) = o0; *(LAS u32x4*)(XB + t * 72 + 16 * cq + 8) = o1;
        }
        if (u + G < NU) RNN_LOAD_XR(u + G);
        if (fin) { PF[wid * 64 + lane] = Ap; PF[512 + wid * 64 + lane] = Hp; }
        __syncthreads();
        {
            f32x16 aR, aI;
#pragma unroll
            for (int i = 0; i < 16; ++i) { aR[i] = 0.f; aI[i] = 0.f; }
#pragma unroll
            for (int s = 0; s < 4; ++s) {
                const bf16x8 af = *(const LAS bf16x8*)(XB + (32 * tt + l32) * 72 + 16 * s + 8 * hl);
                const bf16x8 bR = *(const LAS bf16x8*)(WL + (32 * nt + l32) * 72 + 16 * s + 8 * hl);
                const bf16x8 bI = *(const LAS bf16x8*)(WL + 64 * 72 + (32 * nt + l32) * 72 + 16 * s + 8 * hl);
                aR = MFMA32(af, bR, aR); aI = MFMA32(af, bI, aI);
            }
            const int ch = 32 * nt + l32;
            float At = 1.f, Ht = 0.f;
#pragma unroll
            for (int g = 0; g < 4; ++g) {
                float A = 1.f, H = 0.f;
#pragma unroll
                for (int q4 = 0; q4 < 4; ++q4) { const int i = 4 * g + q4, tok = 32 * tt + 8 * g + 4 * hl + q4;
                    const float r = sigm(aR[i] + bac), ig = sigm(aI[i] + bic);
                    const float a = __builtin_amdgcn_exp2f(k8c * r);
                    const float uu_ = __builtin_amdgcn_sqrtf(fmaxf(1.0f - a * a, 0.f)) * ig * XC[tok * 64 + ch];
                    { const h2_t pv = {(_Float16)(1.0f - a), (_Float16)uu_}; au[(rowbase + tok) * D + ch0 + ch] = __builtin_bit_cast(unsigned, pv); }
                    H = a * H + uu_; A *= a; }
                const float pA = __shfl_xor(A, 32), pH = __shfl_xor(H, 32);
                const float fA = hl ? pA : A, fH = hl ? pH : H, sA = hl ? A : pA, sH = hl ? H : pH;
                Ht = fA * Ht + fH; At *= fA; Ht = sA * Ht + sH; At *= sA;
            }
            if (hl == 0) { SG[tt * 64 + ch] = At; SG[256 + tt * 64 + ch] = Ht; }
            __syncthreads();
            if (tt == 3 && hl == 0) { float Ac = 1.f, Hc = 0.f;
#pragma unroll
                for (int s = 0; s < 4; ++s) { const float sa = SG[s * 64 + ch]; Hc = sa * Hc + SG[256 + s * 64 + ch]; Ac *= sa; }
                sums[((size_t)b * NCH + c) * D + ch0 + ch] = (f32x2){Ac, Hc}; }
        }
    }
#undef RNN_LOAD_XR
}

DI void pool_item(const bf16_t* P, bf16_t* pooled, int idx) {
    const int cg8 = idx & 127, run = idx >> 7; const size_t row0 = (size_t)run * 8; const int t0 = (int)(row0 & (SEQ - 1));
    const int ch = cg8 * 8, w = 2 << (ch >> 8);
    const bf16_t* src = P + PC_P + ch;
    float sum[8];
#pragma unroll
    for (int j = 0; j < 8; ++j) sum[j] = 0.f;
    for (int k = 1; k < w; ++k) if (t0 - k >= 0) { const u32x4 x = *(const u32x4*)(src + (row0 - k) * DIN);
        sum[0] += bflo(x.x); sum[1] += bfhi(x.x); sum[2] += bflo(x.y); sum[3] += bfhi(x.y); sum[4] += bflo(x.z); sum[5] += bfhi(x.z); sum[6] += bflo(x.w); sum[7] += bfhi(x.w); }
#pragma unroll
    for (int j = 0; j < 8; ++j) {
        const int t = t0 + j; const u32x4 x = *(const u32x4*)(src + (row0 + j) * DIN);
        const float cur[8] = {bflo(x.x), bfhi(x.x), bflo(x.y), bfhi(x.y), bflo(x.z), bfhi(x.z), bflo(x.w), bfhi(x.w)};
#pragma unroll
        for (int e = 0; e < 8; ++e) sum[e] += cur[e];
        const float ic = __builtin_amdgcn_rcpf((float)(t + 1 < w ? t + 1 : w));
        u32x4 o; o.x = pk2(sum[0] * ic - cur[0], sum[1] * ic - cur[1]); o.y = pk2(sum[2] * ic - cur[2], sum[3] * ic - cur[3]);
        o.z = pk2(sum[4] * ic - cur[4], sum[5] * ic - cur[5]); o.w = pk2(sum[6] * ic - cur[6], sum[7] * ic - cur[7]);
        *(u32x4*)(pooled + (row0 + j) * D + ch) = o;
        if (t - w + 1 >= 0) { const u32x4 y = *(const u32x4*)(src + (row0 + j - w + 1) * DIN);
            sum[0] -= bflo(y.x); sum[1] -= bfhi(y.x); sum[2] -= bflo(y.y); sum[3] -= bfhi(y.y); sum[4] -= bflo(y.z); sum[5] -= bfhi(y.z); sum[6] -= bflo(y.w); sum[7] -= bfhi(y.w); }
    }
}


#define XB_TMO      128
#define XB_XCNT(j)  (256  + 64 * (j))
#define XB_XSUB(j)  (1280 + 64 * (j))
#define XB_XGEN(j)  (2304 + 64 * (j))
#define XB_TOP      3328
#define XB_TOPGEN   3392
#define XCD_BAR_WORDS 3456
#define XB_SPIN_CAP (1u << 22)
DI unsigned xb_ld(unsigned* p)              { return __hip_atomic_load(p, __ATOMIC_RELAXED, __HIP_MEMORY_SCOPE_AGENT); }
DI unsigned xb_add(unsigned* p, unsigned v) { return __hip_atomic_fetch_add(p, v, __ATOMIC_RELAXED, __HIP_MEMORY_SCOPE_AGENT); }
DI unsigned xb_xcc_id() { return (unsigned)__builtin_amdgcn_s_getreg((3 << 11) | 20) & 0xFu; }
#define XB_SPIN(cond, bar) do { unsigned _sp = 0; while (cond) { __builtin_amdgcn_s_sleep(1); \
    if ((++_sp & 255u) == 0u) { if (xb_ld(&(bar)[XB_TMO])) break; if (_sp > XB_SPIN_CAP) { atomicAdd(&(bar)[XB_TMO], 1u); break; } } } } while (0)
struct XcdBarrier { unsigned* bar; unsigned x; volatile LAS unsigned* st; unsigned n; };
DI XcdBarrier xcd_barrier_post(unsigned* bar, volatile LAS unsigned* st, unsigned n) {
    XcdBarrier b; b.bar = bar; b.x = xb_xcc_id(); b.st = st; b.n = n;
    if (threadIdx.x == 0) (void)xb_add(&bar[XB_XCNT(b.x)], 1u);
    return b;
}
DI void xcd_barrier_complete(unsigned* bar, unsigned x, unsigned G, unsigned& nloc, unsigned& nx) {
    unsigned sum, cnt, mine, sp = 0u;
    for (;;) {
        sum = 0u; cnt = 0u; mine = 0u;
#pragma unroll
        for (unsigned j = 0; j < 16; ++j) { const unsigned c = xb_ld(&bar[XB_XCNT(j)]); sum += c; cnt += (c > 0u) ? 1u : 0u; mine = (j == x) ? c : mine; }
        if (sum == G) break;
        __builtin_amdgcn_s_sleep(1);
        if ((++sp & 255u) == 0u) { if (xb_ld(&bar[XB_TMO])) break; if (sp > XB_SPIN_CAP) { atomicAdd(&bar[XB_TMO], 1u); break; } }
    }
    nloc = mine > 0u ? mine : 1u; nx = cnt > 0u ? cnt : 1u;
}
DI void xcd_barrier(const XcdBarrier& b) {
    asm volatile("s_waitcnt vmcnt(0)" ::: "memory");
    __syncthreads();
    if (threadIdx.x == 0) {
        unsigned* bar = b.bar;
        __builtin_amdgcn_s_waitcnt(0);
        unsigned nloc = b.st[0], nx = b.st[1];
        if (nloc == 0u) { xcd_barrier_complete(bar, b.x, b.n, nloc, nx); b.st[0] = nloc; b.st[1] = nx; }
        const unsigned old = xb_add(&bar[XB_XSUB(b.x)], 1u);
        const unsigned gen = old / nloc;
        if (old + 1u == (gen + 1u) * nloc) {
            __builtin_amdgcn_fence(__ATOMIC_RELEASE, "agent");
            asm volatile("s_waitcnt vmcnt(0)" ::: "memory");
            const unsigned og = xb_add(&bar[XB_TOP], 1u);
            const unsigned tg = og / nx;
            if (og + 1u == (tg + 1u) * nx) xb_add(&bar[XB_TOPGEN], 1u);
            else XB_SPIN(xb_ld(&bar[XB_TOPGEN]) == tg, bar);
            __builtin_amdgcn_fence(__ATOMIC_ACQUIRE, "agent");
            xb_add(&bar[XB_XGEN(b.x)], 1u);
            asm volatile("s_waitcnt vmcnt(0)" ::: "memory");
        } else {
            XB_SPIN(xb_ld(&bar[XB_XGEN(b.x)]) == gen, bar);
            __builtin_amdgcn_fence(__ATOMIC_ACQUIRE, "agent");
            asm volatile("s_waitcnt vmcnt(0)" ::: "memory");
        }
    }
    __syncthreads();
}

__global__ void __launch_bounds__(512, 2) mega_fwd(Params p) {
    extern __shared__ __attribute__((aligned(16))) unsigned char lds_raw[];
    LAS unsigned char* lds = (LAS unsigned char*)lds_raw;
    cg::grid_group grid = cg::this_grid();
    const int Gfull = gridDim.x, bfull = blockIdx.x;
    const int half = (bfull & 7) >> 2, bx = (bfull >> 3) * 4 + (bfull & 3), G = Gfull >> 1, NGW = G * 8;
#define TID_LOCAL() int tid_ = threadIdx.x; asm volatile("" : "+v"(tid_)); const int tid = tid_, lane = tid & 63, wid = __builtin_amdgcn_readfirstlane(tid >> 6), gw = bx * 8 + wid; (void)lane; (void)gw; (void)tid
    volatile LAS unsigned* xst = (volatile LAS unsigned*)(lds + 131072 + 512);
    if (threadIdx.x < 2) xst[threadIdx.x] = 0u;
    __syncthreads();
    unsigned* ctl = (unsigned*)(p.ws + WS_CTL);
    XcdBarrier xbar = xcd_barrier_post(ctl + half * 4096, xst, (unsigned)G);
    unsigned* wflag = ctl + 8192 + 64;
    { TID_LOCAL(); const int gwf = bfull * 8 + wid; prologue(p, lds, 0, 1, true, gwf, Gfull * 8, wid, lane); }
    grid.sync();
    if (half == 1) {
        TID_LOCAL(); prologue(p, lds, 1, DEPTH, false, gw, NGW, wid, lane);
        asm volatile("s_waitcnt vmcnt(0)" ::: "memory"); __syncthreads();
        if (tid == 0) { __builtin_amdgcn_fence(__ATOMIC_RELEASE, "agent"); asm volatile("s_waitcnt vmcnt(0)" ::: "memory"); __hip_atomic_fetch_add(wflag, 1u, __ATOMIC_RELAXED, __HIP_MEMORY_SCOPE_AGENT); }
    }
    bool first = true, wready = (half == 1);
#define STEP_SYNC() do { if (!first) xcd_barrier(xbar); first = false; } while (0)
    for (int cj = 0; cj < NCHUNK / 2; ++cj) {
        const int ck = half * (NCHUNK / 2) + cj;
        { STEP_SYNC(); TID_LOCAL(); int ckx = ck; unsigned char* ws = p.ws + (size_t)half * HALF_STRIDE; asm volatile("" : "+s"(ckx), "+s"(ws));
            rowpass(p.in[I_X] + (size_t)ckx * MC * D, nullptr, nullptr, p.in[I_NMIXPRE], p.out + (size_t)ckx * MC * D, (bf16_t*)(ws + WS_HB), gw, NGW, lane); }
        for (int l = 0; l < DEPTH; ++l) {
            if (!wready && l >= 1) {
                if (threadIdx.x == 0) { unsigned sp = 0; while (__hip_atomic_load(wflag, __ATOMIC_RELAXED, __HIP_MEMORY_SCOPE_AGENT) < (unsigned)G) { __builtin_amdgcn_s_sleep(2); if (++sp > (1u << 24)) break; }
                    __builtin_amdgcn_fence(__ATOMIC_ACQUIRE, "agent"); asm volatile("s_waitcnt vmcnt(0)" ::: "memory"); }
                __syncthreads(); wready = true;
            }
            for (int ph = 0; ph < 9; ++ph) {
                STEP_SYNC();
                if (ph == 1) {
                    TID_LOCAL(); int lx = l; unsigned char* ws = p.ws + (size_t)half * HALF_STRIDE; unsigned char* wg = p.ws; asm volatile("" : "+s"(lx), "+s"(ws), "+s"(wg));
                    bf16_t* proj = (bf16_t*)(ws + WS_PROJ);
                    for (int u = bx; u < BPC * 64 * 4; u += G) attn_unit(lds, proj, (const float*)(wg + WS_ROPE), p.in[I_SINKS] + lx * 16, u, tid, wid, lane);
                    for (int idx = bx * 512 + tid; idx < (MC / 8) * 128; idx += G * 512) pool_item(proj, (bf16_t*)(ws + WS_POOLED), idx);
                }
                if (ph == 1 || ph == 2) {
                    TID_LOCAL(); int lx = l; unsigned char* ws = p.ws + (size_t)half * HALF_STRIDE; unsigned char* wg = p.ws; asm volatile("" : "+s"(lx), "+s"(ws), "+s"(wg));
                    const bf16_t* Wl = (const bf16_t*)(wg + WS_W) + (size_t)lx * WO_LAYER;
                    rnn_phase(lds, (bf16_t*)(ws + WS_PROJ), Wl + WO_RA, Wl + WO_RI, p.in[I_CONVW] + (size_t)lx * 4 * D, p.in[I_CONVB] + lx * D, p.in[I_BRGA] + lx * D, p.in[I_BRGI] + lx * D, p.in[I_LAM] + lx * D,
                              (f32x2*)(ws + WS_SUMS), (unsigned*)(wg + WS_AU + (size_t)half * 64 * MiB), ph == 2, bx, G, tid, wid, lane);
                }
                if (ph == 5 || ph == 8) {
                    TID_LOCAL(); int lx = l, ckx = ck; unsigned char* ws = p.ws + (size_t)half * HALF_STRIDE; asm volatile("" : "+s"(lx), "+s"(ckx), "+s"(ws));
                    const float* gpost = (ph == 5 ? p.in[I_NMIXPOST] : p.in[I_NMLPPOST]) + lx * D;
                    const float* gnext = ph == 5 ? p.in[I_NMLPPRE] + lx * D : (lx + 1 < DEPTH ? p.in[I_NMIXPRE] + (lx + 1) * D : nullptr);
                    float* hck = p.out + (size_t)ckx * MC * D;
                    rowpass(lx == 0 && ph == 5 ? p.in[I_X] + (size_t)ckx * MC * D : hck, (const bf16_t*)(ws + WS_PROJ + PROJ_MIX_OFF), gpost, gnext, hck, (bf16_t*)(ws + WS_HB), gw, NGW, lane);
                }
                if (ph == 0 || ph == 2 || ph == 3 || ph == 4 || ph == 6 || ph == 7) {
                    int lx = l; unsigned char* ws = p.ws + (size_t)half * HALF_STRIDE; unsigned char* wg = p.ws; asm volatile("" : "+s"(lx), "+s"(ws), "+s"(wg));
                    pg8::gemm_phase(lds, ph, ws, wg, lx, p.in[I_PSCALE] + lx * D, G, bx, (Gfull & 7) == 0 ? 4 : 1);
                }
            }
        }
    }
}

#ifndef MK_MULTI
#define MK_MULTI 0
#endif
extern "C" void kernel_launch(void* const* d_in, const int* in_sizes, int n_in, void* d_out, int out_size, void* d_ws, size_t ws_size, hipStream_t stream) {
    static int grid = 0;
    if (grid == 0) {
        if (n_in != 22 || ws_size < WS_END) { fprintf(stderr, "kernel_launch: unexpected n_in %d / ws_size %zu (need %zu)\n", n_in, ws_size, (size_t)WS_END); grid = -1; return; }
        int dev = 0, cus = 0, per_cu = 0;
        hipGetDevice(&dev); hipDeviceGetAttribute(&cus, hipDeviceAttributeMultiprocessorCount, dev);
        if (hipFuncSetAttribute((const void*)mega_fwd, hipFuncAttributeMaxDynamicSharedMemorySize, LDS_BYTES) != hipSuccess) { fprintf(stderr, "kernel_launch: hipFuncSetAttribute failed\n"); grid = -1; return; }
        if (hipOccupancyMaxActiveBlocksPerMultiprocessor(&per_cu, (const void*)mega_fwd, 512, LDS_BYTES) != hipSuccess || per_cu < 1) { fprintf(stderr, "kernel_launch: occupancy query gave %d\n", per_cu); per_cu = 1; }
        (void)hipGetLastError();
        grid = (cus * per_cu) & ~7;
        fprintf(stderr, "kernel_launch: grid %d (cus %d x %d)\n", grid, cus, per_cu);
    }
    if (grid < 0) return;
    if (hipMemsetAsync((char*)d_ws + WS_CTL, 0, CTL_ZERO_BYTES, stream) != hipSuccess) { fprintf(stderr, "kernel_launch: memset failed\n"); return; }
    Params p{};
    for (int i = 0; i < 22; ++i) p.in[i] = (const float*)d_in[i];
    p.out = (float*)d_out; p.ws = (unsigned char*)d_ws;
    for (int j = 0; j < 8; ++j) p.inv_freq[j] = (float)pow(500000.0, -(double)j / 8.0);
    p.lo = 0; p.hi = 0; void* args[] = {&p};
    hipError_t e = hipLaunchCooperativeKernel((const void*)mega_fwd, dim3(grid), dim3(512), args, LDS_BYTES, stream);
    if (e != hipSuccess) fprintf(stderr, "cooperative launch failed: %s (grid %d)\n", hipGetErrorString(e), grid);
}
```
